# Optimizing an MI355X kernel written in HIP

```python
import jax, jax.numpy as jnp
from jax import lax
import numpy as np

D_MODEL = 1024
BATCH = 32
SEQ = 2048
DEPTH = 2

GRID_W = 64
CTX_LEN = 256
N_MIXERS = 2
N_HGRN = (DEPTH + N_MIXERS - 1) // N_MIXERS
N_CMLP = DEPTH // N_MIXERS
HG_HEADS = 8
HG_DK = D_MODEL // HG_HEADS
HG_DV = D_MODEL // HG_HEADS
HG_CHUNK = 64
CM_CHUNK = 128
CM_GROUPS = 8
CM_INNER = 3 * D_MODEL
FFN_HIDDEN = ((8 * D_MODEL // 3 + 127) // 128) * 128
DN_ALPHA = (2 * DEPTH) ** 0.25
DN_BETA = (8 * DEPTH) ** -0.25
LN_EPS = 1e-5
RMS_EPS = 1e-6
N_MOD = 9

kernel_name = "hybrid_hgrn2_chunkmlp_flow_block"


def layer_norm(x, g, b):
    xf = x.astype(jnp.float32)
    mu = jnp.mean(xf, axis=-1, keepdims=True)
    var = jnp.mean(jnp.square(xf - mu), axis=-1, keepdims=True)
    return ((xf - mu) * lax.rsqrt(var + LN_EPS) * g + b).astype(x.dtype)


def modulation(cond, w_mod, b_mod):
    m = jax.nn.silu(cond) @ w_mod + b_mod
    return m.reshape(m.shape[:-1] + (N_MOD, D_MODEL))


def modulate(x, m, k):
    return x * (1 + m[..., 3 * k + 1, :]) + m[..., 3 * k, :]


def post_norm_update(x, y, m, k, g, b):
    return layer_norm(DN_ALPHA * x + m[..., 3 * k + 2, :] * y, g, b)


def swiglu(h, w_in, w_out):
    gate, up = jnp.split(h @ w_in, 2, axis=-1)
    return (jax.nn.silu(gate) * up) @ w_out


def macaron_half_ffn(x, m, k, w_in, w_out, g, b):
    return post_norm_update(x, 0.5 * swiglu(modulate(x, m, k), w_in, w_out), m, k, g, b)


def gla_chunkwise(q, k, v, logf, s0):
    bsz, nh, length, dk = q.shape
    dv = v.shape[-1]
    n = length // HG_CHUNK

    def blocks(t):
        return t.reshape(bsz, nh, n, HG_CHUNK, t.shape[-1]).transpose(2, 0, 1, 3, 4)

    q, k, v, logf = blocks(q), blocks(k), blocks(v), blocks(logf)
    b = jnp.cumsum(logf, axis=-2)
    b_last = b[..., -1:, :]
    q_in = q * jnp.exp(b)
    k_in = k * jnp.exp(-b)
    k_out = k * jnp.exp(b_last - b)
    lower = jnp.tril(jnp.ones((HG_CHUNK, HG_CHUNK), dtype=bool))
    scores = jnp.where(lower, jnp.einsum('nbhtd,nbhsd->nbhts', q_in, k_in), 0.0)
    o_intra = jnp.einsum('nbhts,nbhse->nbhte', scores, v)
    kv_chunk = jnp.einsum('nbhsd,nbhse->nbhde', k_out, v)
    decay_chunk = jnp.exp(b_last[..., 0, :])

    def step(state, xs):
        q_c, dec_c, kv_c = xs
        o_c = jnp.einsum('bhtd,bhde->bhte', q_c, state)
        return dec_c[..., None] * state + kv_c, o_c

    s_final, o_inter = lax.scan(step, s0, (q_in, decay_chunk, kv_chunk))
    o = (o_intra + o_inter).transpose(1, 2, 0, 3, 4).reshape(bsz, nh, length, dv)
    return o, s_final


def hgrn2_project(h, w_in, lb):
    bsz, length, _ = h.shape
    p = (h @ w_in).astype(jnp.float32)
    p = p.reshape(bsz, length, 5, HG_HEADS, HG_DK).transpose(2, 0, 3, 1, 4)
    q = jax.nn.silu(p[0])
    i = p[1]
    lbb = lb[:, None]
    f = lbb + (1 - lbb) * jax.nn.sigmoid(p[2:4])
    return q, i, 1 - f, jnp.log(f), p[4]


def hgrn2_readout(o, g, norm_w, w_out):
    bsz, nh, length, dv = o.shape
    o = o * lax.rsqrt(jnp.mean(o * o, axis=-1, keepdims=True) + RMS_EPS) * norm_w
    o = o * jax.nn.silu(g)
    return o.transpose(0, 2, 1, 3).reshape(bsz, length, nh * dv).astype(w_out.dtype) @ w_out


def hgrn2_mixer(hx, hc, w_in, lb, norm_w, w_out, ctx_out):
    qx, ix, kx, lfx, gx = hgrn2_project(hx, w_in, lb)
    qc, ic, kc, lfc, gc = hgrn2_project(hc, w_in, lb)
    s0 = jnp.zeros((hc.shape[0], HG_HEADS, HG_DK, HG_DV), jnp.float32)
    rev = lambda t: jnp.flip(t, axis=2)
    oc_f, sc_f = gla_chunkwise(qc, kc[0], ic, lfc[0], s0)
    oc_b, sc_b = gla_chunkwise(rev(qc), rev(kc[1]), rev(ic), rev(lfc[1]), s0)
    ox_f, _ = gla_chunkwise(qx, kx[0], ix, lfx[0], sc_f)
    ox_b, _ = gla_chunkwise(rev(qx), rev(kx[1]), rev(ix), rev(lfx[1]), sc_b)
    yx = hgrn2_readout(ox_f + rev(ox_b), gx, norm_w, w_out)
    yc = hgrn2_readout(oc_f + rev(oc_b), gc, norm_w, w_out) if ctx_out else None
    return yx, yc


def chunk_mlp(h, n_chunks, w_in, v_g, v_b, w_s, b_s, w_out):
    bsz, length, _ = h.shape
    u, v = jnp.split(jax.nn.gelu(h @ w_in), 2, axis=-1)
    v = layer_norm(v, v_g, v_b)
    v = v.reshape(bsz, n_chunks, CM_CHUNK, CM_GROUPS, CM_INNER // CM_GROUPS)
    v = jnp.einsum('gts,bnsgc->bntgc', w_s, v) + b_s.T[None, None, :, :, None]
    return (u * v.reshape(bsz, length, CM_INNER)) @ w_out


def setup_inputs(seed: int = 0) -> dict:
    key = jax.random.key(seed)
    ks = jax.random.split(key, 24)
    nrm = lambda k, shape, s: jax.random.normal(k, shape, jnp.float32) * s
    d = D_MODEL
    return {
        "x": nrm(ks[0], (BATCH, SEQ, d), 1.0),
        "c": nrm(ks[1], (BATCH, d), 1.0),
        "ctx": nrm(ks[2], (BATCH, CTX_LEN, d), 1.0),
        "c_ctx": nrm(ks[3], (d,), 1.0),
        "mod_w": nrm(ks[4], (DEPTH, d, N_MOD * d), 0.5 * d ** -0.5),
        "mod_b": nrm(ks[5], (DEPTH, N_MOD * d), 0.02),
        "ln_g": 1.0 + nrm(ks[6], (DEPTH, 3, d), 0.02),
        "ln_b": nrm(ks[7], (DEPTH, 3, d), 0.02),
        "ffn_w_in": nrm(ks[8], (DEPTH, 2, d, 2 * FFN_HIDDEN), d ** -0.5),
        "ffn_w_out": nrm(ks[9], (DEPTH, 2, FFN_HIDDEN, d), DN_BETA * FFN_HIDDEN ** -0.5),
        "hg_w_in": nrm(ks[10], (N_HGRN, d, 5 * d), d ** -0.5),
        "hg_lower_bounds": nrm(ks[11], (2, DEPTH + 1, d), 0.1),
        "hg_norm_w": 1.0 + nrm(ks[12], (N_HGRN, HG_DV), 0.02),
        "hg_w_out": nrm(ks[13], (N_HGRN, d, d), DN_BETA * d ** -0.5),
        "cm_w_in": nrm(ks[14], (N_CMLP, d, 2 * CM_INNER), d ** -0.5),
        "cm_v_g": 1.0 + nrm(ks[15], (N_CMLP, CM_INNER), 0.02),
        "cm_v_b": nrm(ks[16], (N_CMLP, CM_INNER), 0.02),
        "cm_w_s": nrm(ks[17], (N_CMLP, CM_GROUPS, CM_CHUNK, CM_CHUNK), CM_CHUNK ** -0.5),
        "cm_b_s": 1.0 + nrm(ks[18], (N_CMLP, CM_GROUPS, CM_CHUNK), 0.02),
        "cm_w_out": nrm(ks[19], (N_CMLP, CM_INNER, d), DN_BETA * CM_INNER ** -0.5),
    }


def reference(x, c, ctx, c_ctx, mod_w, mod_b, ln_g, ln_b, ffn_w_in, ffn_w_out,
              hg_w_in, hg_lower_bounds, hg_norm_w, hg_w_out,
              cm_w_in, cm_v_g, cm_v_b, cm_w_s, cm_b_s, cm_w_out):
    rows = x.shape[1] // GRID_W
    n_lat_chunks = rows // (CM_CHUNK // GRID_W)
    n_ctx_chunks = ctx.shape[1] // CM_CHUNK
    lb_all = jnp.cumsum(jax.nn.softmax(hg_lower_bounds.astype(jnp.float32), axis=1), axis=1)
    for i in range(DEPTH):
        last = i == DEPTH - 1
        kind = i % N_MIXERS
        j = i // N_MIXERS
        ctx_needed = (not last) or kind == 0
        mx = modulation(c, mod_w[i], mod_b[i])[:, None]
        x = macaron_half_ffn(x, mx, 0, ffn_w_in[i, 0], ffn_w_out[i, 0], ln_g[i, 0], ln_b[i, 0])
        if ctx_needed:
            mc = modulation(c_ctx, mod_w[i], mod_b[i])
            ctx = macaron_half_ffn(ctx, mc, 0, ffn_w_in[i, 0], ffn_w_out[i, 0], ln_g[i, 0], ln_b[i, 0])
        hx = modulate(x, mx, 1)
        if kind == 0:
            lb = lb_all[:, i].reshape(2, HG_HEADS, 1, HG_DK)
            yx, yc = hgrn2_mixer(hx, modulate(ctx, mc, 1), hg_w_in[j], lb, hg_norm_w[j], hg_w_out[j],
                                 ctx_out=not last)
        else:
            yx = chunk_mlp(hx, n_lat_chunks, cm_w_in[j], cm_v_g[j], cm_v_b[j], cm_w_s[j], cm_b_s[j], cm_w_out[j])
            yc = None if last else chunk_mlp(modulate(ctx, mc, 1), n_ctx_chunks, cm_w_in[j], cm_v_g[j],
                                             cm_v_b[j], cm_w_s[j], cm_b_s[j], cm_w_out[j])
        x = post_norm_update(x, yx, mx, 1, ln_g[i, 1], ln_b[i, 1])
        x = macaron_half_ffn(x, mx, 2, ffn_w_in[i, 1], ffn_w_out[i, 1], ln_g[i, 2], ln_b[i, 2])
        if not last:
            ctx = post_norm_update(ctx, yc, mc, 1, ln_g[i, 1], ln_b[i, 1])
            ctx = macaron_half_ffn(ctx, mc, 2, ffn_w_in[i, 1], ffn_w_out[i, 1], ln_g[i, 2], ln_b[i, 2])
    return x
```

```cpp
#include <hip/hip_runtime.h>
#include <hip/hip_cooperative_groups.h>
#include <cstdio>
#include <cstdint>
namespace cg = cooperative_groups;

#define LAS __attribute__((address_space(3)))
typedef unsigned short bf16_t;
typedef short bf16x8 __attribute__((ext_vector_type(8)));
typedef float f32x4 __attribute__((ext_vector_type(4)));
typedef float f32x2 __attribute__((ext_vector_type(2)));
typedef unsigned u32x4 __attribute__((ext_vector_type(4)));
typedef unsigned u32x2 __attribute__((ext_vector_type(2)));

constexpr int D = 1024, NB = 32, SEQ = 2048, CTXL = 256;
constexpr int MX = NB * SEQ;
constexpr int MC = NB * CTXL;
constexpr int MT = MX + MC;
constexpr int FH = 2816, HG5 = 5 * D, CMI = 3072, NMOD = 9;
constexpr float DN_ALPHA = 1.41421356237309515f;
constexpr float LN_EPS = 1e-5f, RMS_EPS = 1e-6f;
constexpr int LDS_BYTES = 147456;
constexpr int NTHREADS = 512;

constexpr size_t WS_MOD = 0;
constexpr size_t WS_LB = WS_MOD + (size_t)2 * 33 * 9216 * 4;
constexpr size_t WS_FIN = WS_LB + 2 * 1024 * 4;
constexpr size_t WS_FOUT = WS_FIN + (size_t)4 * 5632 * 1024 * 2;
constexpr size_t WS_HIN = WS_FOUT + (size_t)4 * 1024 * 2816 * 2;
constexpr size_t WS_HOUT = WS_HIN + (size_t)5120 * 1024 * 2;
constexpr size_t WS_CIN = WS_HOUT + (size_t)1024 * 1024 * 2;
constexpr size_t WS_COUT = WS_CIN + (size_t)6144 * 1024 * 2;
constexpr size_t WS_A0 = WS_COUT + (size_t)1024 * 3072 * 2;
constexpr size_t WS_BIG = WS_A0 + (size_t)MT * 1024 * 2;
constexpr size_t WS_END = WS_BIG + (size_t)MX * 6144 * 2;

struct Params {
    const float* in[20];
    float* out;
    unsigned char* ws;
    int ph_lo, ph_hi;
};

__device__ __forceinline__ unsigned cvt_pk_bf16(float lo, float hi) { unsigned r; asm volatile("v_cvt_pk_bf16_f32 %0, %1, %2" : "=v"(r) : "v"(lo), "v"(hi)); return r; }
__device__ __forceinline__ int opaque_tid() { int t = threadIdx.x; asm volatile("" : "+v"(t)); return t; }
__device__ __forceinline__ float bf_lo(unsigned u) { return __uint_as_float(u << 16); }
__device__ __forceinline__ float bf_hi(unsigned u) { return __uint_as_float(u & 0xffff0000u); }
__device__ __forceinline__ float wave_sum(float v) {
#pragma unroll
    for (int o = 1; o < 64; o <<= 1) v += __shfl_xor(v, o);
    return v;
}
__device__ __forceinline__ float sigmoid_f(float x) { return __builtin_amdgcn_rcpf(1.f + __expf(-x)); }
__device__ __forceinline__ float silu_f(float x) { return x * sigmoid_f(x); }
__device__ __forceinline__ float gelu_tanh_f(float x) { const float u = 0.7978845608028654f * (x + 0.044715f * x * x * x); return x * sigmoid_f(2.f * u); }

namespace pg8 {
constexpr int BM = 256, BK = 64, HALF = 128, HTB = HALF * BK * 2, STAGE_BYTES = 8 * HTB, NXCD = 8, WGM = 8;
__host__ __device__ __forceinline__ int lds_byte(int r, int c) { const int st = (r >> 4) * 2 + (c >> 5), rr = r & 15, cc = c & 31, ob = rr * 64 + cc * 2; return st * 1024 + (ob ^ (((ob >> 9) & 1) << 5)); }
__host__ __device__ __forceinline__ void stage_rc(int b, int& R, int& C) { const int st = b / 1024, sb = b % 1024, swz = sb ^ (((sb >> 9) & 1) << 5); R = (st >> 1) * 16 + swz / 64; C = (st & 1) * 32 + (swz % 64) / 2; }
__host__ __device__ __forceinline__ int perm32(int rho) { const int n = rho >> 4, i = rho & 15; return 8 * (i >> 2) + 4 * n + (i & 3); }

struct Unit { int pm, pn; };
struct Gemm { const bf16_t* A; int lda; const bf16_t* Bt; int M, N, K; };

struct StaticOrder {
    int nM, nN, nwg, G, c;
    __device__ void init(int M, int N, int G_, int c_) { nM = M / BM; nN = N / BM; nwg = nM * nN; G = G_; c = c_; }
    __device__ bool next(int i, Unit& u) const {
        const long L = (long)i * G + c; if (L >= nwg) return false;
        int wgid = (int)L; { const int q = nwg / NXCD, r = nwg % NXCD, xcd = wgid % NXCD, off = wgid / NXCD; wgid = (xcd < r ? xcd * (q + 1) : r * (q + 1) + (xcd - r) * q) + off; }
        const int nig = WGM * nN, gid = wgid / nig, fm = gid * WGM, gsz = (nM - fm) < WGM ? (nM - fm) : WGM;
        u.pm = fm + ((wgid % nig) % gsz); u.pn = (wgid % nig) / gsz; return true;
    }
};

template <int MODE> struct Epi {
    bf16_t* O; int ldo; const float* lb;
    __device__ __forceinline__ void operator()(const f32x4 (&acc)[2][2][4][2], const Unit& u, int wr, int wc, int fr, int fq) const {
        const int row0 = u.pm * BM + wr * 64 + fr;
        if constexpr (MODE == 1) {
            const int col0 = u.pn * 128 + wc * 32 + 8 * fq;
#pragma unroll
            for (int ai = 0; ai < 2; ++ai)
#pragma unroll
                for (int m = 0; m < 4; ++m) {
                    const f32x4 g0 = acc[ai][0][m][0], g1 = acc[ai][0][m][1], u0 = acc[ai][1][m][0], u1 = acc[ai][1][m][1];
                    u32x4 o;
                    o.x = cvt_pk_bf16(silu_f(g0[0]) * u0[0], silu_f(g0[1]) * u0[1]);
                    o.y = cvt_pk_bf16(silu_f(g0[2]) * u0[2], silu_f(g0[3]) * u0[3]);
                    o.z = cvt_pk_bf16(silu_f(g1[0]) * u1[0], silu_f(g1[1]) * u1[1]);
                    o.w = cvt_pk_bf16(silu_f(g1[2]) * u1[2], silu_f(g1[3]) * u1[3]);
                    *(u32x4*)(O + (size_t)(row0 + ai * HALF + m * 16) * ldo + col0) = o;
                    __builtin_amdgcn_sched_barrier(0);
                }
        } else {
            const int seg = u.pn >> 2;
#pragma unroll
            for (int bj = 0; bj < 2; ++bj) {
                const int col0 = u.pn * BM + bj * HALF + wc * 32 + 8 * fq;
                f32x4 l0 = {0.f, 0.f, 0.f, 0.f}, l1 = {0.f, 0.f, 0.f, 0.f};
                if (MODE == 2 && (seg == 2 || seg == 3)) { const float* lp = lb + (seg - 2) * 1024 + (col0 & 1023); l0 = *(const f32x4*)lp; l1 = *(const f32x4*)(lp + 4); }
#pragma unroll
                for (int ai = 0; ai < 2; ++ai)
#pragma unroll
                    for (int m = 0; m < 4; ++m) {
                        f32x4 v0 = acc[ai][bj][m][0], v1 = acc[ai][bj][m][1];
                        if constexpr (MODE == 3) {
#pragma unroll
                            for (int i = 0; i < 4; ++i) { v0[i] = gelu_tanh_f(v0[i]); v1[i] = gelu_tanh_f(v1[i]); }
                        }
                        if constexpr (MODE == 2) {
                            if (seg == 0 || seg == 4) {
#pragma unroll
                                for (int i = 0; i < 4; ++i) { v0[i] = silu_f(v0[i]); v1[i] = silu_f(v1[i]); }
                            } else if (seg >= 2) {
#pragma unroll
                                for (int i = 0; i < 4; ++i) {
                                    v0[i] = __logf(l0[i] + (1.f - l0[i]) * sigmoid_f(v0[i]));
                                    v1[i] = __logf(l1[i] + (1.f - l1[i]) * sigmoid_f(v1[i]));
                                }
                            }
                        }
                        u32x4 o;
                        o.x = cvt_pk_bf16(v0[0], v0[1]); o.y = cvt_pk_bf16(v0[2], v0[3]); o.z = cvt_pk_bf16(v1[0], v1[1]); o.w = cvt_pk_bf16(v1[2], v1[3]);
                        *(u32x4*)(O + (size_t)(row0 + ai * HALF + m * 16) * ldo + col0) = o;
                        __builtin_amdgcn_sched_barrier(0);
                    }
            }
        }
    }
};

template <class EpiT>
__device__ __forceinline__ void gemm_phase(LAS unsigned char* lds, const Gemm g, const StaticOrder& S, const EpiT& E) {
    const int tid = opaque_tid(), wid = __builtin_amdgcn_readfirstlane(tid >> 6), lane = tid & 63, wr = wid >> 2, wc = wid & 3, fr = lane & 15, fq = lane >> 4;
    const int K = g.K, nt = K / BK, lda = g.lda;
    unsigned voffA[2], voffB[2];
#pragma unroll
    for (int i = 0; i < 2; ++i) { int R, C; stage_rc(tid * 16 + i * 8192, R, C); const int Rb = (R & ~31) + perm32(R & 31);
        voffA[i] = (unsigned)(R * lda + C) * 2u; voffB[i] = (unsigned)(Rb * K + C) * 2u; }
    const size_t kstep = (size_t)(BK * 2);
    const size_t hstepA = (size_t)HALF * lda * 2, hstepB = (size_t)HALF * K * 2;
    const size_t tstepA = 2 * hstepA, tstepB = 2 * hstepB;
    const unsigned ldsw = (unsigned)wid * 1024u;
    const int aoff = lds_byte(wr * 64 + fr, fq * 8), boff = lds_byte(wc * 32 + fr, fq * 8);
#define PG8_SA(b, h) (((b) * 2 + (h)) * HTB)
#define PG8_SB(b, h) ((4 + (b) * 2 + (h)) * HTB)
#define PG8_STAGE(bufoff, gbase, voff) do { _Pragma("unroll") for (int _i = 0; _i < 2; ++_i) \
        __builtin_amdgcn_global_load_lds((const unsigned*)((const char*)(gbase) + (voff)[_i]), (LAS unsigned*)(lds + (bufoff) + ldsw + _i * 8192), 16, 0, 0); } while (0)
#define PG8_LDA(dst, b, h) do { _Pragma("unroll") for (int m = 0; m < 4; ++m) _Pragma("unroll") for (int k = 0; k < 2; ++k) dst[m][k] = *(const LAS bf16x8*)(lds + PG8_SA(b, h) + aoff + m * 2048 + k * 1024); } while (0)
#define PG8_LDB(dst, b, h) do { _Pragma("unroll") for (int n = 0; n < 2; ++n) _Pragma("unroll") for (int k = 0; k < 2; ++k) dst[n][k] = *(const LAS bf16x8*)(lds + PG8_SB(b, h) + boff + n * 2048 + k * 1024); } while (0)
#define PG8_MMA(ai, bj, At, Bt) do { __builtin_amdgcn_s_setprio(1); _Pragma("unroll") for (int m = 0; m < 4; ++m) _Pragma("unroll") for (int n = 0; n < 2; ++n) _Pragma("unroll") for (int k = 0; k < 2; ++k) \
        acc[ai][bj][m][n] = __builtin_amdgcn_mfma_f32_16x16x32_bf16(Bt[n][k], At[m][k], acc[ai][bj][m][n], 0, 0, 0); __builtin_amdgcn_s_setprio(0); } while (0)
#define PG8_WAIT_V(n) asm volatile("s_waitcnt vmcnt(" #n ")" ::: "memory")
#define PG8_WAIT_L(n) asm volatile("s_waitcnt lgkmcnt(" #n ")" ::: "memory")
#define PG8_BAR __builtin_amdgcn_s_barrier()
#define PG8_SCHED __builtin_amdgcn_sched_barrier(0)
    Unit cur, nxt; int ui = 0;
    if (!S.next(0, cur)) return;
    f32x4 acc[2][2][4][2];
#pragma unroll
    for (int a = 0; a < 2; ++a)
#pragma unroll
        for (int b = 0; b < 2; ++b)
#pragma unroll
            for (int m = 0; m < 4; ++m)
#pragma unroll
                for (int n = 0; n < 2; ++n) acc[a][b][m][n] = (f32x4){0.f, 0.f, 0.f, 0.f};
    bf16x8 At[4][2], B0[2][2], B1[2][2];
    const char* cA = (const char*)g.A + (size_t)cur.pm * tstepA; const char* cB = (const char*)g.Bt + (size_t)cur.pn * tstepB;
    PG8_STAGE(PG8_SB(0, 0), cB, voffB); PG8_STAGE(PG8_SA(0, 0), cA, voffA); PG8_STAGE(PG8_SB(0, 1), cB + hstepB, voffB); PG8_STAGE(PG8_SA(0, 1), cA + hstepA, voffA);
    if (wr == 1) PG8_BAR;
    PG8_WAIT_V(4); PG8_BAR;
    PG8_STAGE(PG8_SB(1, 0), cB + kstep, voffB); PG8_STAGE(PG8_SA(1, 0), cA + kstep, voffA); PG8_STAGE(PG8_SB(1, 1), cB + hstepB + kstep, voffB);
    PG8_WAIT_V(6); PG8_BAR;
    for (;;) {
        const bool has_next = S.next(ui + 1, nxt);
        const char* nA = has_next ? (const char*)g.A + (size_t)nxt.pm * tstepA : cA; const char* nB = has_next ? (const char*)g.Bt + (size_t)nxt.pn * tstepB : cB;
        for (int t = 0; t < nt; t += 2) {
            const bool last = (t == nt - 2);
            const char* a1 = cA + (size_t)(t + 1) * kstep;
            const char* a2 = last ? nA : cA + (size_t)(t + 2) * kstep; const char* b2 = last ? nB : cB + (size_t)(t + 2) * kstep;
            const char* a3 = a2 + kstep; const char* b3 = b2 + kstep;
            PG8_LDB(B0, 0, 0); PG8_SCHED; PG8_LDA(At, 0, 0); PG8_STAGE(PG8_SA(1, 1), a1 + hstepA, voffA);
            PG8_WAIT_L(8); PG8_BAR; PG8_WAIT_L(0); PG8_MMA(0, 0, At, B0); PG8_BAR; PG8_SCHED;
            PG8_LDB(B1, 0, 1); PG8_STAGE(PG8_SB(0, 0), b2, voffB);
            PG8_BAR; PG8_WAIT_L(0); PG8_MMA(0, 1, At, B1); PG8_BAR;
            PG8_LDA(At, 0, 1); PG8_STAGE(PG8_SA(0, 0), a2, voffA);
            PG8_BAR; PG8_WAIT_L(0); PG8_MMA(1, 0, At, B0); PG8_BAR; PG8_SCHED;
            PG8_STAGE(PG8_SB(0, 1), b2 + hstepB, voffB);
            PG8_WAIT_V(6); PG8_BAR; PG8_MMA(1, 1, At, B1); PG8_BAR;
            PG8_LDB(B0, 1, 0); PG8_SCHED; PG8_LDA(At, 1, 0); PG8_STAGE(PG8_SA(0, 1), a2 + hstepA, voffA);
            PG8_WAIT_L(8); PG8_BAR; PG8_WAIT_L(0); PG8_MMA(0, 0, At, B0); PG8_BAR; PG8_SCHED;
            PG8_LDB(B1, 1, 1); PG8_STAGE(PG8_SB(1, 0), b3, voffB);
            PG8_BAR; PG8_WAIT_L(0); PG8_MMA(0, 1, At, B1); PG8_BAR;
            PG8_LDA(At, 1, 1); PG8_STAGE(PG8_SA(1, 0), a3, voffA);
            PG8_BAR; PG8_WAIT_L(0); PG8_MMA(1, 0, At, B0); PG8_BAR; PG8_SCHED;
            PG8_STAGE(PG8_SB(1, 1), b3 + hstepB, voffB);
            PG8_WAIT_V(6); PG8_BAR; PG8_MMA(1, 1, At, B1); PG8_BAR;
        }
        E(acc, cur, wr, wc, fr, fq);
        if (!has_next) break;
#pragma unroll
        for (int a = 0; a < 2; ++a)
#pragma unroll
            for (int b = 0; b < 2; ++b)
#pragma unroll
                for (int m = 0; m < 4; ++m)
#pragma unroll
                    for (int n = 0; n < 2; ++n) acc[a][b][m][n] = (f32x4){0.f, 0.f, 0.f, 0.f};
        cur = nxt; cA = nA; cB = nB; ++ui;
    }
    PG8_WAIT_V(0);
    if (wr == 0) PG8_BAR;
    PG8_BAR;
#undef PG8_SA
#undef PG8_SB
#undef PG8_STAGE
#undef PG8_LDA
#undef PG8_LDB
#undef PG8_MMA
#undef PG8_WAIT_V
#undef PG8_WAIT_L
#undef PG8_BAR
#undef PG8_SCHED
}
}

template <int MODE>
__device__ __forceinline__ void run_gemm(LAS unsigned char* lds, const bf16_t* A, int lda, const bf16_t* Bt, int M, int N, int K, bf16_t* O, int ldo, const float* lb) {
    pg8::Gemm g{A, lda, Bt, M, N, K};
    pg8::StaticOrder S; S.init(M, N, gridDim.x, blockIdx.x);
    pg8::Epi<MODE> E{O, ldo, lb};
    pg8::gemm_phase(lds, g, S, E);
}

__device__ __forceinline__ void p0_mod_item(const Params& p, LAS unsigned char* lds, int item) {
    const int tid = opaque_tid();
    const int layer = item / 144, cgp = item % 144, col0 = cgp * 64;
    const float* c = p.in[1]; const float* cctx = p.in[3];
    const float* W = p.in[4] + (size_t)layer * 1024 * 9216; const float* bias = p.in[5] + (size_t)layer * 9216;
    float* mout = (float*)(p.ws + WS_MOD) + (size_t)layer * 33 * 9216;
    LAS float* S = (LAS float*)lds;
    __syncthreads();
    for (int i = tid; i < 33 * 1024; i += NTHREADS) { const int r = i >> 10, k = i & 1023; const float v = r < 32 ? c[r * 1024 + k] : cctx[k]; S[i] = silu_f(v); }
    __syncthreads();
    const int col = tid & 63, ks = tid >> 6;
    float acc[33];
#pragma unroll
    for (int r = 0; r < 33; ++r) acc[r] = 0.f;
    for (int k4 = 0; k4 < 32; ++k4) {
        const int k = ks * 128 + k4 * 4;
        const float w0 = W[(size_t)(k + 0) * 9216 + col0 + col], w1 = W[(size_t)(k + 1) * 9216 + col0 + col], w2 = W[(size_t)(k + 2) * 9216 + col0 + col], w3 = W[(size_t)(k + 3) * 9216 + col0 + col];
#pragma unroll
        for (int r = 0; r < 33; ++r) { const f32x4 s4 = *(const LAS f32x4*)(S + r * 1024 + k); acc[r] += w0 * s4[0] + w1 * s4[1] + w2 * s4[2] + w3 * s4[3]; }
    }
    __syncthreads();
    LAS float* red = (LAS float*)lds;
#pragma unroll
    for (int r = 0; r < 33; ++r) red[(ks * 33 + r) * 64 + col] = acc[r];
    __syncthreads();
    for (int i = tid; i < 33 * 64; i += NTHREADS) {
        const int r = i >> 6, cc = i & 63; float s = 0.f;
#pragma unroll
        for (int q = 0; q < 8; ++q) s += red[(q * 33 + r) * 64 + cc];
        mout[(size_t)r * 9216 + col0 + cc] = s + bias[col0 + cc];
    }
    __syncthreads();
}

__device__ __forceinline__ void p0_transpose_item(const float* W, int K, int N, bf16_t* WT, int k0, int n0, int drow0, LAS float* scr, int lane) {
#pragma unroll 8
    for (int i = 0; i < 32; ++i) { const int kk = 2 * i + (lane >> 5); scr[kk * 33 + (lane & 31)] = W[(size_t)(k0 + kk) * N + n0 + (lane & 31)]; }
    asm volatile("s_waitcnt lgkmcnt(0)" ::: "memory");
    const int c = lane & 7;
#pragma unroll
    for (int j = 0; j < 4; ++j) { const int n = (lane >> 3) + 8 * j; const LAS float* s = scr + (8 * c) * 33 + n;
        u32x4 o; o.x = cvt_pk_bf16(s[0 * 33], s[1 * 33]); o.y = cvt_pk_bf16(s[2 * 33], s[3 * 33]); o.z = cvt_pk_bf16(s[4 * 33], s[5 * 33]); o.w = cvt_pk_bf16(s[6 * 33], s[7 * 33]);
        *(u32x4*)(WT + (size_t)(drow0 + n) * K + k0 + 8 * c) = o; }
    asm volatile("s_waitcnt lgkmcnt(0)" ::: "memory");
}

__device__ __forceinline__ void phase0(const Params& p, LAS unsigned char* lds) {
    const int tid = opaque_tid(), wid = tid >> 6, lane = tid & 63;
    if (blockIdx.x == gridDim.x - 1) {
        const float* lbp = p.in[11]; float* lbo = (float*)(p.ws + WS_LB);
        for (int i = tid; i < 2048; i += NTHREADS) { const int dir = i >> 10, col = i & 1023;
            const float l0 = lbp[(dir * 3 + 0) * 1024 + col], l1 = lbp[(dir * 3 + 1) * 1024 + col], l2 = lbp[(dir * 3 + 2) * 1024 + col];
            const float mx = fmaxf(l0, fmaxf(l1, l2)); const float e0 = __expf(l0 - mx), e1 = __expf(l1 - mx), e2 = __expf(l2 - mx);
            lbo[i] = e0 / (e0 + e1 + e2); }
    }
    for (int it = blockIdx.x; it < 288; it += gridDim.x) p0_mod_item(p, lds, it);
    __syncthreads();
    LAS float* scr = (LAS float*)lds + wid * (64 * 33);
    const int gw = blockIdx.x * 8 + wid, nw = gridDim.x * 8;
    for (int mi = 0; mi < 12; ++mi) {
        const float* W; bf16_t* WT; int K, N, mode = 0;
        if (mi < 4) { W = p.in[8] + (size_t)mi * 1024 * 5632; WT = (bf16_t*)(p.ws + WS_FIN) + (size_t)mi * 5632 * 1024; K = 1024; N = 5632; mode = 1; }
        else if (mi < 8) { W = p.in[9] + (size_t)(mi - 4) * 2816 * 1024; WT = (bf16_t*)(p.ws + WS_FOUT) + (size_t)(mi - 4) * 1024 * 2816; K = 2816; N = 1024; }
        else if (mi == 8) { W = p.in[10]; WT = (bf16_t*)(p.ws + WS_HIN); K = 1024; N = 5120; }
        else if (mi == 9) { W = p.in[13]; WT = (bf16_t*)(p.ws + WS_HOUT); K = 1024; N = 1024; }
        else if (mi == 10) { W = p.in[14]; WT = (bf16_t*)(p.ws + WS_CIN); K = 1024; N = 6144; }
        else { W = p.in[19]; WT = (bf16_t*)(p.ws + WS_COUT); K = 3072; N = 1024; }
        const int nblk = N / 32, nitems = (K / 64) * nblk;
        for (int it = gw; it < nitems; it += nw) {
            const int kb = it / nblk, nb = it % nblk, n0 = nb * 32;
            int drow0 = n0;
            if (mode == 1) { const int j = n0 < FH ? n0 : n0 - FH; drow0 = 256 * (j >> 7) + (n0 < FH ? 0 : 128) + (j & 127); }
            p0_transpose_item(W, K, N, WT, kb * 64, n0, drow0, scr, lane);
        }
    }
}

struct RowArgs {
    const float* xs_x; const float* xs_c; int nrows;
    const bf16_t* y; float ysc; const float* m; int k; const float* g; const float* b;
    float* xd; bf16_t* hd; const float* m2; int k2;
};
__device__ __forceinline__ void row_phase(const RowArgs& a) {
    const int tid0 = opaque_tid(); const int wid = tid0 >> 6, lane = tid0 & 63;
    for (int row = blockIdx.x * 8 + wid; row < a.nrows; row += gridDim.x * 8) {
        const int mrow = row < MX ? (row >> 11) : 32;
        const float* xr = row < MX ? a.xs_x + (size_t)row * D : a.xs_c + (size_t)(row - MX) * D;
        f32x4 v[4];
#pragma unroll
        for (int j = 0; j < 4; ++j) v[j] = *(const f32x4*)(xr + j * 256 + lane * 4);
        if (a.y) {
            const float* gp = a.m + (size_t)mrow * 9216 + (3 * a.k + 2) * 1024;
            float s = 0.f;
#pragma unroll
            for (int j = 0; j < 4; ++j) {
                const u32x2 yy = *(const u32x2*)(a.y + (size_t)row * D + j * 256 + lane * 4);
                const f32x4 gt = *(const f32x4*)(gp + j * 256 + lane * 4);
                v[j][0] = DN_ALPHA * v[j][0] + gt[0] * a.ysc * bf_lo(yy.x); v[j][1] = DN_ALPHA * v[j][1] + gt[1] * a.ysc * bf_hi(yy.x);
                v[j][2] = DN_ALPHA * v[j][2] + gt[2] * a.ysc * bf_lo(yy.y); v[j][3] = DN_ALPHA * v[j][3] + gt[3] * a.ysc * bf_hi(yy.y);
                s += (v[j][0] + v[j][1]) + (v[j][2] + v[j][3]);
            }
            const float mean = wave_sum(s) * (1.f / D); float s2 = 0.f;
#pragma unroll
            for (int j = 0; j < 4; ++j) { v[j] = v[j] - mean; s2 += (v[j][0] * v[j][0] + v[j][1] * v[j][1]) + (v[j][2] * v[j][2] + v[j][3] * v[j][3]); }
            const float rstd = __builtin_amdgcn_rsqf(wave_sum(s2) * (1.f / D) + LN_EPS);
#pragma unroll
            for (int j = 0; j < 4; ++j) { const f32x4 gg = *(const f32x4*)(a.g + j * 256 + lane * 4), bb = *(const f32x4*)(a.b + j * 256 + lane * 4); v[j] = v[j] * rstd * gg + bb; }
            if (a.xd && row < MX) {
#pragma unroll
                for (int j = 0; j < 4; ++j) *(f32x4*)(a.xd + (size_t)row * D + j * 256 + lane * 4) = v[j];
            }
        }
        if (a.hd) {
            const float* shp = a.m2 + (size_t)mrow * 9216 + (3 * a.k2) * 1024; const float* scp = shp + 1024;
#pragma unroll
            for (int j = 0; j < 4; ++j) {
                const f32x4 sh = *(const f32x4*)(shp + j * 256 + lane * 4), sc = *(const f32x4*)(scp + j * 256 + lane * 4);
                const f32x4 h = v[j] * (sc + 1.f) + sh;
                u32x2 o; o.x = cvt_pk_bf16(h[0], h[1]); o.y = cvt_pk_bf16(h[2], h[3]);
                *(u32x2*)(a.hd + (size_t)row * D + j * 256 + lane * 4) = o;
            }
        }
    }
}

__device__ __forceinline__ void gla_phase(const Params& p, LAS unsigned char* lds) {
    const int tid = opaque_tid(), dir = tid >> 8, tl = tid & 255, e = tl >> 1, half = tl & 1;
    bf16_t* P = (bf16_t*)(p.ws + WS_BIG); bf16_t* R = (bf16_t*)(p.ws + WS_A0);
    const float* normw = p.in[12];
    LAS float* Fs = (LAS float*)(lds + dir * 65536);
    LAS float* Qs = Fs + 4096; LAS float* Vs = Qs + 4096; LAS float* Os = Vs + 4096;
    const int rsub = tl >> 4, cgp = tl & 15;
    for (int item = blockIdx.x; item < NB * 8; item += gridDim.x) {
        const int b = item >> 3, h = item & 7;
        f32x2 S2[32];
#pragma unroll
        for (int i = 0; i < 32; ++i) S2[i] = (f32x2){0.f, 0.f};
        u32x4 rq[2], rv[2], rf[2];
        auto tile_row = [&](int ti, int j) -> size_t {
            const bool isc = ti < 8; const int lt = isc ? ti : ti - 8, L = isc ? CTXL : SEQ; const int base = isc ? MX + b * CTXL : b * SEQ;
            const int tok = dir == 0 ? 32 * lt + j : L - 1 - (32 * lt + j);
            return (size_t)(base + tok);
        };
        auto load_tile = [&](int ti) {
#pragma unroll
            for (int pp = 0; pp < 2; ++pp) { const bf16_t* rp = P + tile_row(ti, rsub + 16 * pp) * HG5 + h * 128 + 8 * cgp;
                rq[pp] = *(const u32x4*)(rp); rv[pp] = *(const u32x4*)(rp + 1024); rf[pp] = *(const u32x4*)(rp + (2 + dir) * 1024); }
        };
        auto store_tile = [&]() {
#pragma unroll
            for (int pp = 0; pp < 2; ++pp) { const int o = (rsub + 16 * pp) * 128 + 8 * cgp;
                *(LAS f32x4*)(Qs + o) = (f32x4){bf_lo(rq[pp].x), bf_hi(rq[pp].x), bf_lo(rq[pp].y), bf_hi(rq[pp].y)};
                *(LAS f32x4*)(Qs + o + 4) = (f32x4){bf_lo(rq[pp].z), bf_hi(rq[pp].z), bf_lo(rq[pp].w), bf_hi(rq[pp].w)};
                *(LAS f32x4*)(Vs + o) = (f32x4){bf_lo(rv[pp].x), bf_hi(rv[pp].x), bf_lo(rv[pp].y), bf_hi(rv[pp].y)};
                *(LAS f32x4*)(Vs + o + 4) = (f32x4){bf_lo(rv[pp].z), bf_hi(rv[pp].z), bf_lo(rv[pp].w), bf_hi(rv[pp].w)};
                *(LAS f32x4*)(Fs + o) = (f32x4){__expf(bf_lo(rf[pp].x)), __expf(bf_hi(rf[pp].x)), __expf(bf_lo(rf[pp].y)), __expf(bf_hi(rf[pp].y))};
                *(LAS f32x4*)(Fs + o + 4) = (f32x4){__expf(bf_lo(rf[pp].z)), __expf(bf_hi(rf[pp].z)), __expf(bf_lo(rf[pp].w)), __expf(bf_hi(rf[pp].w))}; }
        };
        __syncthreads();
        load_tile(0); store_tile();
        __syncthreads();
        for (int ti = 0; ti < 72; ++ti) {
            if (ti + 1 < 72) load_tile(ti + 1);
            const bool isc = ti < 8;
            for (int j = 0; j < 32; ++j) {
                const float v = Vs[j * 128 + e];
                const f32x2 vv = {v, v};
                f32x2 o2 = {0.f, 0.f};
#pragma unroll
                for (int i = 0; i < 16; ++i) {
                    const f32x4 f4 = *(const LAS f32x4*)(Fs + j * 128 + half * 64 + 4 * i);
                    const f32x4 q4 = *(const LAS f32x4*)(Qs + j * 128 + half * 64 + 4 * i);
                    const f32x2 fa = {f4[0], f4[1]}, fb = {f4[2], f4[3]}, qa = {q4[0], q4[1]}, qb = {q4[2], q4[3]};
                    S2[2 * i] = fa * (S2[2 * i] - vv) + vv;
                    S2[2 * i + 1] = fb * (S2[2 * i + 1] - vv) + vv;
                    o2 += S2[2 * i] * qa + S2[2 * i + 1] * qb;
                }
                float o = o2[0] + o2[1]; o += __shfl_xor(o, 1);
                if (half == 0) Os[j * 128 + e] = o;
            }
            __syncthreads();
            if (!isc) {
#pragma unroll
                for (int pp = 0; pp < 2; ++pp) { const int j = rsub + 16 * pp; const LAS float* op = Os + j * 128 + 8 * cgp;
                    const f32x4 a0 = *(const LAS f32x4*)op, a1 = *(const LAS f32x4*)(op + 4);
                    u32x4 o; o.x = cvt_pk_bf16(a0[0], a0[1]); o.y = cvt_pk_bf16(a0[2], a0[3]); o.z = cvt_pk_bf16(a1[0], a1[1]); o.w = cvt_pk_bf16(a1[2], a1[3]);
                    *(u32x4*)(P + tile_row(ti, j) * HG5 + (2 + dir) * 1024 + h * 128 + 8 * cgp) = o; }
            }
            if (ti + 1 < 72) store_tile();
            __syncthreads();
        }
        __threadfence(); __syncthreads(); __threadfence();
        {
            const int wid = tid >> 6, lane = tid & 63, sub = lane >> 4, l16 = lane & 15;
            const f32x4 w0 = *(const f32x4*)(normw + 8 * l16), w1 = *(const f32x4*)(normw + 8 * l16 + 4);
#pragma unroll 4
            for (int it = 0; it < 64; ++it) {
                const int t = it * 32 + wid * 4 + sub; const size_t row = (size_t)b * SEQ + t;
                const bf16_t* rp = P + row * HG5 + h * 128 + 8 * l16;
                const u32x4 of = *(const u32x4*)(rp + 2048), ob = *(const u32x4*)(rp + 3072), gg = *(const u32x4*)(rp + 4096);
                float o[8];
                o[0] = bf_lo(of.x) + bf_lo(ob.x); o[1] = bf_hi(of.x) + bf_hi(ob.x); o[2] = bf_lo(of.y) + bf_lo(ob.y); o[3] = bf_hi(of.y) + bf_hi(ob.y);
                o[4] = bf_lo(of.z) + bf_lo(ob.z); o[5] = bf_hi(of.z) + bf_hi(ob.z); o[6] = bf_lo(of.w) + bf_lo(ob.w); o[7] = bf_hi(of.w) + bf_hi(ob.w);
                float ss = 0.f;
#pragma unroll
                for (int i = 0; i < 8; ++i) ss += o[i] * o[i];
                ss += __shfl_xor(ss, 1); ss += __shfl_xor(ss, 2); ss += __shfl_xor(ss, 4); ss += __shfl_xor(ss, 8);
                const float rs = __builtin_amdgcn_rsqf(ss * (1.f / 128.f) + RMS_EPS);
                u32x4 r;
                r.x = cvt_pk_bf16(o[0] * rs * w0[0] * bf_lo(gg.x), o[1] * rs * w0[1] * bf_hi(gg.x));
                r.y = cvt_pk_bf16(o[2] * rs * w0[2] * bf_lo(gg.y), o[3] * rs * w0[3] * bf_hi(gg.y));
                r.z = cvt_pk_bf16(o[4] * rs * w1[0] * bf_lo(gg.z), o[5] * rs * w1[1] * bf_hi(gg.z));
                r.w = cvt_pk_bf16(o[6] * rs * w1[2] * bf_lo(gg.w), o[7] * rs * w1[3] * bf_hi(gg.w));
                *(u32x4*)(R + row * D + h * 128 + 8 * l16) = r;
            }
        }
        __syncthreads();
    }
}

__device__ __forceinline__ void cm_gate_phase(const Params& p, LAS unsigned char* lds) {
    const int tid = opaque_tid(), wid = tid >> 6, lane = tid & 63, fr = lane & 15, fq = lane >> 4;
    bf16_t* UV = (bf16_t*)(p.ws + WS_BIG);
    const float* vg = p.in[15]; const float* vb = p.in[16]; const float* ws_ = p.in[17]; const float* bs = p.in[18];
    LAS bf16_t* Wl = (LAS bf16_t*)lds; LAS bf16_t* Vl = (LAS bf16_t*)(lds + 34816); LAS float* st = (LAS float*)(lds + 34816 + 100352);
    for (int ch = blockIdx.x; ch < MX / 128; ch += gridDim.x) {
        const size_t row0 = (size_t)ch * 128;
        __syncthreads();
        for (int rr = 0; rr < 16; ++rr) {
            const int r = wid * 16 + rr; const bf16_t* vp = UV + (row0 + r) * 6144 + 3072;
            u32x4 x[6]; float s = 0.f;
#pragma unroll
            for (int i = 0; i < 6; ++i) { x[i] = *(const u32x4*)(vp + (i * 64 + lane) * 8);
                s += (bf_lo(x[i].x) + bf_hi(x[i].x)) + (bf_lo(x[i].y) + bf_hi(x[i].y)) + (bf_lo(x[i].z) + bf_hi(x[i].z)) + (bf_lo(x[i].w) + bf_hi(x[i].w)); }
            const float mean = wave_sum(s) * (1.f / 3072.f); float s2 = 0.f;
#pragma unroll
            for (int i = 0; i < 6; ++i) { float d;
                d = bf_lo(x[i].x) - mean; s2 += d * d; d = bf_hi(x[i].x) - mean; s2 += d * d; d = bf_lo(x[i].y) - mean; s2 += d * d; d = bf_hi(x[i].y) - mean; s2 += d * d;
                d = bf_lo(x[i].z) - mean; s2 += d * d; d = bf_hi(x[i].z) - mean; s2 += d * d; d = bf_lo(x[i].w) - mean; s2 += d * d; d = bf_hi(x[i].w) - mean; s2 += d * d; }
            const float rstd = __builtin_amdgcn_rsqf(wave_sum(s2) * (1.f / 3072.f) + LN_EPS);
            if (lane == 0) { st[2 * r] = mean; st[2 * r + 1] = rstd; }
        }
        for (int g = 0; g < 8; ++g) {
            __syncthreads();
#pragma unroll
            for (int i = 0; i < 8; ++i) { const int idx = tid + NTHREADS * i, r = idx >> 5, c4 = idx & 31;
                const f32x4 w = *(const f32x4*)(ws_ + (size_t)g * 16384 + r * 128 + c4 * 4);
                u32x2 o; o.x = cvt_pk_bf16(w[0], w[1]); o.y = cvt_pk_bf16(w[2], w[3]);
                *(LAS u32x2*)(Wl + r * 136 + c4 * 4) = o; }
#pragma unroll 4
            for (int i = 0; i < 12; ++i) { const int task = tid + NTHREADS * i, s = task / 48, c8 = task % 48;
                const u32x4 x = *(const u32x4*)(UV + (row0 + s) * 6144 + 3072 + g * 384 + c8 * 8);
                const float mean = st[2 * s], rstd = st[2 * s + 1];
                const float* gp = vg + g * 384 + c8 * 8; const float* bp = vb + g * 384 + c8 * 8;
                const f32x4 g0 = *(const f32x4*)gp, g1 = *(const f32x4*)(gp + 4), b0 = *(const f32x4*)bp, b1 = *(const f32x4*)(bp + 4);
                u32x4 o;
                o.x = cvt_pk_bf16((bf_lo(x.x) - mean) * rstd * g0[0] + b0[0], (bf_hi(x.x) - mean) * rstd * g0[1] + b0[1]);
                o.y = cvt_pk_bf16((bf_lo(x.y) - mean) * rstd * g0[2] + b0[2], (bf_hi(x.y) - mean) * rstd * g0[3] + b0[3]);
                o.z = cvt_pk_bf16((bf_lo(x.z) - mean) * rstd * g1[0] + b1[0], (bf_hi(x.z) - mean) * rstd * g1[1] + b1[1]);
                o.w = cvt_pk_bf16((bf_lo(x.w) - mean) * rstd * g1[2] + b1[2], (bf_hi(x.w) - mean) * rstd * g1[3] + b1[3]);
                *(LAS u32x4*)(Vl + s * 392 + c8 * 8) = o; }
            __syncthreads();
            f32x4 acc[3][8];
#pragma unroll
            for (int n = 0; n < 3; ++n)
#pragma unroll
                for (int m = 0; m < 8; ++m) acc[n][m] = (f32x4){0.f, 0.f, 0.f, 0.f};
#pragma unroll 1
            for (int ks = 0; ks < 4; ++ks) {
                bf16x8 af[3];
#pragma unroll
                for (int n = 0; n < 3; ++n) {
                    const LAS bf16_t* vp = Vl + (32 * ks + 8 * fq) * 392 + wid * 48 + n * 16 + fr;
#pragma unroll
                    for (int i = 0; i < 8; ++i) af[n][i] = (short)vp[i * 392];
                }
#pragma unroll
                for (int m = 0; m < 8; ++m) {
                    const bf16x8 bfrag = *(const LAS bf16x8*)(Wl + (16 * m + fr) * 136 + 32 * ks + 8 * fq);
#pragma unroll
                    for (int n = 0; n < 3; ++n) acc[n][m] = __builtin_amdgcn_mfma_f32_16x16x32_bf16(af[n], bfrag, acc[n][m], 0, 0, 0);
                }
            }
#pragma unroll
            for (int m = 0; m < 8; ++m) {
                const int t = 16 * m + fr; const float bias = bs[g * 128 + t];
#pragma unroll
                for (int n = 0; n < 3; ++n) {
                    bf16_t* up = UV + (row0 + t) * 6144 + g * 384 + wid * 48 + n * 16 + 4 * fq;
                    const u32x2 uu = *(const u32x2*)up;
                    u32x2 o; o.x = cvt_pk_bf16(bf_lo(uu.x) * (acc[n][m][0] + bias), bf_hi(uu.x) * (acc[n][m][1] + bias));
                    o.y = cvt_pk_bf16(bf_lo(uu.y) * (acc[n][m][2] + bias), bf_hi(uu.y) * (acc[n][m][3] + bias));
                    *(u32x2*)up = o;
                }
                __builtin_amdgcn_sched_barrier(0);
            }
        }
    }
}

#ifndef EN_MASK
#define EN_MASK 255
#endif
constexpr int EN = EN_MASK;
__global__ void __launch_bounds__(NTHREADS, 2) fwd_megakernel(Params p) {
    extern __shared__ __attribute__((aligned(16))) unsigned char lds_raw[];
    LAS unsigned char* lds = (LAS unsigned char*)lds_raw;
    cg::grid_group grid = cg::this_grid();
    const float* x_in = p.in[0]; const float* ctx_in = p.in[2];
    const float* mod0 = (const float*)(p.ws + WS_MOD); const float* mod1 = mod0 + (size_t)33 * 9216;
    const float* lbv = (const float*)(p.ws + WS_LB);
    const float* ln_g = p.in[6]; const float* ln_b = p.in[7];
    bf16_t* A0 = (bf16_t*)(p.ws + WS_A0); bf16_t* BIG = (bf16_t*)(p.ws + WS_BIG);
    const bf16_t* FIN = (const bf16_t*)(p.ws + WS_FIN); const bf16_t* FOUT = (const bf16_t*)(p.ws + WS_FOUT);
    const bf16_t* HIN = (const bf16_t*)(p.ws + WS_HIN); const bf16_t* HOUT = (const bf16_t*)(p.ws + WS_HOUT);
    const bf16_t* CIN = (const bf16_t*)(p.ws + WS_CIN); const bf16_t* COUT = (const bf16_t*)(p.ws + WS_COUT);
    const size_t FIN_SZ = (size_t)5632 * 1024, FOUT_SZ = (size_t)1024 * 2816;
    for (int ph = p.ph_lo; ph < p.ph_hi; ++ph) {
        int kind;
        switch (ph) {
        case 0: kind = 0; break;
        case 1: case 4: case 8: case 11: case 14: case 18: case 21: kind = 1; break;
        case 2: case 9: case 12: case 19: kind = 2; break;
        case 3: case 7: case 10: case 13: case 17: case 20: kind = 3; break;
        case 5: kind = 4; break;
        case 6: kind = 5; break;
        case 15: kind = 6; break;
        default: kind = 7; break;
        }
        if (kind == 0) { if (EN & 1) phase0(p, lds); }
        else if (kind == 1) {
            RowArgs a;
            a.xs_x = p.out; a.xs_c = nullptr; a.nrows = MX; a.y = A0; a.ysc = 0.5f; a.xd = p.out; a.hd = A0;
            if (ph == 1) { a.xs_x = x_in; a.xs_c = ctx_in; a.nrows = MT; a.y = nullptr; a.m = mod0; a.k = 0; a.g = ln_g; a.b = ln_b; a.m2 = mod0; a.k2 = 0; }
            else if (ph == 4) { a.xs_x = x_in; a.xs_c = ctx_in; a.nrows = MT; a.m = mod0; a.k = 0; a.g = ln_g + 0 * D; a.b = ln_b + 0 * D; a.m2 = mod0; a.k2 = 1; }
            else if (ph == 8) { a.y = BIG; a.ysc = 1.f; a.m = mod0; a.k = 1; a.g = ln_g + 1 * D; a.b = ln_b + 1 * D; a.m2 = mod0; a.k2 = 2; }
            else if (ph == 11) { a.m = mod0; a.k = 2; a.g = ln_g + 2 * D; a.b = ln_b + 2 * D; a.m2 = mod1; a.k2 = 0; }
            else if (ph == 14) { a.m = mod1; a.k = 0; a.g = ln_g + 3 * D; a.b = ln_b + 3 * D; a.m2 = mod1; a.k2 = 1; }
            else if (ph == 18) { a.ysc = 1.f; a.m = mod1; a.k = 1; a.g = ln_g + 4 * D; a.b = ln_b + 4 * D; a.m2 = mod1; a.k2 = 2; }
            else { a.m = mod1; a.k = 2; a.g = ln_g + 5 * D; a.b = ln_b + 5 * D; a.hd = nullptr; a.m2 = mod1; a.k2 = 0; }
            if (EN & 2) row_phase(a);
        } else if (kind == 2) {
            const int wi = ph == 2 ? 0 : (ph == 9 ? 1 : (ph == 12 ? 2 : 3));
            if (EN & 4) run_gemm<1>(lds, A0, D, FIN + wi * FIN_SZ, ph == 2 ? MT : MX, 2 * FH, D, BIG, FH, nullptr);
        } else if (kind == 3) {
            const bf16_t* A = BIG; int lda = FH, M = MX, K = FH; const bf16_t* Bt; bf16_t* O = A0;
            if (ph == 3) { Bt = FOUT; M = MT; }
            else if (ph == 7) { A = A0; lda = D; K = D; Bt = HOUT; O = BIG; }
            else if (ph == 10) Bt = FOUT + 1 * FOUT_SZ;
            else if (ph == 13) Bt = FOUT + 2 * FOUT_SZ;
            else if (ph == 17) { lda = 2 * CMI; K = CMI; Bt = COUT; }
            else Bt = FOUT + 3 * FOUT_SZ;
            if (EN & 8) run_gemm<0>(lds, A, lda, Bt, M, D, K, O, D, nullptr);
        } else if (kind == 4) { if (EN & 16) run_gemm<2>(lds, A0, D, HIN, MT, HG5, D, BIG, HG5, lbv); }
        else if (kind == 5) { if (EN & 32) gla_phase(p, lds); }
        else if (kind == 6) { if (EN & 64) run_gemm<3>(lds, A0, D, CIN, MX, 2 * CMI, D, BIG, 2 * CMI, nullptr); }
        else { if (EN & 128) cm_gate_phase(p, lds); }
        if (ph + 1 < p.ph_hi) grid.sync();
    }
}

extern "C" void kernel_launch(void* const* d_in, const int* in_sizes, int n_in, void* d_out, int out_size, void* d_ws, size_t ws_size, hipStream_t stream) {
    static int grid_blocks = 0;
    if (grid_blocks == 0) {
        if (n_in != 20 || out_size != MX * D || ws_size < WS_END) { fprintf(stderr, "kernel_launch: unexpected shapes (n_in %d out %d ws %zu need %zu)\n", n_in, out_size, ws_size, (size_t)WS_END); grid_blocks = -1; return; }
        int dev = 0, cus = 0, per_cu = 0;
        hipGetDevice(&dev);
        hipDeviceGetAttribute(&cus, hipDeviceAttributeMultiprocessorCount, dev);
        if (hipFuncSetAttribute((const void*)fwd_megakernel, hipFuncAttributeMaxDynamicSharedMemorySize, LDS_BYTES) != hipSuccess) { fprintf(stderr, "kernel_launch: hipFuncSetAttribute failed\n"); grid_blocks = -1; return; }
        if (hipOccupancyMaxActiveBlocksPerMultiprocessor(&per_cu, (const void*)fwd_megakernel, NTHREADS, LDS_BYTES) != hipSuccess || per_cu < 1) { fprintf(stderr, "kernel_launch: occupancy query says %d\n", per_cu); per_cu = 1; }
        (void)hipGetLastError();
        grid_blocks = cus * 1;
    }
    if (grid_blocks < 0) return;
    Params p{};
    for (int i = 0; i < 20; ++i) p.in[i] = (const float*)d_in[i];
    p.out = (float*)d_out; p.ws = (unsigned char*)d_ws; p.ph_lo = 0; p.ph_hi = 22;
    void* args[] = {&p};
    hipError_t e = hipLaunchCooperativeKernel((const void*)fwd_megakernel, dim3(grid_blocks), dim3(NTHREADS), args, LDS_BYTES, stream);
    if (e != hipSuccess) fprintf(stderr, "cooperative launch failed: %s (grid %d)\n", hipGetErrorString(e), grid_blocks);
}
```

```cpp
#include <hip/hip_runtime.h>
#include <hip/hip_cooperative_groups.h>
#include <cstdio>
#include <cstdint>
namespace cg = cooperative_groups;

#define LAS __attribute__((address_space(3)))
typedef unsigned short bf16_t;
typedef short bf16x8 __attribute__((ext_vector_type(8)));
typedef float f32x4 __attribute__((ext_vector_type(4)));
typedef float f32x2 __attribute__((ext_vector_type(2)));
typedef unsigned u32x4 __attribute__((ext_vector_type(4)));
typedef unsigned u32x2 __attribute__((ext_vector_type(2)));

constexpr int D = 1024, NB = 32, SEQ = 2048, CTXL = 256;
constexpr int MX = NB * SEQ;
constexpr int MC = NB * CTXL;
constexpr int MT = MX + MC;
constexpr int FH = 2816, HG5 = 5 * D, CMI = 3072, NMOD = 9;
constexpr float DN_ALPHA = 1.41421356237309515f;
constexpr float LN_EPS = 1e-5f, RMS_EPS = 1e-6f;
constexpr int LDS_BYTES = 149504;
constexpr int NTHREADS = 512;

constexpr size_t WS_MOD = 0;
constexpr size_t WS_LB = WS_MOD + (size_t)2 * 33 * 9216 * 4;
constexpr size_t WS_FIN = WS_LB + 2 * 1024 * 4;
constexpr size_t WS_FOUT = WS_FIN + (size_t)4 * 5632 * 1024 * 2;
constexpr size_t WS_HIN = WS_FOUT + (size_t)4 * 1024 * 2816 * 2;
constexpr size_t WS_HOUT = WS_HIN + (size_t)5120 * 1024 * 2;
constexpr size_t WS_CIN = WS_HOUT + (size_t)1024 * 1024 * 2;
constexpr size_t WS_COUT = WS_CIN + (size_t)6144 * 1024 * 2;
constexpr size_t WS_A0 = WS_COUT + (size_t)1024 * 3072 * 2;
constexpr size_t WS_BIG = WS_A0 + (size_t)MT * 1024 * 2;
constexpr size_t WS_END = WS_BIG + (size_t)MX * 6144 * 2;

struct Params {
    const float* in[20];
    float* out;
    unsigned char* ws;
    int ph_lo, ph_hi;
};

__device__ __forceinline__ unsigned cvt_pk_bf16(float lo, float hi) { unsigned r; asm volatile("v_cvt_pk_bf16_f32 %0, %1, %2" : "=v"(r) : "v"(lo), "v"(hi)); return r; }
__device__ __forceinline__ int opaque_tid() { int t = threadIdx.x; asm volatile("" : "+v"(t)); return t; }
__device__ __forceinline__ float bf_lo(unsigned u) { return __uint_as_float(u << 16); }
__device__ __forceinline__ float bf_hi(unsigned u) { return __uint_as_float(u & 0xffff0000u); }
__device__ __forceinline__ float wave_sum(float v) {
#pragma unroll
    for (int o = 1; o < 64; o <<= 1) v += __shfl_xor(v, o);
    return v;
}
__device__ __forceinline__ float sigmoid_f(float x) { return __builtin_amdgcn_rcpf(1.f + __expf(-x)); }
__device__ __forceinline__ float silu_f(float x) { return x * sigmoid_f(x); }
__device__ __forceinline__ float gelu_tanh_f(float x) { const float u = 0.7978845608028654f * (x + 0.044715f * x * x * x); return x * sigmoid_f(2.f * u); }

namespace pg8 {
constexpr int BM = 256, BK = 64, HALF = 128, HTB = HALF * BK * 2, STAGE_BYTES = 8 * HTB, NXCD = 8, WGM = 8;
__host__ __device__ __forceinline__ int lds_byte(int r, int c) { const int st = (r >> 4) * 2 + (c >> 5), rr = r & 15, cc = c & 31, ob = rr * 64 + cc * 2; return st * 1024 + (ob ^ (((ob >> 9) & 1) << 5)); }
__host__ __device__ __forceinline__ void stage_rc(int b, int& R, int& C) { const int st = b / 1024, sb = b % 1024, swz = sb ^ (((sb >> 9) & 1) << 5); R = (st >> 1) * 16 + swz / 64; C = (st & 1) * 32 + (swz % 64) / 2; }
__host__ __device__ __forceinline__ int perm32(int rho) { const int n = rho >> 4, i = rho & 15; return 8 * (i >> 2) + 4 * n + (i & 3); }

struct Unit { int pm, pn; };
struct Gemm { const bf16_t* A; int lda; const bf16_t* Bt; int M, N, K; };

struct StaticOrder {
    int nM, nN, nwg, G, c;
    __device__ void init(int M, int N, int G_, int c_) { nM = M / BM; nN = N / BM; nwg = nM * nN; G = G_; c = c_; }
    __device__ bool next(int i, Unit& u) const {
        const long L = (long)i * G + c; if (L >= nwg) return false;
        int wgid = (int)L; { const int q = nwg / NXCD, r = nwg % NXCD, xcd = wgid % NXCD, off = wgid / NXCD; wgid = (xcd < r ? xcd * (q + 1) : r * (q + 1) + (xcd - r) * q) + off; }
        const int nig = WGM * nN, gid = wgid / nig, fm = gid * WGM, gsz = (nM - fm) < WGM ? (nM - fm) : WGM;
        u.pm = fm + ((wgid % nig) % gsz); u.pn = (wgid % nig) / gsz; return true;
    }
};

template <int MODE> struct Epi {
    bf16_t* O; int ldo; const float* lb;
    __device__ __forceinline__ void operator()(const f32x4 (&acc)[2][2][4][2], const Unit& u, int wr, int wc, int fr, int fq) const {
        const int row0 = u.pm * BM + wr * 64 + fr;
        if constexpr (MODE == 1) {
            const int col0 = u.pn * 128 + wc * 32 + 8 * fq;
#pragma unroll
            for (int ai = 0; ai < 2; ++ai)
#pragma unroll
                for (int m = 0; m < 4; ++m) {
                    const f32x4 g0 = acc[ai][0][m][0], g1 = acc[ai][0][m][1], u0 = acc[ai][1][m][0], u1 = acc[ai][1][m][1];
                    u32x4 o;
                    o.x = cvt_pk_bf16(silu_f(g0[0]) * u0[0], silu_f(g0[1]) * u0[1]);
                    o.y = cvt_pk_bf16(silu_f(g0[2]) * u0[2], silu_f(g0[3]) * u0[3]);
                    o.z = cvt_pk_bf16(silu_f(g1[0]) * u1[0], silu_f(g1[1]) * u1[1]);
                    o.w = cvt_pk_bf16(silu_f(g1[2]) * u1[2], silu_f(g1[3]) * u1[3]);
                    *(u32x4*)(O + (size_t)(row0 + ai * HALF + m * 16) * ldo + col0) = o;
                    __builtin_amdgcn_sched_barrier(0);
                }
        } else {
            const int seg = u.pn >> 2;
#pragma unroll
            for (int bj = 0; bj < 2; ++bj) {
                const int col0 = u.pn * BM + bj * HALF + wc * 32 + 8 * fq;
                f32x4 l0 = {0.f, 0.f, 0.f, 0.f}, l1 = {0.f, 0.f, 0.f, 0.f};
                if (MODE == 2 && (seg == 2 || seg == 3)) { const float* lp = lb + (seg - 2) * 1024 + (col0 & 1023); l0 = *(const f32x4*)lp; l1 = *(const f32x4*)(lp + 4); }
#pragma unroll
                for (int ai = 0; ai < 2; ++ai)
#pragma unroll
                    for (int m = 0; m < 4; ++m) {
                        f32x4 v0 = acc[ai][bj][m][0], v1 = acc[ai][bj][m][1];
                        if constexpr (MODE == 3) {
#pragma unroll
                            for (int i = 0; i < 4; ++i) { v0[i] = gelu_tanh_f(v0[i]); v1[i] = gelu_tanh_f(v1[i]); }
                        }
                        if constexpr (MODE == 2) {
                            if (seg == 0 || seg == 4) {
#pragma unroll
                                for (int i = 0; i < 4; ++i) { v0[i] = silu_f(v0[i]); v1[i] = silu_f(v1[i]); }
                            } else if (seg >= 2) {
#pragma unroll
                                for (int i = 0; i < 4; ++i) {
                                    v0[i] = __logf(l0[i] + (1.f - l0[i]) * sigmoid_f(v0[i]));
                                    v1[i] = __logf(l1[i] + (1.f - l1[i]) * sigmoid_f(v1[i]));
                                }
                            }
                        }
                        u32x4 o;
                        o.x = cvt_pk_bf16(v0[0], v0[1]); o.y = cvt_pk_bf16(v0[2], v0[3]); o.z = cvt_pk_bf16(v1[0], v1[1]); o.w = cvt_pk_bf16(v1[2], v1[3]);
                        *(u32x4*)(O + (size_t)(row0 + ai * HALF + m * 16) * ldo + col0) = o;
                        __builtin_amdgcn_sched_barrier(0);
                    }
            }
        }
    }
};

template <class EpiT>
__device__ __forceinline__ void gemm_phase(LAS unsigned char* lds, const Gemm g, const StaticOrder& S, const EpiT& E) {
    const int tid = opaque_tid(), wid = __builtin_amdgcn_readfirstlane(tid >> 6), lane = tid & 63, wr = wid >> 2, wc = wid & 3, fr = lane & 15, fq = lane >> 4;
    const int K = g.K, nt = K / BK, lda = g.lda;
    unsigned voffA[2], voffB[2];
#pragma unroll
    for (int i = 0; i < 2; ++i) { int R, C; stage_rc(tid * 16 + i * 8192, R, C); const int Rb = (R & ~31) + perm32(R & 31);
        voffA[i] = (unsigned)(R * lda + C) * 2u; voffB[i] = (unsigned)(Rb * K + C) * 2u; }
    const size_t kstep = (size_t)(BK * 2);
    const size_t hstepA = (size_t)HALF * lda * 2, hstepB = (size_t)HALF * K * 2;
    const size_t tstepA = 2 * hstepA, tstepB = 2 * hstepB;
    const unsigned ldsw = (unsigned)wid * 1024u;
    const int aoff = lds_byte(wr * 64 + fr, fq * 8), boff = lds_byte(wc * 32 + fr, fq * 8);
#define PG8_SA(b, h) (((b) * 2 + (h)) * HTB)
#define PG8_SB(b, h) ((4 + (b) * 2 + (h)) * HTB)
#define PG8_STAGE(bufoff, gbase, voff) do { _Pragma("unroll") for (int _i = 0; _i < 2; ++_i) \
        __builtin_amdgcn_global_load_lds((const unsigned*)((const char*)(gbase) + (voff)[_i]), (LAS unsigned*)(lds + (bufoff) + ldsw + _i * 8192), 16, 0, 0); } while (0)
#define PG8_LDA(dst, b, h) do { _Pragma("unroll") for (int m = 0; m < 4; ++m) _Pragma("unroll") for (int k = 0; k < 2; ++k) dst[m][k] = *(const LAS bf16x8*)(lds + PG8_SA(b, h) + aoff + m * 2048 + k * 1024); } while (0)
#define PG8_LDB(dst, b, h) do { _Pragma("unroll") for (int n = 0; n < 2; ++n) _Pragma("unroll") for (int k = 0; k < 2; ++k) dst[n][k] = *(const LAS bf16x8*)(lds + PG8_SB(b, h) + boff + n * 2048 + k * 1024); } while (0)
#define PG8_MMA(ai, bj, At, Bt) do { __builtin_amdgcn_s_setprio(1); _Pragma("unroll") for (int m = 0; m < 4; ++m) _Pragma("unroll") for (int n = 0; n < 2; ++n) _Pragma("unroll") for (int k = 0; k < 2; ++k) \
        acc[ai][bj][m][n] = __builtin_amdgcn_mfma_f32_16x16x32_bf16(Bt[n][k], At[m][k], acc[ai][bj][m][n], 0, 0, 0); __builtin_amdgcn_s_setprio(0); } while (0)
#define PG8_WAIT_V(n) asm volatile("s_waitcnt vmcnt(" #n ")" ::: "memory")
#define PG8_WAIT_L(n) asm volatile("s_waitcnt lgkmcnt(" #n ")" ::: "memory")
#define PG8_BAR __builtin_amdgcn_s_barrier()
#define PG8_SCHED __builtin_amdgcn_sched_barrier(0)
    Unit cur, nxt; int ui = 0;
    if (!S.next(0, cur)) return;
    f32x4 acc[2][2][4][2];
#pragma unroll
    for (int a = 0; a < 2; ++a)
#pragma unroll
        for (int b = 0; b < 2; ++b)
#pragma unroll
            for (int m = 0; m < 4; ++m)
#pragma unroll
                for (int n = 0; n < 2; ++n) acc[a][b][m][n] = (f32x4){0.f, 0.f, 0.f, 0.f};
    bf16x8 At[4][2], B0[2][2], B1[2][2];
    const char* cA = (const char*)g.A + (size_t)cur.pm * tstepA; const char* cB = (const char*)g.Bt + (size_t)cur.pn * tstepB;
    PG8_STAGE(PG8_SB(0, 0), cB, voffB); PG8_STAGE(PG8_SA(0, 0), cA, voffA); PG8_STAGE(PG8_SB(0, 1), cB + hstepB, voffB); PG8_STAGE(PG8_SA(0, 1), cA + hstepA, voffA);
    if (wr == 1) PG8_BAR;
    PG8_WAIT_V(4); PG8_BAR;
    PG8_STAGE(PG8_SB(1, 0), cB + kstep, voffB); PG8_STAGE(PG8_SA(1, 0), cA + kstep, voffA); PG8_STAGE(PG8_SB(1, 1), cB + hstepB + kstep, voffB);
    PG8_WAIT_V(6); PG8_BAR;
    for (;;) {
        const bool has_next = S.next(ui + 1, nxt);
        const char* nA = has_next ? (const char*)g.A + (size_t)nxt.pm * tstepA : cA; const char* nB = has_next ? (const char*)g.Bt + (size_t)nxt.pn * tstepB : cB;
        for (int t = 0; t < nt; t += 2) {
            const bool last = (t == nt - 2);
            const char* a1 = cA + (size_t)(t + 1) * kstep;
            const char* a2 = last ? nA : cA + (size_t)(t + 2) * kstep; const char* b2 = last ? nB : cB + (size_t)(t + 2) * kstep;
            const char* a3 = a2 + kstep; const char* b3 = b2 + kstep;
            PG8_LDB(B0, 0, 0); PG8_SCHED; PG8_LDA(At, 0, 0); PG8_STAGE(PG8_SA(1, 1), a1 + hstepA, voffA);
            PG8_WAIT_L(8); PG8_BAR; PG8_WAIT_L(0); PG8_MMA(0, 0, At, B0); PG8_BAR; PG8_SCHED;
            PG8_LDB(B1, 0, 1); PG8_STAGE(PG8_SB(0, 0), b2, voffB);
            PG8_BAR; PG8_WAIT_L(0); PG8_MMA(0, 1, At, B1); PG8_BAR;
            PG8_LDA(At, 0, 1); PG8_STAGE(PG8_SA(0, 0), a2, voffA);
            PG8_BAR; PG8_WAIT_L(0); PG8_MMA(1, 0, At, B0); PG8_BAR; PG8_SCHED;
            PG8_STAGE(PG8_SB(0, 1), b2 + hstepB, voffB);
            PG8_WAIT_V(6); PG8_BAR; PG8_MMA(1, 1, At, B1); PG8_BAR;
            PG8_LDB(B0, 1, 0); PG8_SCHED; PG8_LDA(At, 1, 0); PG8_STAGE(PG8_SA(0, 1), a2 + hstepA, voffA);
            PG8_WAIT_L(8); PG8_BAR; PG8_WAIT_L(0); PG8_MMA(0, 0, At, B0); PG8_BAR; PG8_SCHED;
            PG8_LDB(B1, 1, 1); PG8_STAGE(PG8_SB(1, 0), b3, voffB);
            PG8_BAR; PG8_WAIT_L(0); PG8_MMA(0, 1, At, B1); PG8_BAR;
            PG8_LDA(At, 1, 1); PG8_STAGE(PG8_SA(1, 0), a3, voffA);
            PG8_BAR; PG8_WAIT_L(0); PG8_MMA(1, 0, At, B0); PG8_BAR; PG8_SCHED;
            PG8_STAGE(PG8_SB(1, 1), b3 + hstepB, voffB);
            PG8_WAIT_V(6); PG8_BAR; PG8_MMA(1, 1, At, B1); PG8_BAR;
        }
        E(acc, cur, wr, wc, fr, fq);
        if (!has_next) break;
#pragma unroll
        for (int a = 0; a < 2; ++a)
#pragma unroll
            for (int b = 0; b < 2; ++b)
#pragma unroll
                for (int m = 0; m < 4; ++m)
#pragma unroll
                    for (int n = 0; n < 2; ++n) acc[a][b][m][n] = (f32x4){0.f, 0.f, 0.f, 0.f};
        cur = nxt; cA = nA; cB = nB; ++ui;
    }
    PG8_WAIT_V(0);
    if (wr == 0) PG8_BAR;
    PG8_BAR;
#undef PG8_SA
#undef PG8_SB
#undef PG8_STAGE
#undef PG8_LDA
#undef PG8_LDB
#undef PG8_MMA
#undef PG8_WAIT_V
#undef PG8_WAIT_L
#undef PG8_BAR
#undef PG8_SCHED
}
}

template <int MODE>
__device__ __forceinline__ void run_gemm(LAS unsigned char* lds, const bf16_t* A, int lda, const bf16_t* Bt, int M, int N, int K, bf16_t* O, int ldo, const float* lb) {
    pg8::Gemm g{A, lda, Bt, M, N, K};
    pg8::StaticOrder S; S.init(M, N, gridDim.x, blockIdx.x);
    pg8::Epi<MODE> E{O, ldo, lb};
    pg8::gemm_phase(lds, g, S, E);
}

__device__ __forceinline__ void p0_mod_item(const Params& p, LAS unsigned char* lds, int item) {
    const int tid = opaque_tid();
    const int layer = item / 144, cgp = item % 144, col0 = cgp * 64;
    const float* c = p.in[1]; const float* cctx = p.in[3];
    const float* W = p.in[4] + (size_t)layer * 1024 * 9216; const float* bias = p.in[5] + (size_t)layer * 9216;
    float* mout = (float*)(p.ws + WS_MOD) + (size_t)layer * 33 * 9216;
    LAS float* S = (LAS float*)lds;
    __syncthreads();
    for (int i = tid; i < 33 * 1024; i += NTHREADS) { const int r = i >> 10, k = i & 1023; const float v = r < 32 ? c[r * 1024 + k] : cctx[k]; S[i] = silu_f(v); }
    __syncthreads();
    const int col = tid & 63, ks = tid >> 6;
    float acc[33];
#pragma unroll
    for (int r = 0; r < 33; ++r) acc[r] = 0.f;
    for (int k4 = 0; k4 < 32; ++k4) {
        const int k = ks * 128 + k4 * 4;
        const float w0 = W[(size_t)(k + 0) * 9216 + col0 + col], w1 = W[(size_t)(k + 1) * 9216 + col0 + col], w2 = W[(size_t)(k + 2) * 9216 + col0 + col], w3 = W[(size_t)(k + 3) * 9216 + col0 + col];
#pragma unroll
        for (int r = 0; r < 33; ++r) { const f32x4 s4 = *(const LAS f32x4*)(S + r * 1024 + k); acc[r] += w0 * s4[0] + w1 * s4[1] + w2 * s4[2] + w3 * s4[3]; }
    }
    __syncthreads();
    LAS float* red = (LAS float*)lds;
#pragma unroll
    for (int r = 0; r < 33; ++r) red[(ks * 33 + r) * 64 + col] = acc[r];
    __syncthreads();
    for (int i = tid; i < 33 * 64; i += NTHREADS) {
        const int r = i >> 6, cc = i & 63; float s = 0.f;
#pragma unroll
        for (int q = 0; q < 8; ++q) s += red[(q * 33 + r) * 64 + cc];
        mout[(size_t)r * 9216 + col0 + cc] = s + bias[col0 + cc];
    }
    __syncthreads();
}

__device__ __forceinline__ void p0_transpose_item(const float* W, int K, int N, bf16_t* WT, int k0, int n0, int drow0, LAS float* scr, int lane) {
#pragma unroll 8
    for (int i = 0; i < 32; ++i) { const int kk = 2 * i + (lane >> 5); scr[kk * 33 + (lane & 31)] = W[(size_t)(k0 + kk) * N + n0 + (lane & 31)]; }
    asm volatile("s_waitcnt lgkmcnt(0)" ::: "memory");
    const int c = lane & 7;
#pragma unroll
    for (int j = 0; j < 4; ++j) { const int n = (lane >> 3) + 8 * j; const LAS float* s = scr + (8 * c) * 33 + n;
        u32x4 o; o.x = cvt_pk_bf16(s[0 * 33], s[1 * 33]); o.y = cvt_pk_bf16(s[2 * 33], s[3 * 33]); o.z = cvt_pk_bf16(s[4 * 33], s[5 * 33]); o.w = cvt_pk_bf16(s[6 * 33], s[7 * 33]);
        *(u32x4*)(WT + (size_t)(drow0 + n) * K + k0 + 8 * c) = o; }
    asm volatile("s_waitcnt lgkmcnt(0)" ::: "memory");
}

__device__ __forceinline__ void phase0(const Params& p, LAS unsigned char* lds) {
    const int tid = opaque_tid(), wid = tid >> 6, lane = tid & 63;
    if (blockIdx.x == gridDim.x - 1) {
        const float* lbp = p.in[11]; float* lbo = (float*)(p.ws + WS_LB);
        for (int i = tid; i < 2048; i += NTHREADS) { const int dir = i >> 10, col = i & 1023;
            const float l0 = lbp[(dir * 3 + 0) * 1024 + col], l1 = lbp[(dir * 3 + 1) * 1024 + col], l2 = lbp[(dir * 3 + 2) * 1024 + col];
            const float mx = fmaxf(l0, fmaxf(l1, l2)); const float e0 = __expf(l0 - mx), e1 = __expf(l1 - mx), e2 = __expf(l2 - mx);
            lbo[i] = e0 / (e0 + e1 + e2); }
    }
    for (int it = blockIdx.x; it < 288; it += gridDim.x) p0_mod_item(p, lds, it);
    __syncthreads();
    LAS float* scr = (LAS float*)lds + wid * (64 * 33);
    const int gw = blockIdx.x * 8 + wid, nw = gridDim.x * 8;
    for (int mi = 0; mi < 12; ++mi) {
        const float* W; bf16_t* WT; int K, N, mode = 0;
        if (mi < 4) { W = p.in[8] + (size_t)mi * 1024 * 5632; WT = (bf16_t*)(p.ws + WS_FIN) + (size_t)mi * 5632 * 1024; K = 1024; N = 5632; mode = 1; }
        else if (mi < 8) { W = p.in[9] + (size_t)(mi - 4) * 2816 * 1024; WT = (bf16_t*)(p.ws + WS_FOUT) + (size_t)(mi - 4) * 1024 * 2816; K = 2816; N = 1024; }
        else if (mi == 8) { W = p.in[10]; WT = (bf16_t*)(p.ws + WS_HIN); K = 1024; N = 5120; }
        else if (mi == 9) { W = p.in[13]; WT = (bf16_t*)(p.ws + WS_HOUT); K = 1024; N = 1024; }
        else if (mi == 10) { W = p.in[14]; WT = (bf16_t*)(p.ws + WS_CIN); K = 1024; N = 6144; }
        else { W = p.in[19]; WT = (bf16_t*)(p.ws + WS_COUT); K = 3072; N = 1024; }
        const int nblk = N / 32, nitems = (K / 64) * nblk;
        for (int it = gw; it < nitems; it += nw) {
            const int kb = it / nblk, nb = it % nblk, n0 = nb * 32;
            int drow0 = n0;
            if (mode == 1) { const int j = n0 < FH ? n0 : n0 - FH; drow0 = 256 * (j >> 7) + (n0 < FH ? 0 : 128) + (j & 127); }
            p0_transpose_item(W, K, N, WT, kb * 64, n0, drow0, scr, lane);
        }
    }
}

struct RowArgs {
    const float* xs_x; const float* xs_c; int nrows;
    const bf16_t* y; float ysc; const float* m; int k; const float* g; const float* b;
    float* xd; bf16_t* hd; const float* m2; int k2;
};
__device__ __forceinline__ void row_phase(const RowArgs& a) {
    const int tid0 = opaque_tid(); const int wid = tid0 >> 6, lane = tid0 & 63;
    for (int row = blockIdx.x * 8 + wid; row < a.nrows; row += gridDim.x * 8) {
        const int mrow = row < MX ? (row >> 11) : 32;
        const float* xr = row < MX ? a.xs_x + (size_t)row * D : a.xs_c + (size_t)(row - MX) * D;
        f32x4 v[4];
#pragma unroll
        for (int j = 0; j < 4; ++j) v[j] = *(const f32x4*)(xr + j * 256 + lane * 4);
        if (a.y) {
            const float* gp = a.m + (size_t)mrow * 9216 + (3 * a.k + 2) * 1024;
            float s = 0.f;
#pragma unroll
            for (int j = 0; j < 4; ++j) {
                const u32x2 yy = *(const u32x2*)(a.y + (size_t)row * D + j * 256 + lane * 4);
                const f32x4 gt = *(const f32x4*)(gp + j * 256 + lane * 4);
                v[j][0] = DN_ALPHA * v[j][0] + gt[0] * a.ysc * bf_lo(yy.x); v[j][1] = DN_ALPHA * v[j][1] + gt[1] * a.ysc * bf_hi(yy.x);
                v[j][2] = DN_ALPHA * v[j][2] + gt[2] * a.ysc * bf_lo(yy.y); v[j][3] = DN_ALPHA * v[j][3] + gt[3] * a.ysc * bf_hi(yy.y);
                s += (v[j][0] + v[j][1]) + (v[j][2] + v[j][3]);
            }
            const float mean = wave_sum(s) * (1.f / D); float s2 = 0.f;
#pragma unroll
            for (int j = 0; j < 4; ++j) { v[j] = v[j] - mean; s2 += (v[j][0] * v[j][0] + v[j][1] * v[j][1]) + (v[j][2] * v[j][2] + v[j][3] * v[j][3]); }
            const float rstd = __builtin_amdgcn_rsqf(wave_sum(s2) * (1.f / D) + LN_EPS);
#pragma unroll
            for (int j = 0; j < 4; ++j) { const f32x4 gg = *(const f32x4*)(a.g + j * 256 + lane * 4), bb = *(const f32x4*)(a.b + j * 256 + lane * 4); v[j] = v[j] * rstd * gg + bb; }
            if (a.xd && row < MX) {
#pragma unroll
                for (int j = 0; j < 4; ++j) *(f32x4*)(a.xd + (size_t)row * D + j * 256 + lane * 4) = v[j];
            }
        }
        if (a.hd) {
            const float* shp = a.m2 + (size_t)mrow * 9216 + (3 * a.k2) * 1024; const float* scp = shp + 1024;
#pragma unroll
            for (int j = 0; j < 4; ++j) {
                const f32x4 sh = *(const f32x4*)(shp + j * 256 + lane * 4), sc = *(const f32x4*)(scp + j * 256 + lane * 4);
                const f32x4 h = v[j] * (sc + 1.f) + sh;
                u32x2 o; o.x = cvt_pk_bf16(h[0], h[1]); o.y = cvt_pk_bf16(h[2], h[3]);
                *(u32x2*)(a.hd + (size_t)row * D + j * 256 + lane * 4) = o;
            }
        }
    }
}

constexpr int GLA_DIRB = 74240;
__device__ __forceinline__ void gla_phase(const Params& p, LAS unsigned char* lds) {
    const int tid = opaque_tid(), dir = tid >> 8, tl = tid & 255, w = tl >> 6, lane = tl & 63, fr = lane & 15, fq = lane >> 4;
    const int cp = lane, qt = w;
    bf16_t* P = (bf16_t*)(p.ws + WS_BIG); bf16_t* R = (bf16_t*)(p.ws + WS_A0);
    const float* normw = p.in[12];
    LAS unsigned char* base = lds + dir * GLA_DIRB;
    LAS bf16_t* Qin = (LAS bf16_t*)base;
    LAS bf16_t* Kin = (LAS bf16_t*)(base + 17408);
    LAS bf16_t* Sc = Kin;
    LAS bf16_t* KinT = (LAS bf16_t*)(base + 34816);
    LAS bf16_t* VT = (LAS bf16_t*)(base + 53248);
    LAS float* tot = (LAS float*)(base + 71680);
    LAS float* dec = (LAS float*)(base + 73728);
    for (int item = blockIdx.x; item < NB * 8; item += gridDim.x) {
        const int b = item >> 3, h = item & 7;
        f32x4 Sacc[8][2];
#pragma unroll
        for (int m = 0; m < 8; ++m) { Sacc[m][0] = (f32x4){0.f, 0.f, 0.f, 0.f}; Sacc[m][1] = (f32x4){0.f, 0.f, 0.f, 0.f}; }
        unsigned rq[16], rv[16], rl[16];
        auto chunk_row = [&](int ci, int t) -> size_t {
            const bool isc = ci < 4; const int lc = isc ? ci : ci - 4, L = isc ? CTXL : SEQ; const int rbase = isc ? MX + b * CTXL : b * SEQ;
            const int tok = dir == 0 ? 64 * lc + t : L - 1 - (64 * lc + t);
            return (size_t)(rbase + tok);
        };
        auto load_chunk = [&](int ci) {
            const bf16_t* rp = P + chunk_row(ci, 16 * qt) * HG5 + h * 128 + 2 * cp;
            const long step = dir == 0 ? (long)HG5 : -(long)HG5;
#pragma unroll
            for (int i = 0; i < 16; ++i) {
                rq[i] = *(const unsigned*)rp; rv[i] = *(const unsigned*)(rp + 1024); rl[i] = *(const unsigned*)(rp + (2 + dir) * 1024);
                rp += step; asm volatile("" : "+v"(rp));
            }
        };
        __syncthreads();
        load_chunk(0);
        for (int ci = 0; ci < 36; ++ci) {
            const bool isc = ci < 4;
            {
                float run0 = 0.f, run1 = 0.f;
#pragma unroll
                for (int i = 0; i < 16; ++i) { run0 += bf_lo(rl[i]); run1 += bf_hi(rl[i]); }
                *(LAS f32x2*)(tot + qt * 128 + 2 * cp) = (f32x2){run0, run1};
#pragma unroll
                for (int hh = 0; hh < 2; ++hh) {
                    u32x4 a, c;
#pragma unroll
                    for (int u = 0; u < 4; ++u) { const int ip = 4 * hh + u;
                        a[u] = (rv[2 * ip] & 0xffffu) | (rv[2 * ip + 1] << 16); c[u] = (rv[2 * ip] >> 16) | (rv[2 * ip + 1] & 0xffff0000u); }
                    *(LAS u32x4*)(VT + (2 * cp) * 72 + 16 * qt + 8 * hh) = a;
                    *(LAS u32x4*)(VT + (2 * cp + 1) * 72 + 16 * qt + 8 * hh) = c;
                }
                __syncthreads();
                float pre0 = 0.f, pre1 = 0.f, all0 = 0.f, all1 = 0.f;
#pragma unroll
                for (int q = 0; q < 4; ++q) { const f32x2 tq = *(const LAS f32x2*)(tot + q * 128 + 2 * cp); if (q < qt) { pre0 += tq[0]; pre1 += tq[1]; } all0 += tq[0]; all1 += tq[1]; }
                if (qt == 0) *(LAS f32x2*)(dec + 2 * cp) = (f32x2){__expf(all0), __expf(all1)};
                float iebp0 = __expf(-pre0), iebp1 = __expf(-pre1);
                float bb0 = pre0, bb1 = pre1;
#pragma unroll
                for (int hh = 0; hh < 2; ++hh) {
                    u32x4 a, c;
#pragma unroll
                    for (int u4 = 0; u4 < 4; ++u4) {
                        float kin0[2], kin1[2];
#pragma unroll
                        for (int u = 0; u < 2; ++u) {
                            const int i = 8 * hh + 2 * u4 + u, t = 16 * qt + i;
                            bb0 += bf_lo(rl[i]); bb1 += bf_hi(rl[i]);
                            const float eb0 = __expf(bb0), eb1 = __expf(bb1), ieb0 = __expf(-bb0), ieb1 = __expf(-bb1);
                            const float k0 = 1.f - eb0 * iebp0, k1 = 1.f - eb1 * iebp1;
                            iebp0 = ieb0; iebp1 = ieb1;
                            kin0[u] = k0 * ieb0; kin1[u] = k1 * ieb1;
                            *(LAS unsigned*)(Qin + t * 136 + 2 * cp) = cvt_pk_bf16(bf_lo(rq[i]) * eb0, bf_hi(rq[i]) * eb1);
                            *(LAS unsigned*)(Kin + t * 136 + 2 * cp) = cvt_pk_bf16(kin0[u], kin1[u]);
                        }
                        a[u4] = cvt_pk_bf16(kin0[0], kin0[1]); c[u4] = cvt_pk_bf16(kin1[0], kin1[1]);
                    }
                    *(LAS u32x4*)(KinT + (2 * cp) * 72 + 16 * qt + 8 * hh) = a;
                    *(LAS u32x4*)(KinT + (2 * cp + 1) * 72 + 16 * qt + 8 * hh) = c;
                    __builtin_amdgcn_sched_barrier(0);
                }
            }
            __syncthreads();
            if (ci + 1 < 36) load_chunk(ci + 1);
            f32x4 sacc[4];
            if (!isc) {
                bf16x8 qf[4];
#pragma unroll
                for (int ks = 0; ks < 4; ++ks) qf[ks] = *(const LAS bf16x8*)(Qin + (16 * w + fr) * 136 + 32 * ks + 8 * fq);
#pragma unroll
                for (int ms = 0; ms < 4; ++ms) {
                    sacc[ms] = (f32x4){0.f, 0.f, 0.f, 0.f};
                    if (ms <= w) {
#pragma unroll
                        for (int ks = 0; ks < 4; ++ks) { const bf16x8 kf = *(const LAS bf16x8*)(Kin + (16 * ms + fr) * 136 + 32 * ks + 8 * fq);
                            sacc[ms] = __builtin_amdgcn_mfma_f32_16x16x32_bf16(kf, qf[ks], sacc[ms], 0, 0, 0); }
                    }
                }
            }
            __syncthreads();
            if (!isc) {
#pragma unroll
                for (int ms = 0; ms < 4; ++ms) {
                    f32x4 v = sacc[ms];
                    if (ms == w) {
#pragma unroll
                        for (int j = 0; j < 4; ++j) v[j] = (4 * fq + j <= fr) ? v[j] : 0.f;
                    }
                    u32x2 o; o.x = cvt_pk_bf16(v[0], v[1]); o.y = cvt_pk_bf16(v[2], v[3]);
                    *(LAS u32x2*)(Sc + (16 * w + fr) * 72 + 16 * ms + 4 * fq) = o;
                }
            }
            __syncthreads();
            __builtin_amdgcn_sched_barrier(0);
            bf16x8 vfrag[2][2];
#pragma unroll
            for (int n = 0; n < 2; ++n)
#pragma unroll
                for (int ks = 0; ks < 2; ++ks) vfrag[n][ks] = *(const LAS bf16x8*)(VT + (32 * w + 16 * n + fr) * 72 + 32 * ks + 8 * fq);
            if (!isc) {
                f32x4 oacc[2][4];
#pragma unroll
                for (int n = 0; n < 2; ++n)
#pragma unroll
                    for (int tt = 0; tt < 4; ++tt) oacc[n][tt] = (f32x4){0.f, 0.f, 0.f, 0.f};
#pragma unroll
                for (int kk = 0; kk < 4; ++kk) {
                    bf16x8 sf[2];
#pragma unroll
                    for (int n = 0; n < 2; ++n) {
                        u32x4 pk; pk.x = cvt_pk_bf16(Sacc[2 * kk][n][0], Sacc[2 * kk][n][1]); pk.y = cvt_pk_bf16(Sacc[2 * kk][n][2], Sacc[2 * kk][n][3]);
                        pk.z = cvt_pk_bf16(Sacc[2 * kk + 1][n][0], Sacc[2 * kk + 1][n][1]); pk.w = cvt_pk_bf16(Sacc[2 * kk + 1][n][2], Sacc[2 * kk + 1][n][3]);
                        sf[n] = __builtin_bit_cast(bf16x8, pk);
                    }
#pragma unroll
                    for (int tt = 0; tt < 4; ++tt) {
                        const LAS bf16_t* qp = Qin + (16 * tt + fr) * 136 + 32 * kk + 4 * fq;
                        const u32x2 lo = *(const LAS u32x2*)qp, hi = *(const LAS u32x2*)(qp + 16);
                        const bf16x8 qfr = __builtin_bit_cast(bf16x8, ((u32x4){lo.x, lo.y, hi.x, hi.y}));
#pragma unroll
                        for (int n = 0; n < 2; ++n) oacc[n][tt] = __builtin_amdgcn_mfma_f32_16x16x32_bf16(sf[n], qfr, oacc[n][tt], 0, 0, 0);
                    }
                }
                __builtin_amdgcn_sched_barrier(0);
#pragma unroll
                for (int tt = 0; tt < 4; ++tt)
#pragma unroll
                    for (int ks = 0; ks < 2; ++ks) {
                        if (ks == 1 && tt < 2) continue;
                        const bf16x8 scf = *(const LAS bf16x8*)(Sc + (16 * tt + fr) * 72 + 32 * ks + 8 * fq);
#pragma unroll
                        for (int n = 0; n < 2; ++n) oacc[n][tt] = __builtin_amdgcn_mfma_f32_16x16x32_bf16(vfrag[n][ks], scf, oacc[n][tt], 0, 0, 0);
                    }
                __builtin_amdgcn_sched_barrier(0);
#pragma unroll
                for (int tt = 0; tt < 4; ++tt) {
                    bf16_t* op = P + chunk_row(ci, 16 * tt + fr) * HG5 + (2 + dir) * 1024 + h * 128 + 32 * w + 4 * fq;
#pragma unroll
                    for (int n = 0; n < 2; ++n) { u32x2 o; o.x = cvt_pk_bf16(oacc[n][tt][0], oacc[n][tt][1]); o.y = cvt_pk_bf16(oacc[n][tt][2], oacc[n][tt][3]); *(u32x2*)(op + 16 * n) = o; }
                }
            }
            __builtin_amdgcn_sched_barrier(0);
#pragma unroll
            for (int m = 0; m < 8; ++m) {
#pragma unroll
                for (int ks = 0; ks < 2; ++ks) { const bf16x8 kf = *(const LAS bf16x8*)(KinT + (16 * m + fr) * 72 + 32 * ks + 8 * fq);
#pragma unroll
                    for (int n = 0; n < 2; ++n) Sacc[m][n] = __builtin_amdgcn_mfma_f32_16x16x32_bf16(kf, vfrag[n][ks], Sacc[m][n], 0, 0, 0); }
                const f32x4 dv = *(const LAS f32x4*)(dec + 16 * m + 4 * fq);
                Sacc[m][0] *= dv; Sacc[m][1] *= dv;
            }
            __syncthreads();
        }
        __threadfence(); __syncthreads(); __threadfence();
        {
            const int wid = tid >> 6, lane = tid & 63, sub = lane >> 4, l16 = lane & 15;
            const f32x4 w0 = *(const f32x4*)(normw + 8 * l16), w1 = *(const f32x4*)(normw + 8 * l16 + 4);
#pragma unroll 4
            for (int it = 0; it < 64; ++it) {
                const int t = it * 32 + wid * 4 + sub; const size_t row = (size_t)b * SEQ + t;
                const bf16_t* rp = P + row * HG5 + h * 128 + 8 * l16;
                const u32x4 of = *(const u32x4*)(rp + 2048), ob = *(const u32x4*)(rp + 3072), gg = *(const u32x4*)(rp + 4096);
                float o[8];
                o[0] = bf_lo(of.x) + bf_lo(ob.x); o[1] = bf_hi(of.x) + bf_hi(ob.x); o[2] = bf_lo(of.y) + bf_lo(ob.y); o[3] = bf_hi(of.y) + bf_hi(ob.y);
                o[4] = bf_lo(of.z) + bf_lo(ob.z); o[5] = bf_hi(of.z) + bf_hi(ob.z); o[6] = bf_lo(of.w) + bf_lo(ob.w); o[7] = bf_hi(of.w) + bf_hi(ob.w);
                float ss = 0.f;
#pragma unroll
                for (int i = 0; i < 8; ++i) ss += o[i] * o[i];
                ss += __shfl_xor(ss, 1); ss += __shfl_xor(ss, 2); ss += __shfl_xor(ss, 4); ss += __shfl_xor(ss, 8);
                const float rs = __builtin_amdgcn_rsqf(ss * (1.f / 128.f) + RMS_EPS);
                u32x4 r;
                r.x = cvt_pk_bf16(o[0] * rs * w0[0] * bf_lo(gg.x), o[1] * rs * w0[1] * bf_hi(gg.x));
                r.y = cvt_pk_bf16(o[2] * rs * w0[2] * bf_lo(gg.y), o[3] * rs * w0[3] * bf_hi(gg.y));
                r.z = cvt_pk_bf16(o[4] * rs * w1[0] * bf_lo(gg.z), o[5] * rs * w1[1] * bf_hi(gg.z));
                r.w = cvt_pk_bf16(o[6] * rs * w1[2] * bf_lo(gg.w), o[7] * rs * w1[3] * bf_hi(gg.w));
                *(u32x4*)(R + row * D + h * 128 + 8 * l16) = r;
            }
        }
        __syncthreads();
    }
}

__device__ __forceinline__ void cm_gate_phase(const Params& p, LAS unsigned char* lds) {
    const int tid = opaque_tid(), wid = tid >> 6, lane = tid & 63, fr = lane & 15, fq = lane >> 4;
    bf16_t* UV = (bf16_t*)(p.ws + WS_BIG);
    const float* vg = p.in[15]; const float* vb = p.in[16]; const float* ws_ = p.in[17]; const float* bs = p.in[18];
    LAS bf16_t* Wl = (LAS bf16_t*)lds; LAS bf16_t* Vl = (LAS bf16_t*)(lds + 34816); LAS float* st = (LAS float*)(lds + 34816 + 100352);
    for (int ch = blockIdx.x; ch < MX / 128; ch += gridDim.x) {
        const size_t row0 = (size_t)ch * 128;
        __syncthreads();
        for (int rr = 0; rr < 16; ++rr) {
            const int r = wid * 16 + rr; const bf16_t* vp = UV + (row0 + r) * 6144 + 3072;
            u32x4 x[6]; float s = 0.f;
#pragma unroll
            for (int i = 0; i < 6; ++i) { x[i] = *(const u32x4*)(vp + (i * 64 + lane) * 8);
                s += (bf_lo(x[i].x) + bf_hi(x[i].x)) + (bf_lo(x[i].y) + bf_hi(x[i].y)) + (bf_lo(x[i].z) + bf_hi(x[i].z)) + (bf_lo(x[i].w) + bf_hi(x[i].w)); }
            const float mean = wave_sum(s) * (1.f / 3072.f); float s2 = 0.f;
#pragma unroll
            for (int i = 0; i < 6; ++i) { float d;
                d = bf_lo(x[i].x) - mean; s2 += d * d; d = bf_hi(x[i].x) - mean; s2 += d * d; d = bf_lo(x[i].y) - mean; s2 += d * d; d = bf_hi(x[i].y) - mean; s2 += d * d;
                d = bf_lo(x[i].z) - mean; s2 += d * d; d = bf_hi(x[i].z) - mean; s2 += d * d; d = bf_lo(x[i].w) - mean; s2 += d * d; d = bf_hi(x[i].w) - mean; s2 += d * d; }
            const float rstd = __builtin_amdgcn_rsqf(wave_sum(s2) * (1.f / 3072.f) + LN_EPS);
            if (lane == 0) { st[2 * r] = mean; st[2 * r + 1] = rstd; }
        }
        for (int g = 0; g < 8; ++g) {
            __syncthreads();
#pragma unroll
            for (int i = 0; i < 8; ++i) { const int idx = tid + NTHREADS * i, r = idx >> 5, c4 = idx & 31;
                const f32x4 w = *(const f32x4*)(ws_ + (size_t)g * 16384 + r * 128 + c4 * 4);
                u32x2 o; o.x = cvt_pk_bf16(w[0], w[1]); o.y = cvt_pk_bf16(w[2], w[3]);
                *(LAS u32x2*)(Wl + r * 136 + c4 * 4) = o; }
#pragma unroll 4
            for (int i = 0; i < 12; ++i) { const int task = tid + NTHREADS * i, s = task / 48, c8 = task % 48;
                const u32x4 x = *(const u32x4*)(UV + (row0 + s) * 6144 + 3072 + g * 384 + c8 * 8);
                const float mean = st[2 * s], rstd = st[2 * s + 1];
                const float* gp = vg + g * 384 + c8 * 8; const float* bp = vb + g * 384 + c8 * 8;
                const f32x4 g0 = *(const f32x4*)gp, g1 = *(const f32x4*)(gp + 4), b0 = *(const f32x4*)bp, b1 = *(const f32x4*)(bp + 4);
                u32x4 o;
                o.x = cvt_pk_bf16((bf_lo(x.x) - mean) * rstd * g0[0] + b0[0], (bf_hi(x.x) - mean) * rstd * g0[1] + b0[1]);
                o.y = cvt_pk_bf16((bf_lo(x.y) - mean) * rstd * g0[2] + b0[2], (bf_hi(x.y) - mean) * rstd * g0[3] + b0[3]);
                o.z = cvt_pk_bf16((bf_lo(x.z) - mean) * rstd * g1[0] + b1[0], (bf_hi(x.z) - mean) * rstd * g1[1] + b1[1]);
                o.w = cvt_pk_bf16((bf_lo(x.w) - mean) * rstd * g1[2] + b1[2], (bf_hi(x.w) - mean) * rstd * g1[3] + b1[3]);
                *(LAS u32x4*)(Vl + s * 392 + c8 * 8) = o; }
            __syncthreads();
            f32x4 acc[3][8];
#pragma unroll
            for (int n = 0; n < 3; ++n)
#pragma unroll
                for (int m = 0; m < 8; ++m) acc[n][m] = (f32x4){0.f, 0.f, 0.f, 0.f};
#pragma unroll 1
            for (int ks = 0; ks < 4; ++ks) {
                bf16x8 af[3];
#pragma unroll
                for (int n = 0; n < 3; ++n) {
                    const LAS bf16_t* vp = Vl + (32 * ks + 8 * fq) * 392 + wid * 48 + n * 16 + fr;
#pragma unroll
                    for (int i = 0; i < 8; ++i) af[n][i] = (short)vp[i * 392];
                }
#pragma unroll
                for (int m = 0; m < 8; ++m) {
                    const bf16x8 bfrag = *(const LAS bf16x8*)(Wl + (16 * m + fr) * 136 + 32 * ks + 8 * fq);
#pragma unroll
                    for (int n = 0; n < 3; ++n) acc[n][m] = __builtin_amdgcn_mfma_f32_16x16x32_bf16(af[n], bfrag, acc[n][m], 0, 0, 0);
                }
            }
#pragma unroll
            for (int m = 0; m < 8; ++m) {
                const int t = 16 * m + fr; const float bias = bs[g * 128 + t];
#pragma unroll
                for (int n = 0; n < 3; ++n) {
                    bf16_t* up = UV + (row0 + t) * 6144 + g * 384 + wid * 48 + n * 16 + 4 * fq;
                    const u32x2 uu = *(const u32x2*)up;
                    u32x2 o; o.x = cvt_pk_bf16(bf_lo(uu.x) * (acc[n][m][0] + bias), bf_hi(uu.x) * (acc[n][m][1] + bias));
                    o.y = cvt_pk_bf16(bf_lo(uu.y) * (acc[n][m][2] + bias), bf_hi(uu.y) * (acc[n][m][3] + bias));
                    *(u32x2*)up = o;
                }
                __builtin_amdgcn_sched_barrier(0);
            }
        }
    }
}

#ifndef EN_MASK
#define EN_MASK 255
#endif
constexpr int EN = EN_MASK;
__global__ void __launch_bounds__(NTHREADS, 2) fwd_megakernel(Params p) {
    extern __shared__ __attribute__((aligned(16))) unsigned char lds_raw[];
    LAS unsigned char* lds = (LAS unsigned char*)lds_raw;
    cg::grid_group grid = cg::this_grid();
    const float* x_in = p.in[0]; const float* ctx_in = p.in[2];
    const float* mod0 = (const float*)(p.ws + WS_MOD); const float* mod1 = mod0 + (size_t)33 * 9216;
    const float* lbv = (const float*)(p.ws + WS_LB);
    const float* ln_g = p.in[6]; const float* ln_b = p.in[7];
    bf16_t* A0 = (bf16_t*)(p.ws + WS_A0); bf16_t* BIG = (bf16_t*)(p.ws + WS_BIG);
    const bf16_t* FIN = (const bf16_t*)(p.ws + WS_FIN); const bf16_t* FOUT = (const bf16_t*)(p.ws + WS_FOUT);
    const bf16_t* HIN = (const bf16_t*)(p.ws + WS_HIN); const bf16_t* HOUT = (const bf16_t*)(p.ws + WS_HOUT);
    const bf16_t* CIN = (const bf16_t*)(p.ws + WS_CIN); const bf16_t* COUT = (const bf16_t*)(p.ws + WS_COUT);
    const size_t FIN_SZ = (size_t)5632 * 1024, FOUT_SZ = (size_t)1024 * 2816;
    for (int ph = p.ph_lo; ph < p.ph_hi; ++ph) {
        int kind;
        switch (ph) {
        case 0: kind = 0; break;
        case 1: case 4: case 8: case 11: case 14: case 18: case 21: kind = 1; break;
        case 2: case 9: case 12: case 19: kind = 2; break;
        case 3: case 7: case 10: case 13: case 17: case 20: kind = 3; break;
        case 5: kind = 4; break;
        case 6: kind = 5; break;
        case 15: kind = 6; break;
        default: kind = 7; break;
        }
        if (kind == 0) { if (EN & 1) phase0(p, lds); }
        else if (kind == 1) {
            RowArgs a;
            a.xs_x = p.out; a.xs_c = nullptr; a.nrows = MX; a.y = A0; a.ysc = 0.5f; a.xd = p.out; a.hd = A0;
            if (ph == 1) { a.xs_x = x_in; a.xs_c = ctx_in; a.nrows = MT; a.y = nullptr; a.m = mod0; a.k = 0; a.g = ln_g; a.b = ln_b; a.m2 = mod0; a.k2 = 0; }
            else if (ph == 4) { a.xs_x = x_in; a.xs_c = ctx_in; a.nrows = MT; a.m = mod0; a.k = 0; a.g = ln_g + 0 * D; a.b = ln_b + 0 * D; a.m2 = mod0; a.k2 = 1; }
            else if (ph == 8) { a.y = BIG; a.ysc = 1.f; a.m = mod0; a.k = 1; a.g = ln_g + 1 * D; a.b = ln_b + 1 * D; a.m2 = mod0; a.k2 = 2; }
            else if (ph == 11) { a.m = mod0; a.k = 2; a.g = ln_g + 2 * D; a.b = ln_b + 2 * D; a.m2 = mod1; a.k2 = 0; }
            else if (ph == 14) { a.m = mod1; a.k = 0; a.g = ln_g + 3 * D; a.b = ln_b + 3 * D; a.m2 = mod1; a.k2 = 1; }
            else if (ph == 18) { a.ysc = 1.f; a.m = mod1; a.k = 1; a.g = ln_g + 4 * D; a.b = ln_b + 4 * D; a.m2 = mod1; a.k2 = 2; }
            else { a.m = mod1; a.k = 2; a.g = ln_g + 5 * D; a.b = ln_b + 5 * D; a.hd = nullptr; a.m2 = mod1; a.k2 = 0; }
            if (EN & 2) row_phase(a);
        } else if (kind == 2) {
            const int wi = ph == 2 ? 0 : (ph == 9 ? 1 : (ph == 12 ? 2 : 3));
            if (EN & 4) run_gemm<1>(lds, A0, D, FIN + wi * FIN_SZ, ph == 2 ? MT : MX, 2 * FH, D, BIG, FH, nullptr);
        } else if (kind == 3) {
            const bf16_t* A = BIG; int lda = FH, M = MX, K = FH; const bf16_t* Bt; bf16_t* O = A0;
            if (ph == 3) { Bt = FOUT; M = MT; }
            else if (ph == 7) { A = A0; lda = D; K = D; Bt = HOUT; O = BIG; }
            else if (ph == 10) Bt = FOUT + 1 * FOUT_SZ;
            else if (ph == 13) Bt = FOUT + 2 * FOUT_SZ;
            else if (ph == 17) { lda = 2 * CMI; K = CMI; Bt = COUT; }
            else Bt = FOUT + 3 * FOUT_SZ;
            if (EN & 8) run_gemm<0>(lds, A, lda, Bt, M, D, K, O, D, nullptr);
        } else if (kind == 4) { if (EN & 16) run_gemm<2>(lds, A0, D, HIN, MT, HG5, D, BIG, HG5, lbv); }
        else if (kind == 5) { if (EN & 32) gla_phase(p, lds); }
        else if (kind == 6) { if (EN & 64) run_gemm<3>(lds, A0, D, CIN, MX, 2 * CMI, D, BIG, 2 * CMI, nullptr); }
        else { if (EN & 128) cm_gate_phase(p, lds); }
        if (ph + 1 < p.ph_hi) grid.sync();
    }
}

extern "C" void kernel_launch(void* const* d_in, const int* in_sizes, int n_in, void* d_out, int out_size, void* d_ws, size_t ws_size, hipStream_t stream) {
    static int grid_blocks = 0;
    if (grid_blocks == 0) {
        if (n_in != 20 || out_size != MX * D || ws_size < WS_END) { fprintf(stderr, "kernel_launch: unexpected shapes (n_in %d out %d ws %zu need %zu)\n", n_in, out_size, ws_size, (size_t)WS_END); grid_blocks = -1; return; }
        int dev = 0, cus = 0, per_cu = 0;
        hipGetDevice(&dev);
        hipDeviceGetAttribute(&cus, hipDeviceAttributeMultiprocessorCount, dev);
        if (hipFuncSetAttribute((const void*)fwd_megakernel, hipFuncAttributeMaxDynamicSharedMemorySize, LDS_BYTES) != hipSuccess) { fprintf(stderr, "kernel_launch: hipFuncSetAttribute failed\n"); grid_blocks = -1; return; }
        if (hipOccupancyMaxActiveBlocksPerMultiprocessor(&per_cu, (const void*)fwd_megakernel, NTHREADS, LDS_BYTES) != hipSuccess || per_cu < 1) { fprintf(stderr, "kernel_launch: occupancy query says %d\n", per_cu); per_cu = 1; }
        (void)hipGetLastError();
        grid_blocks = cus * 1;
    }
    if (grid_blocks < 0) return;
    Params p{};
    for (int i = 0; i < 20; ++i) p.in[i] = (const float*)d_in[i];
    p.out = (float*)d_out; p.ws = (unsigned char*)d_ws; p.ph_lo = 0; p.ph_hi = 22;
    void* args[] = {&p};
    hipError_t e = hipLaunchCooperativeKernel((const void*)fwd_megakernel, dim3(grid_blocks), dim3(NTHREADS), args, LDS_BYTES, stream);
    if (e != hipSuccess) fprintf(stderr, "cooperative launch failed: %s (grid %d)\n", hipGetErrorString(e), grid_blocks);
}
```

```cpp
#include <hip/hip_runtime.h>
#include <hip/hip_cooperative_groups.h>
#include <cstdio>
#include <cstdint>
namespace cg = cooperative_groups;

#define LAS __attribute__((address_space(3)))
typedef unsigned short bf16_t;
typedef short bf16x8 __attribute__((ext_vector_type(8)));
typedef float f32x4 __attribute__((ext_vector_type(4)));
typedef float f32x2 __attribute__((ext_vector_type(2)));
typedef unsigned u32x4 __attribute__((ext_vector_type(4)));
typedef unsigned u32x2 __attribute__((ext_vector_type(2)));

constexpr int D = 1024, NB = 32, SEQ = 2048, CTXL = 256;
constexpr int MX = NB * SEQ;
constexpr int MC = NB * CTXL;
constexpr int MT = MX + MC;
constexpr int FH = 2816, HG5 = 5 * D, CMI = 3072, NMOD = 9;
constexpr float DN_ALPHA = 1.41421356237309515f;
constexpr float LN_EPS = 1e-5f, RMS_EPS = 1e-6f;
constexpr int LDS_BYTES = 149504;
constexpr int NTHREADS = 512;

constexpr size_t WS_MOD = 0;
constexpr size_t WS_LB = WS_MOD + (size_t)2 * 33 * 9216 * 4;
constexpr size_t WS_FIN = WS_LB + 2 * 1024 * 4;
constexpr size_t WS_FOUT = WS_FIN + (size_t)4 * 5632 * 1024 * 2;
constexpr size_t WS_HIN = WS_FOUT + (size_t)4 * 1024 * 2816 * 2;
constexpr size_t WS_HOUT = WS_HIN + (size_t)5120 * 1024 * 2;
constexpr size_t WS_CIN = WS_HOUT + (size_t)1024 * 1024 * 2;
constexpr size_t WS_COUT = WS_CIN + (size_t)6144 * 1024 * 2;
constexpr size_t WS_WSB = WS_COUT + (size_t)1024 * 3072 * 2;
constexpr size_t WS_A0 = WS_WSB + (size_t)8 * 128 * 128 * 2;
constexpr size_t WS_BIG = WS_A0 + (size_t)MT * 1024 * 2;
constexpr size_t WS_END = WS_BIG + (size_t)MX * 6144 * 2;

struct Params {
    const float* in[20];
    float* out;
    unsigned char* ws;
    int ph_lo, ph_hi;
};

__device__ __forceinline__ unsigned cvt_pk_bf16(float lo, float hi) { unsigned r; asm volatile("v_cvt_pk_bf16_f32 %0, %1, %2" : "=v"(r) : "v"(lo), "v"(hi)); return r; }
__device__ __forceinline__ int opaque_tid() { int t = threadIdx.x; asm volatile("" : "+v"(t)); return t; }
__device__ __forceinline__ float bf_lo(unsigned u) { return __uint_as_float(u << 16); }
__device__ __forceinline__ float bf_hi(unsigned u) { return __uint_as_float(u & 0xffff0000u); }
__device__ __forceinline__ float wave_sum(float v) {
#pragma unroll
    for (int o = 1; o < 64; o <<= 1) v += __shfl_xor(v, o);
    return v;
}
__device__ __forceinline__ float sigmoid_f(float x) { return __builtin_amdgcn_rcpf(1.f + __expf(-x)); }
__device__ __forceinline__ float silu_f(float x) { return x * sigmoid_f(x); }
__device__ __forceinline__ float gelu_tanh_f(float x) { const float u = 0.7978845608028654f * (x + 0.044715f * x * x * x); return x * sigmoid_f(2.f * u); }

namespace pg8 {
constexpr int BM = 256, BK = 64, HALF = 128, HTB = HALF * BK * 2, STAGE_BYTES = 8 * HTB, NXCD = 8, WGM = 8;
__host__ __device__ __forceinline__ int lds_byte(int r, int c) { const int st = (r >> 4) * 2 + (c >> 5), rr = r & 15, cc = c & 31, ob = rr * 64 + cc * 2; return st * 1024 + (ob ^ (((ob >> 9) & 1) << 5)); }
__host__ __device__ __forceinline__ void stage_rc(int b, int& R, int& C) { const int st = b / 1024, sb = b % 1024, swz = sb ^ (((sb >> 9) & 1) << 5); R = (st >> 1) * 16 + swz / 64; C = (st & 1) * 32 + (swz % 64) / 2; }
__host__ __device__ __forceinline__ int perm32(int rho) { const int n = rho >> 4, i = rho & 15; return 8 * (i >> 2) + 4 * n + (i & 3); }

struct Unit { int pm, pn; };
struct Gemm { const bf16_t* A; int lda; const bf16_t* Bt; int M, N, K; };

struct StaticOrder {
    int nM, nN, nwg, G, c;
    __device__ void init(int M, int N, int G_, int c_) { nM = M / BM; nN = N / BM; nwg = nM * nN; G = G_; c = c_; }
    __device__ bool next(int i, Unit& u) const {
        const long L = (long)i * G + c; if (L >= nwg) return false;
        int wgid = (int)L; { const int q = nwg / NXCD, r = nwg % NXCD, xcd = wgid % NXCD, off = wgid / NXCD; wgid = (xcd < r ? xcd * (q + 1) : r * (q + 1) + (xcd - r) * q) + off; }
        const int nig = WGM * nN, gid = wgid / nig, fm = gid * WGM, gsz = (nM - fm) < WGM ? (nM - fm) : WGM;
        u.pm = fm + ((wgid % nig) % gsz); u.pn = (wgid % nig) / gsz; return true;
    }
};

template <int MODE> struct Epi {
    bf16_t* O; int ldo; const float* lb;
    __device__ __forceinline__ void operator()(const f32x4 (&acc)[2][2][4][2], const Unit& u, int wr, int wc, int fr, int fq) const {
        const int row0 = u.pm * BM + wr * 64 + fr;
        if constexpr (MODE == 1) {
            const int col0 = u.pn * 128 + wc * 32 + 8 * fq;
#pragma unroll
            for (int ai = 0; ai < 2; ++ai)
#pragma unroll
                for (int m = 0; m < 4; ++m) {
                    const f32x4 g0 = acc[ai][0][m][0], g1 = acc[ai][0][m][1], u0 = acc[ai][1][m][0], u1 = acc[ai][1][m][1];
                    u32x4 o;
                    o.x = cvt_pk_bf16(silu_f(g0[0]) * u0[0], silu_f(g0[1]) * u0[1]);
                    o.y = cvt_pk_bf16(silu_f(g0[2]) * u0[2], silu_f(g0[3]) * u0[3]);
                    o.z = cvt_pk_bf16(silu_f(g1[0]) * u1[0], silu_f(g1[1]) * u1[1]);
                    o.w = cvt_pk_bf16(silu_f(g1[2]) * u1[2], silu_f(g1[3]) * u1[3]);
                    *(u32x4*)(O + (size_t)(row0 + ai * HALF + m * 16) * ldo + col0) = o;
                    __builtin_amdgcn_sched_barrier(0);
                }
        } else {
            const int seg = u.pn >> 2;
#pragma unroll
            for (int bj = 0; bj < 2; ++bj) {
                const int col0 = u.pn * BM + bj * HALF + wc * 32 + 8 * fq;
                f32x4 l0 = {0.f, 0.f, 0.f, 0.f}, l1 = {0.f, 0.f, 0.f, 0.f};
                if (MODE == 2 && (seg == 2 || seg == 3)) { const float* lp = lb + (seg - 2) * 1024 + (col0 & 1023); l0 = *(const f32x4*)lp; l1 = *(const f32x4*)(lp + 4); }
#pragma unroll
                for (int ai = 0; ai < 2; ++ai)
#pragma unroll
                    for (int m = 0; m < 4; ++m) {
                        f32x4 v0 = acc[ai][bj][m][0], v1 = acc[ai][bj][m][1];
                        if constexpr (MODE == 3) {
#pragma unroll
                            for (int i = 0; i < 4; ++i) { v0[i] = gelu_tanh_f(v0[i]); v1[i] = gelu_tanh_f(v1[i]); }
                        }
                        if constexpr (MODE == 2) {
                            if (seg == 0 || seg == 4) {
#pragma unroll
                                for (int i = 0; i < 4; ++i) { v0[i] = silu_f(v0[i]); v1[i] = silu_f(v1[i]); }
                            } else if (seg >= 2) {
#pragma unroll
                                for (int i = 0; i < 4; ++i) {
                                    v0[i] = __logf(l0[i] + (1.f - l0[i]) * sigmoid_f(v0[i]));
                                    v1[i] = __logf(l1[i] + (1.f - l1[i]) * sigmoid_f(v1[i]));
                                }
                            }
                        }
                        u32x4 o;
                        o.x = cvt_pk_bf16(v0[0], v0[1]); o.y = cvt_pk_bf16(v0[2], v0[3]); o.z = cvt_pk_bf16(v1[0], v1[1]); o.w = cvt_pk_bf16(v1[2], v1[3]);
                        *(u32x4*)(O + (size_t)(row0 + ai * HALF + m * 16) * ldo + col0) = o;
                        __builtin_amdgcn_sched_barrier(0);
                    }
            }
        }
    }
};

template <class EpiT>
__device__ __forceinline__ void gemm_phase(LAS unsigned char* lds, const Gemm g, const StaticOrder& S, const EpiT& E) {
    const int tid = opaque_tid(), wid = __builtin_amdgcn_readfirstlane(tid >> 6), lane = tid & 63, wr = wid >> 2, wc = wid & 3, fr = lane & 15, fq = lane >> 4;
    const int K = g.K, nt = K / BK, lda = g.lda;
    unsigned voffA[2], voffB[2];
#pragma unroll
    for (int i = 0; i < 2; ++i) { int R, C; stage_rc(tid * 16 + i * 8192, R, C); const int Rb = (R & ~31) + perm32(R & 31);
        voffA[i] = (unsigned)(R * lda + C) * 2u; voffB[i] = (unsigned)(Rb * K + C) * 2u; }
    const size_t kstep = (size_t)(BK * 2);
    const size_t hstepA = (size_t)HALF * lda * 2, hstepB = (size_t)HALF * K * 2;
    const size_t tstepA = 2 * hstepA, tstepB = 2 * hstepB;
    const unsigned ldsw = (unsigned)wid * 1024u;
    const int aoff = lds_byte(wr * 64 + fr, fq * 8), boff = lds_byte(wc * 32 + fr, fq * 8);
#define PG8_SA(b, h) (((b) * 2 + (h)) * HTB)
#define PG8_SB(b, h) ((4 + (b) * 2 + (h)) * HTB)
#define PG8_STAGE(bufoff, gbase, voff) do { _Pragma("unroll") for (int _i = 0; _i < 2; ++_i) \
        __builtin_amdgcn_global_load_lds((const unsigned*)((const char*)(gbase) + (voff)[_i]), (LAS unsigned*)(lds + (bufoff) + ldsw + _i * 8192), 16, 0, 0); } while (0)
#define PG8_LDA(dst, b, h) do { _Pragma("unroll") for (int m = 0; m < 4; ++m) _Pragma("unroll") for (int k = 0; k < 2; ++k) dst[m][k] = *(const LAS bf16x8*)(lds + PG8_SA(b, h) + aoff + m * 2048 + k * 1024); } while (0)
#define PG8_LDB(dst, b, h) do { _Pragma("unroll") for (int n = 0; n < 2; ++n) _Pragma("unroll") for (int k = 0; k < 2; ++k) dst[n][k] = *(const LAS bf16x8*)(lds + PG8_SB(b, h) + boff + n * 2048 + k * 1024); } while (0)
#define PG8_MMA(ai, bj, At, Bt) do { __builtin_amdgcn_s_setprio(1); _Pragma("unroll") for (int m = 0; m < 4; ++m) _Pragma("unroll") for (int n = 0; n < 2; ++n) _Pragma("unroll") for (int k = 0; k < 2; ++k) \
        acc[ai][bj][m][n] = __builtin_amdgcn_mfma_f32_16x16x32_bf16(Bt[n][k], At[m][k], acc[ai][bj][m][n], 0, 0, 0); __builtin_amdgcn_s_setprio(0); } while (0)
#define PG8_WAIT_V(n) asm volatile("s_waitcnt vmcnt(" #n ")" ::: "memory")
#define PG8_WAIT_L(n) asm volatile("s_waitcnt lgkmcnt(" #n ")" ::: "memory")
#define PG8_BAR __builtin_amdgcn_s_barrier()
#define PG8_SCHED __builtin_amdgcn_sched_barrier(0)
    Unit cur, nxt; int ui = 0;
    if (!S.next(0, cur)) return;
    f32x4 acc[2][2][4][2];
#pragma unroll
    for (int a = 0; a < 2; ++a)
#pragma unroll
        for (int b = 0; b < 2; ++b)
#pragma unroll
            for (int m = 0; m < 4; ++m)
#pragma unroll
                for (int n = 0; n < 2; ++n) acc[a][b][m][n] = (f32x4){0.f, 0.f, 0.f, 0.f};
    bf16x8 At[4][2], B0[2][2], B1[2][2];
    const char* cA = (const char*)g.A + (size_t)cur.pm * tstepA; const char* cB = (const char*)g.Bt + (size_t)cur.pn * tstepB;
    PG8_STAGE(PG8_SB(0, 0), cB, voffB); PG8_STAGE(PG8_SA(0, 0), cA, voffA); PG8_STAGE(PG8_SB(0, 1), cB + hstepB, voffB); PG8_STAGE(PG8_SA(0, 1), cA + hstepA, voffA);
    if (wr == 1) PG8_BAR;
    PG8_WAIT_V(4); PG8_BAR;
    PG8_STAGE(PG8_SB(1, 0), cB + kstep, voffB); PG8_STAGE(PG8_SA(1, 0), cA + kstep, voffA); PG8_STAGE(PG8_SB(1, 1), cB + hstepB + kstep, voffB);
    PG8_WAIT_V(6); PG8_BAR;
    for (;;) {
        const bool has_next = S.next(ui + 1, nxt);
        const char* nA = has_next ? (const char*)g.A + (size_t)nxt.pm * tstepA : cA; const char* nB = has_next ? (const char*)g.Bt + (size_t)nxt.pn * tstepB : cB;
        for (int t = 0; t < nt; t += 2) {
            const bool last = (t == nt - 2);
            const char* a1 = cA + (size_t)(t + 1) * kstep;
            const char* a2 = last ? nA : cA + (size_t)(t + 2) * kstep; const char* b2 = last ? nB : cB + (size_t)(t + 2) * kstep;
            const char* a3 = a2 + kstep; const char* b3 = b2 + kstep;
            PG8_LDB(B0, 0, 0); PG8_SCHED; PG8_LDA(At, 0, 0); PG8_STAGE(PG8_SA(1, 1), a1 + hstepA, voffA);
            PG8_WAIT_L(8); PG8_BAR; PG8_WAIT_L(0); PG8_MMA(0, 0, At, B0); PG8_BAR; PG8_SCHED;
            PG8_LDB(B1, 0, 1); PG8_STAGE(PG8_SB(0, 0), b2, voffB);
            PG8_BAR; PG8_WAIT_L(0); PG8_MMA(0, 1, At, B1); PG8_BAR;
            PG8_LDA(At, 0, 1); PG8_STAGE(PG8_SA(0, 0), a2, voffA);
            PG8_BAR; PG8_WAIT_L(0); PG8_MMA(1, 0, At, B0); PG8_BAR; PG8_SCHED;
            PG8_STAGE(PG8_SB(0, 1), b2 + hstepB, voffB);
            PG8_WAIT_V(6); PG8_BAR; PG8_MMA(1, 1, At, B1); PG8_BAR;
            PG8_LDB(B0, 1, 0); PG8_SCHED; PG8_LDA(At, 1, 0); PG8_STAGE(PG8_SA(0, 1), a2 + hstepA, voffA);
            PG8_WAIT_L(8); PG8_BAR; PG8_WAIT_L(0); PG8_MMA(0, 0, At, B0); PG8_BAR; PG8_SCHED;
            PG8_LDB(B1, 1, 1); PG8_STAGE(PG8_SB(1, 0), b3, voffB);
            PG8_BAR; PG8_WAIT_L(0); PG8_MMA(0, 1, At, B1); PG8_BAR;
            PG8_LDA(At, 1, 1); PG8_STAGE(PG8_SA(1, 0), a3, voffA);
            PG8_BAR; PG8_WAIT_L(0); PG8_MMA(1, 0, At, B0); PG8_BAR; PG8_SCHED;
            PG8_STAGE(PG8_SB(1, 1), b3 + hstepB, voffB);
            PG8_WAIT_V(6); PG8_BAR; PG8_MMA(1, 1, At, B1); PG8_BAR;
        }
        E(acc, cur, wr, wc, fr, fq);
        if (!has_next) break;
#pragma unroll
        for (int a = 0; a < 2; ++a)
#pragma unroll
            for (int b = 0; b < 2; ++b)
#pragma unroll
                for (int m = 0; m < 4; ++m)
#pragma unroll
                    for (int n = 0; n < 2; ++n) acc[a][b][m][n] = (f32x4){0.f, 0.f, 0.f, 0.f};
        cur = nxt; cA = nA; cB = nB; ++ui;
    }
    PG8_WAIT_V(0);
    if (wr == 0) PG8_BAR;
    PG8_BAR;
#undef PG8_SA
#undef PG8_SB
#undef PG8_STAGE
#undef PG8_LDA
#undef PG8_LDB
#undef PG8_MMA
#undef PG8_WAIT_V
#undef PG8_WAIT_L
#undef PG8_BAR
#undef PG8_SCHED
}
}

template <int MODE>
__device__ __forceinline__ void run_gemm(LAS unsigned char* lds, const bf16_t* A, int lda, const bf16_t* Bt, int M, int N, int K, bf16_t* O, int ldo, const float* lb) {
    pg8::Gemm g{A, lda, Bt, M, N, K};
    pg8::StaticOrder S; S.init(M, N, gridDim.x, blockIdx.x);
    pg8::Epi<MODE> E{O, ldo, lb};
    pg8::gemm_phase(lds, g, S, E);
}

__device__ __forceinline__ void p0_mod_item(const Params& p, LAS unsigned char* lds, int item) {
    const int tid = opaque_tid();
    const int layer = item / 144, cgp = item % 144, col0 = cgp * 64;
    const float* c = p.in[1]; const float* cctx = p.in[3];
    const float* W = p.in[4] + (size_t)layer * 1024 * 9216; const float* bias = p.in[5] + (size_t)layer * 9216;
    float* mout = (float*)(p.ws + WS_MOD) + (size_t)layer * 33 * 9216;
    LAS float* S = (LAS float*)lds;
    __syncthreads();
    for (int i = tid; i < 33 * 1024; i += NTHREADS) { const int r = i >> 10, k = i & 1023; const float v = r < 32 ? c[r * 1024 + k] : cctx[k]; S[i] = silu_f(v); }
    __syncthreads();
    const int col = tid & 63, ks = tid >> 6;
    float acc[33];
#pragma unroll
    for (int r = 0; r < 33; ++r) acc[r] = 0.f;
    for (int k4 = 0; k4 < 32; ++k4) {
        const int k = ks * 128 + k4 * 4;
        const float w0 = W[(size_t)(k + 0) * 9216 + col0 + col], w1 = W[(size_t)(k + 1) * 9216 + col0 + col], w2 = W[(size_t)(k + 2) * 9216 + col0 + col], w3 = W[(size_t)(k + 3) * 9216 + col0 + col];
#pragma unroll
        for (int r = 0; r < 33; ++r) { const f32x4 s4 = *(const LAS f32x4*)(S + r * 1024 + k); acc[r] += w0 * s4[0] + w1 * s4[1] + w2 * s4[2] + w3 * s4[3]; }
    }
    __syncthreads();
    LAS float* red = (LAS float*)lds;
#pragma unroll
    for (int r = 0; r < 33; ++r) red[(ks * 33 + r) * 64 + col] = acc[r];
    __syncthreads();
    for (int i = tid; i < 33 * 64; i += NTHREADS) {
        const int r = i >> 6, cc = i & 63; float s = 0.f;
#pragma unroll
        for (int q = 0; q < 8; ++q) s += red[(q * 33 + r) * 64 + cc];
        mout[(size_t)r * 9216 + col0 + cc] = s + bias[col0 + cc];
    }
    __syncthreads();
}

__device__ __forceinline__ void p0_transpose_item(const float* W, int K, int N, bf16_t* WT, int k0, int n0, int drow0, LAS float* scr, int lane) {
#pragma unroll 8
    for (int i = 0; i < 32; ++i) { const int kk = 2 * i + (lane >> 5); scr[kk * 33 + (lane & 31)] = W[(size_t)(k0 + kk) * N + n0 + (lane & 31)]; }
    asm volatile("s_waitcnt lgkmcnt(0)" ::: "memory");
    const int c = lane & 7;
#pragma unroll
    for (int j = 0; j < 4; ++j) { const int n = (lane >> 3) + 8 * j; const LAS float* s = scr + (8 * c) * 33 + n;
        u32x4 o; o.x = cvt_pk_bf16(s[0 * 33], s[1 * 33]); o.y = cvt_pk_bf16(s[2 * 33], s[3 * 33]); o.z = cvt_pk_bf16(s[4 * 33], s[5 * 33]); o.w = cvt_pk_bf16(s[6 * 33], s[7 * 33]);
        *(u32x4*)(WT + (size_t)(drow0 + n) * K + k0 + 8 * c) = o; }
    asm volatile("s_waitcnt lgkmcnt(0)" ::: "memory");
}

__device__ __forceinline__ void phase0(const Params& p, LAS unsigned char* lds) {
    const int tid = opaque_tid(), wid = tid >> 6, lane = tid & 63;
    if (blockIdx.x == gridDim.x - 1) {
        const float* lbp = p.in[11]; float* lbo = (float*)(p.ws + WS_LB);
        for (int i = tid; i < 2048; i += NTHREADS) { const int dir = i >> 10, col = i & 1023;
            const float l0 = lbp[(dir * 3 + 0) * 1024 + col], l1 = lbp[(dir * 3 + 1) * 1024 + col], l2 = lbp[(dir * 3 + 2) * 1024 + col];
            const float mx = fmaxf(l0, fmaxf(l1, l2)); const float e0 = __expf(l0 - mx), e1 = __expf(l1 - mx), e2 = __expf(l2 - mx);
            lbo[i] = e0 / (e0 + e1 + e2); }
    }
    if (blockIdx.x == gridDim.x - 2) {
        const float* wsp = p.in[17]; bf16_t* wsb = (bf16_t*)(p.ws + WS_WSB);
        for (int i = tid; i < 8 * 128 * 128 / 4; i += NTHREADS) { const f32x4 w = *(const f32x4*)(wsp + 4 * i); u32x2 o; o.x = cvt_pk_bf16(w[0], w[1]); o.y = cvt_pk_bf16(w[2], w[3]); *(u32x2*)(wsb + 4 * i) = o; }
    }
    for (int it = blockIdx.x; it < 288; it += gridDim.x) p0_mod_item(p, lds, it);
    __syncthreads();
    LAS float* scr = (LAS float*)lds + wid * (64 * 33);
    const int gw = blockIdx.x * 8 + wid, nw = gridDim.x * 8;
    for (int mi = 0; mi < 12; ++mi) {
        const float* W; bf16_t* WT; int K, N, mode = 0;
        if (mi < 4) { W = p.in[8] + (size_t)mi * 1024 * 5632; WT = (bf16_t*)(p.ws + WS_FIN) + (size_t)mi * 5632 * 1024; K = 1024; N = 5632; mode = 1; }
        else if (mi < 8) { W = p.in[9] + (size_t)(mi - 4) * 2816 * 1024; WT = (bf16_t*)(p.ws + WS_FOUT) + (size_t)(mi - 4) * 1024 * 2816; K = 2816; N = 1024; }
        else if (mi == 8) { W = p.in[10]; WT = (bf16_t*)(p.ws + WS_HIN); K = 1024; N = 5120; }
        else if (mi == 9) { W = p.in[13]; WT = (bf16_t*)(p.ws + WS_HOUT); K = 1024; N = 1024; }
        else if (mi == 10) { W = p.in[14]; WT = (bf16_t*)(p.ws + WS_CIN); K = 1024; N = 6144; }
        else { W = p.in[19]; WT = (bf16_t*)(p.ws + WS_COUT); K = 3072; N = 1024; }
        const int nblk = N / 32, nitems = (K / 64) * nblk;
        for (int it = gw; it < nitems; it += nw) {
            const int kb = it / nblk, nb = it % nblk, n0 = nb * 32;
            int drow0 = n0;
            if (mode == 1) { const int j = n0 < FH ? n0 : n0 - FH; drow0 = 256 * (j >> 7) + (n0 < FH ? 0 : 128) + (j & 127); }
            p0_transpose_item(W, K, N, WT, kb * 64, n0, drow0, scr, lane);
        }
    }
}

struct RowArgs {
    const float* xs_x; const float* xs_c; int nrows;
    const bf16_t* y; float ysc; const float* m; int k; const float* g; const float* b;
    float* xd; bf16_t* hd; const float* m2; int k2;
};
__device__ __forceinline__ void row_phase(const RowArgs& a) {
    const int tid0 = opaque_tid(); const int wid = tid0 >> 6, lane = tid0 & 63;
    for (int row = blockIdx.x * 8 + wid; row < a.nrows; row += gridDim.x * 8) {
        const int mrow = row < MX ? (row >> 11) : 32;
        const float* xr = row < MX ? a.xs_x + (size_t)row * D : a.xs_c + (size_t)(row - MX) * D;
        f32x4 v[4];
#pragma unroll
        for (int j = 0; j < 4; ++j) v[j] = *(const f32x4*)(xr + j * 256 + lane * 4);
        if (a.y) {
            const float* gp = a.m + (size_t)mrow * 9216 + (3 * a.k + 2) * 1024;
            float s = 0.f;
#pragma unroll
            for (int j = 0; j < 4; ++j) {
                const u32x2 yy = *(const u32x2*)(a.y + (size_t)row * D + j * 256 + lane * 4);
                const f32x4 gt = *(const f32x4*)(gp + j * 256 + lane * 4);
                v[j][0] = DN_ALPHA * v[j][0] + gt[0] * a.ysc * bf_lo(yy.x); v[j][1] = DN_ALPHA * v[j][1] + gt[1] * a.ysc * bf_hi(yy.x);
                v[j][2] = DN_ALPHA * v[j][2] + gt[2] * a.ysc * bf_lo(yy.y); v[j][3] = DN_ALPHA * v[j][3] + gt[3] * a.ysc * bf_hi(yy.y);
                s += (v[j][0] + v[j][1]) + (v[j][2] + v[j][3]);
            }
            const float mean = wave_sum(s) * (1.f / D); float s2 = 0.f;
#pragma unroll
            for (int j = 0; j < 4; ++j) { v[j] = v[j] - mean; s2 += (v[j][0] * v[j][0] + v[j][1] * v[j][1]) + (v[j][2] * v[j][2] + v[j][3] * v[j][3]); }
            const float rstd = __builtin_amdgcn_rsqf(wave_sum(s2) * (1.f / D) + LN_EPS);
#pragma unroll
            for (int j = 0; j < 4; ++j) { const f32x4 gg = *(const f32x4*)(a.g + j * 256 + lane * 4), bb = *(const f32x4*)(a.b + j * 256 + lane * 4); v[j] = v[j] * rstd * gg + bb; }
            if (a.xd && row < MX) {
#pragma unroll
                for (int j = 0; j < 4; ++j) *(f32x4*)(a.xd + (size_t)row * D + j * 256 + lane * 4) = v[j];
            }
        }
        if (a.hd) {
            const float* shp = a.m2 + (size_t)mrow * 9216 + (3 * a.k2) * 1024; const float* scp = shp + 1024;
#pragma unroll
            for (int j = 0; j < 4; ++j) {
                const f32x4 sh = *(const f32x4*)(shp + j * 256 + lane * 4), sc = *(const f32x4*)(scp + j * 256 + lane * 4);
                const f32x4 h = v[j] * (sc + 1.f) + sh;
                u32x2 o; o.x = cvt_pk_bf16(h[0], h[1]); o.y = cvt_pk_bf16(h[2], h[3]);
                *(u32x2*)(a.hd + (size_t)row * D + j * 256 + lane * 4) = o;
            }
        }
    }
}

constexpr int GLA_DIRB = 74240;
__device__ __forceinline__ void gla_phase(const Params& p, LAS unsigned char* lds) {
    const int tid = opaque_tid(), dir = tid >> 8, tl = tid & 255, w = tl >> 6, lane = tl & 63, fr = lane & 15, fq = lane >> 4;
    const int cp = lane, qt = w;
    bf16_t* P = (bf16_t*)(p.ws + WS_BIG); bf16_t* R = (bf16_t*)(p.ws + WS_A0);
    const float* normw = p.in[12];
    LAS unsigned char* base = lds + dir * GLA_DIRB;
    LAS bf16_t* Qin = (LAS bf16_t*)base;
    LAS bf16_t* Kin = (LAS bf16_t*)(base + 17408);
    LAS bf16_t* Sc = Kin;
    LAS bf16_t* KinT = (LAS bf16_t*)(base + 34816);
    LAS bf16_t* VT = (LAS bf16_t*)(base + 53248);
    LAS float* tot = (LAS float*)(base + 71680);
    LAS float* dec = (LAS float*)(base + 73728);
    for (int item = blockIdx.x; item < NB * 8; item += gridDim.x) {
        const int b = item >> 3, h = item & 7;
        f32x4 Sacc[8][2];
#pragma unroll
        for (int m = 0; m < 8; ++m) { Sacc[m][0] = (f32x4){0.f, 0.f, 0.f, 0.f}; Sacc[m][1] = (f32x4){0.f, 0.f, 0.f, 0.f}; }
        unsigned rq[16], rv[16], rl[16];
        auto chunk_row = [&](int ci, int t) -> size_t {
            const bool isc = ci < 4; const int lc = isc ? ci : ci - 4, L = isc ? CTXL : SEQ; const int rbase = isc ? MX + b * CTXL : b * SEQ;
            const int tok = dir == 0 ? 64 * lc + t : L - 1 - (64 * lc + t);
            return (size_t)(rbase + tok);
        };
        auto load_chunk = [&](int ci) {
            const bf16_t* rp = P + chunk_row(ci, 16 * qt) * HG5 + h * 128 + 2 * cp;
            const long step = dir == 0 ? (long)HG5 : -(long)HG5;
#pragma unroll
            for (int i = 0; i < 16; ++i) {
                rq[i] = *(const unsigned*)rp; rv[i] = *(const unsigned*)(rp + 1024); rl[i] = *(const unsigned*)(rp + (2 + dir) * 1024);
                rp += step; asm volatile("" : "+v"(rp));
            }
        };
        __syncthreads();
        load_chunk(0);
        for (int ci = 0; ci < 36; ++ci) {
            const bool isc = ci < 4;
            {
                float run0 = 0.f, run1 = 0.f;
#pragma unroll
                for (int i = 0; i < 16; ++i) { run0 += bf_lo(rl[i]); run1 += bf_hi(rl[i]); }
                *(LAS f32x2*)(tot + qt * 128 + 2 * cp) = (f32x2){run0, run1};
#pragma unroll
                for (int hh = 0; hh < 2; ++hh) {
                    u32x4 a, c;
#pragma unroll
                    for (int u = 0; u < 4; ++u) { const int ip = 4 * hh + u;
                        a[u] = (rv[2 * ip] & 0xffffu) | (rv[2 * ip + 1] << 16); c[u] = (rv[2 * ip] >> 16) | (rv[2 * ip + 1] & 0xffff0000u); }
                    *(LAS u32x4*)(VT + (2 * cp) * 72 + 16 * qt + 8 * hh) = a;
                    *(LAS u32x4*)(VT + (2 * cp + 1) * 72 + 16 * qt + 8 * hh) = c;
                }
                __syncthreads();
                float pre0 = 0.f, pre1 = 0.f, all0 = 0.f, all1 = 0.f;
#pragma unroll
                for (int q = 0; q < 4; ++q) { const f32x2 tq = *(const LAS f32x2*)(tot + q * 128 + 2 * cp); if (q < qt) { pre0 += tq[0]; pre1 += tq[1]; } all0 += tq[0]; all1 += tq[1]; }
                if (qt == 0) *(LAS f32x2*)(dec + 2 * cp) = (f32x2){__expf(all0), __expf(all1)};
                float iebp0 = __expf(-pre0), iebp1 = __expf(-pre1);
                float bb0 = pre0, bb1 = pre1;
#pragma unroll
                for (int hh = 0; hh < 2; ++hh) {
                    u32x4 a, c;
#pragma unroll
                    for (int u4 = 0; u4 < 4; ++u4) {
                        float kin0[2], kin1[2];
#pragma unroll
                        for (int u = 0; u < 2; ++u) {
                            const int i = 8 * hh + 2 * u4 + u, t = 16 * qt + i;
                            bb0 += bf_lo(rl[i]); bb1 += bf_hi(rl[i]);
                            const float eb0 = __expf(bb0), eb1 = __expf(bb1), ieb0 = __expf(-bb0), ieb1 = __expf(-bb1);
                            const float k0 = 1.f - eb0 * iebp0, k1 = 1.f - eb1 * iebp1;
                            iebp0 = ieb0; iebp1 = ieb1;
                            kin0[u] = k0 * ieb0; kin1[u] = k1 * ieb1;
                            *(LAS unsigned*)(Qin + t * 136 + 2 * cp) = cvt_pk_bf16(bf_lo(rq[i]) * eb0, bf_hi(rq[i]) * eb1);
                            *(LAS unsigned*)(Kin + t * 136 + 2 * cp) = cvt_pk_bf16(kin0[u], kin1[u]);
                        }
                        a[u4] = cvt_pk_bf16(kin0[0], kin0[1]); c[u4] = cvt_pk_bf16(kin1[0], kin1[1]);
                    }
                    *(LAS u32x4*)(KinT + (2 * cp) * 72 + 16 * qt + 8 * hh) = a;
                    *(LAS u32x4*)(KinT + (2 * cp + 1) * 72 + 16 * qt + 8 * hh) = c;
                    __builtin_amdgcn_sched_barrier(0);
                }
            }
            __syncthreads();
            if (ci + 1 < 36) load_chunk(ci + 1);
            f32x4 sacc[4];
            if (!isc) {
                bf16x8 qf[4];
#pragma unroll
                for (int ks = 0; ks < 4; ++ks) qf[ks] = *(const LAS bf16x8*)(Qin + (16 * w + fr) * 136 + 32 * ks + 8 * fq);
#pragma unroll
                for (int ms = 0; ms < 4; ++ms) {
                    sacc[ms] = (f32x4){0.f, 0.f, 0.f, 0.f};
                    if (ms <= w) {
#pragma unroll
                        for (int ks = 0; ks < 4; ++ks) { const bf16x8 kf = *(const LAS bf16x8*)(Kin + (16 * ms + fr) * 136 + 32 * ks + 8 * fq);
                            sacc[ms] = __builtin_amdgcn_mfma_f32_16x16x32_bf16(kf, qf[ks], sacc[ms], 0, 0, 0); }
                    }
                }
            }
            __syncthreads();
            if (!isc) {
#pragma unroll
                for (int ms = 0; ms < 4; ++ms) {
                    f32x4 v = sacc[ms];
                    if (ms == w) {
#pragma unroll
                        for (int j = 0; j < 4; ++j) v[j] = (4 * fq + j <= fr) ? v[j] : 0.f;
                    }
                    u32x2 o; o.x = cvt_pk_bf16(v[0], v[1]); o.y = cvt_pk_bf16(v[2], v[3]);
                    *(LAS u32x2*)(Sc + (16 * w + fr) * 72 + 16 * ms + 4 * fq) = o;
                }
            }
            __syncthreads();
            __builtin_amdgcn_sched_barrier(0);
            bf16x8 vfrag[2][2];
#pragma unroll
            for (int n = 0; n < 2; ++n)
#pragma unroll
                for (int ks = 0; ks < 2; ++ks) vfrag[n][ks] = *(const LAS bf16x8*)(VT + (32 * w + 16 * n + fr) * 72 + 32 * ks + 8 * fq);
            if (!isc) {
                f32x4 oacc[2][4];
#pragma unroll
                for (int n = 0; n < 2; ++n)
#pragma unroll
                    for (int tt = 0; tt < 4; ++tt) oacc[n][tt] = (f32x4){0.f, 0.f, 0.f, 0.f};
#pragma unroll
                for (int kk = 0; kk < 4; ++kk) {
                    bf16x8 sf[2];
#pragma unroll
                    for (int n = 0; n < 2; ++n) {
                        u32x4 pk; pk.x = cvt_pk_bf16(Sacc[2 * kk][n][0], Sacc[2 * kk][n][1]); pk.y = cvt_pk_bf16(Sacc[2 * kk][n][2], Sacc[2 * kk][n][3]);
                        pk.z = cvt_pk_bf16(Sacc[2 * kk + 1][n][0], Sacc[2 * kk + 1][n][1]); pk.w = cvt_pk_bf16(Sacc[2 * kk + 1][n][2], Sacc[2 * kk + 1][n][3]);
                        sf[n] = __builtin_bit_cast(bf16x8, pk);
                    }
#pragma unroll
                    for (int tt = 0; tt < 4; ++tt) {
                        const LAS bf16_t* qp = Qin + (16 * tt + fr) * 136 + 32 * kk + 4 * fq;
                        const u32x2 lo = *(const LAS u32x2*)qp, hi = *(const LAS u32x2*)(qp + 16);
                        const bf16x8 qfr = __builtin_bit_cast(bf16x8, ((u32x4){lo.x, lo.y, hi.x, hi.y}));
#pragma unroll
                        for (int n = 0; n < 2; ++n) oacc[n][tt] = __builtin_amdgcn_mfma_f32_16x16x32_bf16(sf[n], qfr, oacc[n][tt], 0, 0, 0);
                    }
                }
                __builtin_amdgcn_sched_barrier(0);
#pragma unroll
                for (int tt = 0; tt < 4; ++tt)
#pragma unroll
                    for (int ks = 0; ks < 2; ++ks) {
                        if (ks == 1 && tt < 2) continue;
                        const bf16x8 scf = *(const LAS bf16x8*)(Sc + (16 * tt + fr) * 72 + 32 * ks + 8 * fq);
#pragma unroll
                        for (int n = 0; n < 2; ++n) oacc[n][tt] = __builtin_amdgcn_mfma_f32_16x16x32_bf16(vfrag[n][ks], scf, oacc[n][tt], 0, 0, 0);
                    }
                __builtin_amdgcn_sched_barrier(0);
#pragma unroll
                for (int tt = 0; tt < 4; ++tt) {
                    bf16_t* op = P + chunk_row(ci, 16 * tt + fr) * HG5 + (2 + dir) * 1024 + h * 128 + 32 * w + 4 * fq;
#pragma unroll
                    for (int n = 0; n < 2; ++n) { u32x2 o; o.x = cvt_pk_bf16(oacc[n][tt][0], oacc[n][tt][1]); o.y = cvt_pk_bf16(oacc[n][tt][2], oacc[n][tt][3]); *(u32x2*)(op + 16 * n) = o; }
                }
            }
            __builtin_amdgcn_sched_barrier(0);
#pragma unroll
            for (int m = 0; m < 8; ++m) {
#pragma unroll
                for (int ks = 0; ks < 2; ++ks) { const bf16x8 kf = *(const LAS bf16x8*)(KinT + (16 * m + fr) * 72 + 32 * ks + 8 * fq);
#pragma unroll
                    for (int n = 0; n < 2; ++n) Sacc[m][n] = __builtin_amdgcn_mfma_f32_16x16x32_bf16(kf, vfrag[n][ks], Sacc[m][n], 0, 0, 0); }
                const f32x4 dv = *(const LAS f32x4*)(dec + 16 * m + 4 * fq);
                Sacc[m][0] *= dv; Sacc[m][1] *= dv;
            }
            __syncthreads();
        }
        __threadfence(); __syncthreads(); __threadfence();
        {
            const int wid = tid >> 6, lane = tid & 63, sub = lane >> 4, l16 = lane & 15;
            const f32x4 w0 = *(const f32x4*)(normw + 8 * l16), w1 = *(const f32x4*)(normw + 8 * l16 + 4);
#pragma unroll 4
            for (int it = 0; it < 64; ++it) {
                const int t = it * 32 + wid * 4 + sub; const size_t row = (size_t)b * SEQ + t;
                const bf16_t* rp = P + row * HG5 + h * 128 + 8 * l16;
                const u32x4 of = *(const u32x4*)(rp + 2048), ob = *(const u32x4*)(rp + 3072), gg = *(const u32x4*)(rp + 4096);
                float o[8];
                o[0] = bf_lo(of.x) + bf_lo(ob.x); o[1] = bf_hi(of.x) + bf_hi(ob.x); o[2] = bf_lo(of.y) + bf_lo(ob.y); o[3] = bf_hi(of.y) + bf_hi(ob.y);
                o[4] = bf_lo(of.z) + bf_lo(ob.z); o[5] = bf_hi(of.z) + bf_hi(ob.z); o[6] = bf_lo(of.w) + bf_lo(ob.w); o[7] = bf_hi(of.w) + bf_hi(ob.w);
                float ss = 0.f;
#pragma unroll
                for (int i = 0; i < 8; ++i) ss += o[i] * o[i];
                ss += __shfl_xor(ss, 1); ss += __shfl_xor(ss, 2); ss += __shfl_xor(ss, 4); ss += __shfl_xor(ss, 8);
                const float rs = __builtin_amdgcn_rsqf(ss * (1.f / 128.f) + RMS_EPS);
                u32x4 r;
                r.x = cvt_pk_bf16(o[0] * rs * w0[0] * bf_lo(gg.x), o[1] * rs * w0[1] * bf_hi(gg.x));
                r.y = cvt_pk_bf16(o[2] * rs * w0[2] * bf_lo(gg.y), o[3] * rs * w0[3] * bf_hi(gg.y));
                r.z = cvt_pk_bf16(o[4] * rs * w1[0] * bf_lo(gg.z), o[5] * rs * w1[1] * bf_hi(gg.z));
                r.w = cvt_pk_bf16(o[6] * rs * w1[2] * bf_lo(gg.w), o[7] * rs * w1[3] * bf_hi(gg.w));
                *(u32x4*)(R + row * D + h * 128 + 8 * l16) = r;
            }
        }
        __syncthreads();
    }
}

__device__ __forceinline__ void cm_gate_phase(const Params& p, LAS unsigned char* lds) {
    const int tid = opaque_tid(), wid = tid >> 6, lane = tid & 63, fr = lane & 15, fq = lane >> 4;
    bf16_t* UV = (bf16_t*)(p.ws + WS_BIG);
    const float* vg = p.in[15]; const float* vb = p.in[16]; const float* bs = p.in[18];
    const bf16_t* WSB = (const bf16_t*)(p.ws + WS_WSB);
    LAS bf16_t* Wl = (LAS bf16_t*)lds; LAS bf16_t* Vl = (LAS bf16_t*)(lds + 34816); LAS float* st = (LAS float*)(lds + 34816 + 100352); LAS float* bl = st + 256;
    const int c8 = lane < 48 ? lane : 47;
    for (int ch = blockIdx.x; ch < MX / 128; ch += gridDim.x) {
        const size_t row0 = (size_t)ch * 128;
        __syncthreads();
        for (int rr = 0; rr < 8; ++rr) {
            const int r = wid * 16 + 2 * rr; const bf16_t* vp = UV + (row0 + r) * 6144 + 3072;
            u32x4 x[2][6]; float s[2] = {0.f, 0.f};
#pragma unroll
            for (int q = 0; q < 2; ++q)
#pragma unroll
                for (int i = 0; i < 6; ++i) x[q][i] = *(const u32x4*)(vp + (size_t)q * 6144 + (i * 64 + lane) * 8);
#pragma unroll
            for (int q = 0; q < 2; ++q)
#pragma unroll
                for (int i = 0; i < 6; ++i) s[q] += (bf_lo(x[q][i].x) + bf_hi(x[q][i].x)) + (bf_lo(x[q][i].y) + bf_hi(x[q][i].y)) + (bf_lo(x[q][i].z) + bf_hi(x[q][i].z)) + (bf_lo(x[q][i].w) + bf_hi(x[q][i].w));
            float mean[2], s2[2] = {0.f, 0.f};
#pragma unroll
            for (int q = 0; q < 2; ++q) mean[q] = wave_sum(s[q]) * (1.f / 3072.f);
#pragma unroll
            for (int q = 0; q < 2; ++q)
#pragma unroll
                for (int i = 0; i < 6; ++i) { float d;
                    d = bf_lo(x[q][i].x) - mean[q]; s2[q] += d * d; d = bf_hi(x[q][i].x) - mean[q]; s2[q] += d * d; d = bf_lo(x[q][i].y) - mean[q]; s2[q] += d * d; d = bf_hi(x[q][i].y) - mean[q]; s2[q] += d * d;
                    d = bf_lo(x[q][i].z) - mean[q]; s2[q] += d * d; d = bf_hi(x[q][i].z) - mean[q]; s2[q] += d * d; d = bf_lo(x[q][i].w) - mean[q]; s2[q] += d * d; d = bf_hi(x[q][i].w) - mean[q]; s2[q] += d * d; }
#pragma unroll
            for (int q = 0; q < 2; ++q) { const float rstd = __builtin_amdgcn_rsqf(wave_sum(s2[q]) * (1.f / 3072.f) + LN_EPS); if (lane == 0) { st[2 * (r + q)] = mean[q]; st[2 * (r + q) + 1] = rstd; } }
        }
        for (int g = 0; g < 8; ++g) {
            __syncthreads();
#pragma unroll
            for (int i = 0; i < 4; ++i) { const int idx = tid + NTHREADS * i, r = idx >> 4, cc = idx & 15;
                *(LAS u32x4*)(Wl + r * 136 + cc * 8) = *(const u32x4*)(WSB + (size_t)g * 16384 + r * 128 + cc * 8); }
            if (tid < 128) bl[tid] = bs[g * 128 + tid];
            {
                const float* gp = vg + g * 384 + c8 * 8; const float* bp = vb + g * 384 + c8 * 8;
                const f32x4 g0 = *(const f32x4*)gp, g1 = *(const f32x4*)(gp + 4), b0 = *(const f32x4*)bp, b1 = *(const f32x4*)(bp + 4);
                const bf16_t* xp = UV + (row0 + wid) * 6144 + 3072 + g * 384 + c8 * 8;
#pragma unroll
                for (int hb = 0; hb < 2; ++hb) {
                    u32x4 xv[8];
#pragma unroll
                    for (int i = 0; i < 8; ++i) { xv[i] = *(const u32x4*)xp; xp += 8 * 6144; asm volatile("" : "+v"(xp)); }
#pragma unroll
                    for (int i = 0; i < 8; ++i) { const int sr = wid + 8 * (8 * hb + i);
                        const f32x2 ms = *(const LAS f32x2*)(st + 2 * sr); const float mean = ms[0], rstd = ms[1]; const u32x4 x = xv[i];
                        u32x4 o;
                        o.x = cvt_pk_bf16((bf_lo(x.x) - mean) * rstd * g0[0] + b0[0], (bf_hi(x.x) - mean) * rstd * g0[1] + b0[1]);
                        o.y = cvt_pk_bf16((bf_lo(x.y) - mean) * rstd * g0[2] + b0[2], (bf_hi(x.y) - mean) * rstd * g0[3] + b0[3]);
                        o.z = cvt_pk_bf16((bf_lo(x.z) - mean) * rstd * g1[0] + b1[0], (bf_hi(x.z) - mean) * rstd * g1[1] + b1[1]);
                        o.w = cvt_pk_bf16((bf_lo(x.w) - mean) * rstd * g1[2] + b1[2], (bf_hi(x.w) - mean) * rstd * g1[3] + b1[3]);
                        if (lane < 48) *(LAS u32x4*)(Vl + sr * 392 + c8 * 8) = o; }
                }
            }
            __syncthreads();
            u32x2 uu[8][3];
            { const bf16_t* up = UV + (row0 + fr) * 6144 + g * 384 + wid * 48 + 4 * fq;
#pragma unroll
            for (int m = 0; m < 8; ++m) {
#pragma unroll
                for (int n = 0; n < 3; ++n) uu[m][n] = *(const u32x2*)(up + n * 16);
                up += 16 * 6144; asm volatile("" : "+v"(up)); } }
            f32x4 acc[3][8];
#pragma unroll
            for (int n = 0; n < 3; ++n)
#pragma unroll
                for (int m = 0; m < 8; ++m) acc[n][m] = (f32x4){0.f, 0.f, 0.f, 0.f};
#pragma unroll 1
            for (int ks = 0; ks < 4; ++ks) {
                bf16x8 af[3];
#pragma unroll
                for (int n = 0; n < 3; ++n) {
                    const LAS bf16_t* vp = Vl + (32 * ks + 8 * fq) * 392 + wid * 48 + n * 16 + fr;
#pragma unroll
                    for (int i = 0; i < 8; ++i) af[n][i] = (short)vp[i * 392];
                }
#pragma unroll
                for (int m = 0; m < 8; ++m) {
                    const bf16x8 bfrag = *(const LAS bf16x8*)(Wl + (16 * m + fr) * 136 + 32 * ks + 8 * fq);
#pragma unroll
                    for (int n = 0; n < 3; ++n) acc[n][m] = __builtin_amdgcn_mfma_f32_16x16x32_bf16(af[n], bfrag, acc[n][m], 0, 0, 0);
                    if (m & 1) __builtin_amdgcn_sched_barrier(0);
                }
            }
            bf16_t* zp = UV + (row0 + fr) * 6144 + g * 384 + wid * 48 + 4 * fq;
#pragma unroll
            for (int m = 0; m < 8; ++m) {
                const float bias = bl[16 * m + fr];
#pragma unroll
                for (int n = 0; n < 3; ++n) {
                    const u32x2 u2 = uu[m][n];
                    u32x2 o; o.x = cvt_pk_bf16(bf_lo(u2.x) * (acc[n][m][0] + bias), bf_hi(u2.x) * (acc[n][m][1] + bias));
                    o.y = cvt_pk_bf16(bf_lo(u2.y) * (acc[n][m][2] + bias), bf_hi(u2.y) * (acc[n][m][3] + bias));
                    *(u32x2*)(zp + n * 16) = o;
                }
                zp += 16 * 6144; asm volatile("" : "+v"(zp));
            }
        }
    }
}

#ifndef EN_MASK
#define EN_MASK 255
#endif
constexpr int EN = EN_MASK;
__global__ void __launch_bounds__(NTHREADS, 2) fwd_megakernel(Params p) {
    extern __shared__ __attribute__((aligned(16))) unsigned char lds_raw[];
    LAS unsigned char* lds = (LAS unsigned char*)lds_raw;
    cg::grid_group grid = cg::this_grid();
    const float* x_in = p.in[0]; const float* ctx_in = p.in[2];
    const float* mod0 = (const float*)(p.ws + WS_MOD); const float* mod1 = mod0 + (size_t)33 * 9216;
    const float* lbv = (const float*)(p.ws + WS_LB);
    const float* ln_g = p.in[6]; const float* ln_b = p.in[7];
    bf16_t* A0 = (bf16_t*)(p.ws + WS_A0); bf16_t* BIG = (bf16_t*)(p.ws + WS_BIG);
    const bf16_t* FIN = (const bf16_t*)(p.ws + WS_FIN); const bf16_t* FOUT = (const bf16_t*)(p.ws + WS_FOUT);
    const bf16_t* HIN = (const bf16_t*)(p.ws + WS_HIN); const bf16_t* HOUT = (const bf16_t*)(p.ws + WS_HOUT);
    const bf16_t* CIN = (const bf16_t*)(p.ws + WS_CIN); const bf16_t* COUT = (const bf16_t*)(p.ws + WS_COUT);
    const size_t FIN_SZ = (size_t)5632 * 1024, FOUT_SZ = (size_t)1024 * 2816;
    for (int ph = p.ph_lo; ph < p.ph_hi; ++ph) {
        int kind;
        switch (ph) {
        case 0: kind = 0; break;
        case 1: case 4: case 8: case 11: case 14: case 18: case 21: kind = 1; break;
        case 2: case 9: case 12: case 19: kind = 2; break;
        case 3: case 7: case 10: case 13: case 17: case 20: kind = 3; break;
        case 5: kind = 4; break;
        case 6: kind = 5; break;
        case 15: kind = 6; break;
        default: kind = 7; break;
        }
        if (kind == 0) { if (EN & 1) phase0(p, lds); }
        else if (kind == 1) {
            RowArgs a;
            a.xs_x = p.out; a.xs_c = nullptr; a.nrows = MX; a.y = A0; a.ysc = 0.5f; a.xd = p.out; a.hd = A0;
            if (ph == 1) { a.xs_x = x_in; a.xs_c = ctx_in; a.nrows = MT; a.y = nullptr; a.m = mod0; a.k = 0; a.g = ln_g; a.b = ln_b; a.m2 = mod0; a.k2 = 0; }
            else if (ph == 4) { a.xs_x = x_in; a.xs_c = ctx_in; a.nrows = MT; a.m = mod0; a.k = 0; a.g = ln_g + 0 * D; a.b = ln_b + 0 * D; a.m2 = mod0; a.k2 = 1; }
            else if (ph == 8) { a.y = BIG; a.ysc = 1.f; a.m = mod0; a.k = 1; a.g = ln_g + 1 * D; a.b = ln_b + 1 * D; a.m2 = mod0; a.k2 = 2; }
            else if (ph == 11) { a.m = mod0; a.k = 2; a.g = ln_g + 2 * D; a.b = ln_b + 2 * D; a.m2 = mod1; a.k2 = 0; }
            else if (ph == 14) { a.m = mod1; a.k = 0; a.g = ln_g + 3 * D; a.b = ln_b + 3 * D; a.m2 = mod1; a.k2 = 1; }
            else if (ph == 18) { a.ysc = 1.f; a.m = mod1; a.k = 1; a.g = ln_g + 4 * D; a.b = ln_b + 4 * D; a.m2 = mod1; a.k2 = 2; }
            else { a.m = mod1; a.k = 2; a.g = ln_g + 5 * D; a.b = ln_b + 5 * D; a.hd = nullptr; a.m2 = mod1; a.k2 = 0; }
            if (EN & 2) row_phase(a);
        } else if (kind == 2) {
            const int wi = ph == 2 ? 0 : (ph == 9 ? 1 : (ph == 12 ? 2 : 3));
            if (EN & 4) run_gemm<1>(lds, A0, D, FIN + wi * FIN_SZ, ph == 2 ? MT : MX, 2 * FH, D, BIG, FH, nullptr);
        } else if (kind == 3) {
            const bf16_t* A = BIG; int lda = FH, M = MX, K = FH; const bf16_t* Bt; bf16_t* O = A0;
            if (ph == 3) { Bt = FOUT; M = MT; }
            else if (ph == 7) { A = A0; lda = D; K = D; Bt = HOUT; O = BIG; }
            else if (ph == 10) Bt = FOUT + 1 * FOUT_SZ;
            else if (ph == 13) Bt = FOUT + 2 * FOUT_SZ;
            else if (ph == 17) { lda = 2 * CMI; K = CMI; Bt = COUT; }
            else Bt = FOUT + 3 * FOUT_SZ;
            if (EN & 8) run_gemm<0>(lds, A, lda, Bt, M, D, K, O, D, nullptr);
        } else if (kind == 4) { if (EN & 16) run_gemm<2>(lds, A0, D, HIN, MT, HG5, D, BIG, HG5, lbv); }
        else if (kind == 5) { if (EN & 32) gla_phase(p, lds); }
        else if (kind == 6) { if (EN & 64) run_gemm<3>(lds, A0, D, CIN, MX, 2 * CMI, D, BIG, 2 * CMI, nullptr); }
        else { if (EN & 128) cm_gate_phase(p, lds); }
        if (ph + 1 < p.ph_hi) grid.sync();
    }
}

extern "C" void kernel_launch(void* const* d_in, const int* in_sizes, int n_in, void* d_out, int out_size, void* d_ws, size_t ws_size, hipStream_t stream) {
    static int grid_blocks = 0;
    if (grid_blocks == 0) {
        if (n_in != 20 || out_size != MX * D || ws_size < WS_END) { fprintf(stderr, "kernel_launch: unexpected shapes (n_in %d out %d ws %zu need %zu)\n", n_in, out_size, ws_size, (size_t)WS_END); grid_blocks = -1; return; }
        int dev = 0, cus = 0, per_cu = 0;
        hipGetDevice(&dev);
        hipDeviceGetAttribute(&cus, hipDeviceAttributeMultiprocessorCount, dev);
        if (hipFuncSetAttribute((const void*)fwd_megakernel, hipFuncAttributeMaxDynamicSharedMemorySize, LDS_BYTES) != hipSuccess) { fprintf(stderr, "kernel_launch: hipFuncSetAttribute failed\n"); grid_blocks = -1; return; }
        if (hipOccupancyMaxActiveBlocksPerMultiprocessor(&per_cu, (const void*)fwd_megakernel, NTHREADS, LDS_BYTES) != hipSuccess || per_cu < 1) { fprintf(stderr, "kernel_launch: occupancy query says %d\n", per_cu); per_cu = 1; }
        (void)hipGetLastError();
        grid_blocks = cus * 1;
    }
    if (grid_blocks < 0) return;
    Params p{};
    for (int i = 0; i < 20; ++i) p.in[i] = (const float*)d_in[i];
    p.out = (float*)d_out; p.ws = (unsigned char*)d_ws; p.ph_lo = 0; p.ph_hi = 22;
    void* args[] = {&p};
    hipError_t e = hipLaunchCooperativeKernel((const void*)fwd_megakernel, dim3(grid_blocks), dim3(NTHREADS), args, LDS_BYTES, stream);
    if (e != hipSuccess) fprintf(stderr, "cooperative launch failed: %s (grid %d)\n", hipGetErrorString(e), grid_blocks);
}
```

```cpp
#include <hip/hip_runtime.h>
#include <hip/hip_cooperative_groups.h>
#include <cstdio>
#include <cstdint>
namespace cg = cooperative_groups;

#define LAS __attribute__((address_space(3)))
typedef unsigned short bf16_t;
typedef short bf16x8 __attribute__((ext_vector_type(8)));
typedef float f32x4 __attribute__((ext_vector_type(4)));
typedef float f32x2 __attribute__((ext_vector_type(2)));
typedef unsigned u32x4 __attribute__((ext_vector_type(4)));
typedef unsigned u32x2 __attribute__((ext_vector_type(2)));

constexpr int D = 1024, NB = 32, SEQ = 2048, CTXL = 256;
constexpr int MX = NB * SEQ;
constexpr int MC = NB * CTXL;
constexpr int MT = MX + MC;
constexpr int FH = 2816, HG5 = 5 * D, CMI = 3072, NMOD = 9;
constexpr float DN_ALPHA = 1.41421356237309515f;
constexpr float LN_EPS = 1e-5f, RMS_EPS = 1e-6f;
constexpr int LDS_BYTES = 149504;
constexpr int NTHREADS = 512;

constexpr size_t WS_MOD = 0;
constexpr size_t WS_LB = WS_MOD + (size_t)2 * 33 * 9216 * 4;
constexpr size_t WS_BAR = WS_LB + 2 * 1024 * 4;
constexpr size_t WS_FIN = WS_BAR + 4096 * 4;
constexpr size_t WS_FOUT = WS_FIN + (size_t)4 * 5632 * 1024 * 2;
constexpr size_t WS_HIN = WS_FOUT + (size_t)4 * 1024 * 2816 * 2;
constexpr size_t WS_HOUT = WS_HIN + (size_t)5120 * 1024 * 2;
constexpr size_t WS_CIN = WS_HOUT + (size_t)1024 * 1024 * 2;
constexpr size_t WS_COUT = WS_CIN + (size_t)6144 * 1024 * 2;
constexpr size_t WS_WSB = WS_COUT + (size_t)1024 * 3072 * 2;
constexpr size_t WS_A0 = WS_WSB + (size_t)8 * 128 * 128 * 2;
constexpr size_t WS_BIG = WS_A0 + (size_t)MT * 1024 * 2;
constexpr size_t WS_END = WS_BIG + (size_t)MX * 6144 * 2;

struct Params {
    const float* in[20];
    float* out;
    unsigned char* ws;
    int ph_lo, ph_hi;
};

__device__ __forceinline__ unsigned cvt_pk_bf16(float lo, float hi) { unsigned r; asm volatile("v_cvt_pk_bf16_f32 %0, %1, %2" : "=v"(r) : "v"(lo), "v"(hi)); return r; }
__device__ __forceinline__ int opaque_tid() { int t = threadIdx.x; asm volatile("" : "+v"(t)); return t; }
__device__ __forceinline__ float bf_lo(unsigned u) { return __uint_as_float(u << 16); }
__device__ __forceinline__ float bf_hi(unsigned u) { return __uint_as_float(u & 0xffff0000u); }
__device__ __forceinline__ float wave_sum(float v) {
#pragma unroll
    for (int o = 1; o < 64; o <<= 1) v += __shfl_xor(v, o);
    return v;
}
__device__ __forceinline__ float sigmoid_f(float x) { return __builtin_amdgcn_rcpf(1.f + __expf(-x)); }
__device__ __forceinline__ float silu_f(float x) { return x * sigmoid_f(x); }
__device__ __forceinline__ float gelu_tanh_f(float x) { const float u = 0.7978845608028654f * (x + 0.044715f * x * x * x); return x * sigmoid_f(2.f * u); }

namespace pg8 {
constexpr int BM = 256, BK = 64, HALF = 128, HTB = HALF * BK * 2, STAGE_BYTES = 8 * HTB, NXCD = 8, WGM = 8;
__host__ __device__ __forceinline__ int lds_byte(int r, int c) { const int st = (r >> 4) * 2 + (c >> 5), rr = r & 15, cc = c & 31, ob = rr * 64 + cc * 2; return st * 1024 + (ob ^ (((ob >> 9) & 1) << 5)); }
__host__ __device__ __forceinline__ void stage_rc(int b, int& R, int& C) { const int st = b / 1024, sb = b % 1024, swz = sb ^ (((sb >> 9) & 1) << 5); R = (st >> 1) * 16 + swz / 64; C = (st & 1) * 32 + (swz % 64) / 2; }
__host__ __device__ __forceinline__ int perm32(int rho) { const int n = rho >> 4, i = rho & 15; return 8 * (i >> 2) + 4 * n + (i & 3); }

struct Unit { int pm, pn; };
struct Gemm { const bf16_t* A; int lda; const bf16_t* Bt; int M, N, K; };

struct StaticOrder {
    int nM, nN, nwg, G, c;
    __device__ void init(int M, int N, int G_, int c_) { nM = M / BM; nN = N / BM; nwg = nM * nN; G = G_; c = c_; }
    __device__ bool next(int i, Unit& u) const {
        const long L = (long)i * G + c; if (L >= nwg) return false;
        int wgid = (int)L; { const int q = nwg / NXCD, r = nwg % NXCD, xcd = wgid % NXCD, off = wgid / NXCD; wgid = (xcd < r ? xcd * (q + 1) : r * (q + 1) + (xcd - r) * q) + off; }
        const int nig = WGM * nN, gid = wgid / nig, fm = gid * WGM, gsz = (nM - fm) < WGM ? (nM - fm) : WGM;
        u.pm = fm + ((wgid % nig) % gsz); u.pn = (wgid % nig) / gsz; return true;
    }
};

template <int MODE> struct Epi {
    bf16_t* O; int ldo; const float* lb;
    __device__ __forceinline__ void operator()(const f32x4 (&acc)[2][2][4][2], const Unit& u, int wr, int wc, int fr, int fq) const {
        const int row0 = u.pm * BM + wr * 64 + fr;
        if constexpr (MODE == 1) {
            const int col0 = u.pn * 128 + wc * 32 + 8 * fq;
#pragma unroll
            for (int ai = 0; ai < 2; ++ai)
#pragma unroll
                for (int m = 0; m < 4; ++m) {
                    const f32x4 g0 = acc[ai][0][m][0], g1 = acc[ai][0][m][1], u0 = acc[ai][1][m][0], u1 = acc[ai][1][m][1];
                    u32x4 o;
                    o.x = cvt_pk_bf16(silu_f(g0[0]) * u0[0], silu_f(g0[1]) * u0[1]);
                    o.y = cvt_pk_bf16(silu_f(g0[2]) * u0[2], silu_f(g0[3]) * u0[3]);
                    o.z = cvt_pk_bf16(silu_f(g1[0]) * u1[0], silu_f(g1[1]) * u1[1]);
                    o.w = cvt_pk_bf16(silu_f(g1[2]) * u1[2], silu_f(g1[3]) * u1[3]);
                    *(u32x4*)(O + (size_t)(row0 + ai * HALF + m * 16) * ldo + col0) = o;
                    __builtin_amdgcn_sched_barrier(0);
                }
        } else {
            const int seg = u.pn >> 2;
#pragma unroll
            for (int bj = 0; bj < 2; ++bj) {
                const int col0 = u.pn * BM + bj * HALF + wc * 32 + 8 * fq;
                f32x4 l0 = {0.f, 0.f, 0.f, 0.f}, l1 = {0.f, 0.f, 0.f, 0.f};
                if (MODE == 2 && (seg == 2 || seg == 3)) { const float* lp = lb + (seg - 2) * 1024 + (col0 & 1023); l0 = *(const f32x4*)lp; l1 = *(const f32x4*)(lp + 4); }
#pragma unroll
                for (int ai = 0; ai < 2; ++ai)
#pragma unroll
                    for (int m = 0; m < 4; ++m) {
                        f32x4 v0 = acc[ai][bj][m][0], v1 = acc[ai][bj][m][1];
                        if constexpr (MODE == 3) {
#pragma unroll
                            for (int i = 0; i < 4; ++i) { v0[i] = gelu_tanh_f(v0[i]); v1[i] = gelu_tanh_f(v1[i]); }
                        }
                        if constexpr (MODE == 2) {
                            if (seg == 0 || seg == 4) {
#pragma unroll
                                for (int i = 0; i < 4; ++i) { v0[i] = silu_f(v0[i]); v1[i] = silu_f(v1[i]); }
                            } else if (seg >= 2) {
#pragma unroll
                                for (int i = 0; i < 4; ++i) {
                                    v0[i] = __logf(l0[i] + (1.f - l0[i]) * sigmoid_f(v0[i]));
                                    v1[i] = __logf(l1[i] + (1.f - l1[i]) * sigmoid_f(v1[i]));
                                }
                            }
                        }
                        u32x4 o;
                        o.x = cvt_pk_bf16(v0[0], v0[1]); o.y = cvt_pk_bf16(v0[2], v0[3]); o.z = cvt_pk_bf16(v1[0], v1[1]); o.w = cvt_pk_bf16(v1[2], v1[3]);
                        *(u32x4*)(O + (size_t)(row0 + ai * HALF + m * 16) * ldo + col0) = o;
                        __builtin_amdgcn_sched_barrier(0);
                    }
            }
        }
    }
};

template <class EpiT>
__device__ __forceinline__ void gemm_phase(LAS unsigned char* lds, const Gemm g, const StaticOrder& S, const EpiT& E) {
    const int tid = opaque_tid(), wid = __builtin_amdgcn_readfirstlane(tid >> 6), lane = tid & 63, wr = wid >> 2, wc = wid & 3, fr = lane & 15, fq = lane >> 4;
    const int K = g.K, nt = K / BK, lda = g.lda;
    unsigned voffA[2], voffB[2];
#pragma unroll
    for (int i = 0; i < 2; ++i) { int R, C; stage_rc(tid * 16 + i * 8192, R, C); const int Rb = (R & ~31) + perm32(R & 31);
        voffA[i] = (unsigned)(R * lda + C) * 2u; voffB[i] = (unsigned)(Rb * K + C) * 2u; }
    const size_t kstep = (size_t)(BK * 2);
    const size_t hstepA = (size_t)HALF * lda * 2, hstepB = (size_t)HALF * K * 2;
    const size_t tstepA = 2 * hstepA, tstepB = 2 * hstepB;
    const unsigned ldsw = (unsigned)wid * 1024u;
    const int aoff = lds_byte(wr * 64 + fr, fq * 8), boff = lds_byte(wc * 32 + fr, fq * 8);
#define PG8_SA(b, h) (((b) * 2 + (h)) * HTB)
#define PG8_SB(b, h) ((4 + (b) * 2 + (h)) * HTB)
#define PG8_STAGE(bufoff, gbase, voff) do { _Pragma("unroll") for (int _i = 0; _i < 2; ++_i) \
        __builtin_amdgcn_global_load_lds((const unsigned*)((const char*)(gbase) + (voff)[_i]), (LAS unsigned*)(lds + (bufoff) + ldsw + _i * 8192), 16, 0, 0); } while (0)
#define PG8_LDA(dst, b, h) do { _Pragma("unroll") for (int m = 0; m < 4; ++m) _Pragma("unroll") for (int k = 0; k < 2; ++k) dst[m][k] = *(const LAS bf16x8*)(lds + PG8_SA(b, h) + aoff + m * 2048 + k * 1024); } while (0)
#define PG8_LDB(dst, b, h) do { _Pragma("unroll") for (int n = 0; n < 2; ++n) _Pragma("unroll") for (int k = 0; k < 2; ++k) dst[n][k] = *(const LAS bf16x8*)(lds + PG8_SB(b, h) + boff + n * 2048 + k * 1024); } while (0)
#define PG8_MMA(ai, bj, At, Bt) do { __builtin_amdgcn_s_setprio(1); _Pragma("unroll") for (int m = 0; m < 4; ++m) _Pragma("unroll") for (int n = 0; n < 2; ++n) _Pragma("unroll") for (int k = 0; k < 2; ++k) \
        acc[ai][bj][m][n] = __builtin_amdgcn_mfma_f32_16x16x32_bf16(Bt[n][k], At[m][k], acc[ai][bj][m][n], 0, 0, 0); __builtin_amdgcn_s_setprio(0); } while (0)
#define PG8_WAIT_V(n) asm volatile("s_waitcnt vmcnt(" #n ")" ::: "memory")
#define PG8_WAIT_L(n) asm volatile("s_waitcnt lgkmcnt(" #n ")" ::: "memory")
#define PG8_BAR __builtin_amdgcn_s_barrier()
#define PG8_SCHED __builtin_amdgcn_sched_barrier(0)
    Unit cur, nxt; int ui = 0;
    if (!S.next(0, cur)) return;
    f32x4 acc[2][2][4][2];
#pragma unroll
    for (int a = 0; a < 2; ++a)
#pragma unroll
        for (int b = 0; b < 2; ++b)
#pragma unroll
            for (int m = 0; m < 4; ++m)
#pragma unroll
                for (int n = 0; n < 2; ++n) acc[a][b][m][n] = (f32x4){0.f, 0.f, 0.f, 0.f};
    bf16x8 At[4][2], B0[2][2], B1[2][2];
    const char* cA = (const char*)g.A + (size_t)cur.pm * tstepA; const char* cB = (const char*)g.Bt + (size_t)cur.pn * tstepB;
    PG8_STAGE(PG8_SB(0, 0), cB, voffB); PG8_STAGE(PG8_SA(0, 0), cA, voffA); PG8_STAGE(PG8_SB(0, 1), cB + hstepB, voffB); PG8_STAGE(PG8_SA(0, 1), cA + hstepA, voffA);
    if (wr == 1) PG8_BAR;
    PG8_WAIT_V(4); PG8_BAR;
    PG8_STAGE(PG8_SB(1, 0), cB + kstep, voffB); PG8_STAGE(PG8_SA(1, 0), cA + kstep, voffA); PG8_STAGE(PG8_SB(1, 1), cB + hstepB + kstep, voffB);
    PG8_WAIT_V(6); PG8_BAR;
    for (;;) {
        const bool has_next = S.next(ui + 1, nxt);
        const char* nA = has_next ? (const char*)g.A + (size_t)nxt.pm * tstepA : cA; const char* nB = has_next ? (const char*)g.Bt + (size_t)nxt.pn * tstepB : cB;
        for (int t = 0; t < nt; t += 2) {
            const bool last = (t == nt - 2);
            const char* a1 = cA + (size_t)(t + 1) * kstep;
            const char* a2 = last ? nA : cA + (size_t)(t + 2) * kstep; const char* b2 = last ? nB : cB + (size_t)(t + 2) * kstep;
            const char* a3 = a2 + kstep; const char* b3 = b2 + kstep;
            PG8_LDB(B0, 0, 0); PG8_SCHED; PG8_LDA(At, 0, 0); PG8_STAGE(PG8_SA(1, 1), a1 + hstepA, voffA);
            PG8_WAIT_L(8); PG8_BAR; PG8_WAIT_L(0); PG8_MMA(0, 0, At, B0); PG8_BAR; PG8_SCHED;
            PG8_LDB(B1, 0, 1); PG8_STAGE(PG8_SB(0, 0), b2, voffB);
            PG8_BAR; PG8_WAIT_L(0); PG8_MMA(0, 1, At, B1); PG8_BAR;
            PG8_LDA(At, 0, 1); PG8_STAGE(PG8_SA(0, 0), a2, voffA);
            PG8_BAR; PG8_WAIT_L(0); PG8_MMA(1, 0, At, B0); PG8_BAR; PG8_SCHED;
            PG8_STAGE(PG8_SB(0, 1), b2 + hstepB, voffB);
            PG8_WAIT_V(6); PG8_BAR; PG8_MMA(1, 1, At, B1); PG8_BAR;
            PG8_LDB(B0, 1, 0); PG8_SCHED; PG8_LDA(At, 1, 0); PG8_STAGE(PG8_SA(0, 1), a2 + hstepA, voffA);
            PG8_WAIT_L(8); PG8_BAR; PG8_WAIT_L(0); PG8_MMA(0, 0, At, B0); PG8_BAR; PG8_SCHED;
            PG8_LDB(B1, 1, 1); PG8_STAGE(PG8_SB(1, 0), b3, voffB);
            PG8_BAR; PG8_WAIT_L(0); PG8_MMA(0, 1, At, B1); PG8_BAR;
            PG8_LDA(At, 1, 1); PG8_STAGE(PG8_SA(1, 0), a3, voffA);
            PG8_BAR; PG8_WAIT_L(0); PG8_MMA(1, 0, At, B0); PG8_BAR; PG8_SCHED;
            PG8_STAGE(PG8_SB(1, 1), b3 + hstepB, voffB);
            PG8_WAIT_V(6); PG8_BAR; PG8_MMA(1, 1, At, B1); PG8_BAR;
        }
        E(acc, cur, wr, wc, fr, fq);
        if (!has_next) break;
#pragma unroll
        for (int a = 0; a < 2; ++a)
#pragma unroll
            for (int b = 0; b < 2; ++b)
#pragma unroll
                for (int m = 0; m < 4; ++m)
#pragma unroll
                    for (int n = 0; n < 2; ++n) acc[a][b][m][n] = (f32x4){0.f, 0.f, 0.f, 0.f};
        cur = nxt; cA = nA; cB = nB; ++ui;
    }
    PG8_WAIT_V(0);
    if (wr == 0) PG8_BAR;
    PG8_BAR;
#undef PG8_SA
#undef PG8_SB
#undef PG8_STAGE
#undef PG8_LDA
#undef PG8_LDB
#undef PG8_MMA
#undef PG8_WAIT_V
#undef PG8_WAIT_L
#undef PG8_BAR
#undef PG8_SCHED
}
}

template <int MODE>
__device__ __forceinline__ void run_gemm(LAS unsigned char* lds, const bf16_t* A, int lda, const bf16_t* Bt, int M, int N, int K, bf16_t* O, int ldo, const float* lb) {
    pg8::Gemm g{A, lda, Bt, M, N, K};
    pg8::StaticOrder S; S.init(M, N, gridDim.x, blockIdx.x);
    pg8::Epi<MODE> E{O, ldo, lb};
    pg8::gemm_phase(lds, g, S, E);
}

#define XB_TMO      128
#define XB_XCNT(j)  (256  + 64 * (j))
#define XB_XSUB(j)  (1280 + 64 * (j))
#define XB_XGEN(j)  (2304 + 64 * (j))
#define XB_TOP      3328
#define XB_TOPGEN   3392
#define XCD_BAR_WORDS 3456
#define XB_SPIN_CAP (1u << 22)
__device__ __forceinline__ unsigned xb_ld(unsigned* p)              { return __hip_atomic_load(p, __ATOMIC_RELAXED, __HIP_MEMORY_SCOPE_AGENT); }
__device__ __forceinline__ unsigned xb_add(unsigned* p, unsigned v) { return __hip_atomic_fetch_add(p, v, __ATOMIC_RELAXED, __HIP_MEMORY_SCOPE_AGENT); }
__device__ __forceinline__ unsigned xb_xcc_id() { return (unsigned)__builtin_amdgcn_s_getreg((3 << 11) | 20) & 0xFu; }
#define XB_SPIN(cond, bar) do { unsigned _sp = 0; while (cond) { __builtin_amdgcn_s_sleep(1); \
    if ((++_sp & 255u) == 0u) { if (xb_ld(&(bar)[XB_TMO])) break; if (_sp > XB_SPIN_CAP) { atomicAdd(&(bar)[XB_TMO], 1u); break; } } } } while (0)
struct XcdBarrier { unsigned* bar; unsigned x; volatile LAS unsigned* st; };
__device__ __forceinline__ XcdBarrier xcd_barrier_post(unsigned* bar, volatile LAS unsigned* st) {
    XcdBarrier b; b.bar = bar; b.x = xb_xcc_id(); b.st = st;
    if (threadIdx.x == 0) (void)xb_add(&bar[XB_XCNT(b.x)], 1u);
    return b;
}
__device__ __forceinline__ void xcd_barrier_complete(unsigned* bar, unsigned x, unsigned& nloc, unsigned& nx) {
    const unsigned G = gridDim.x * gridDim.y * gridDim.z;
    unsigned sum, cnt, mine, sp = 0u;
    for (;;) {
        sum = 0u; cnt = 0u; mine = 0u;
#pragma unroll
        for (unsigned j = 0; j < 16; ++j) { const unsigned c = xb_ld(&bar[XB_XCNT(j)]); sum += c; cnt += (c > 0u) ? 1u : 0u; mine = (j == x) ? c : mine; }
        if (sum == G) break;
        __builtin_amdgcn_s_sleep(1);
        if ((++sp & 255u) == 0u) { if (xb_ld(&bar[XB_TMO])) break; if (sp > XB_SPIN_CAP) { atomicAdd(&bar[XB_TMO], 1u); break; } }
    }
    nloc = mine > 0u ? mine : 1u; nx = cnt > 0u ? cnt : 1u;
}
__device__ __forceinline__ void xcd_barrier(const XcdBarrier& b) {
    asm volatile("s_waitcnt vmcnt(0)" ::: "memory");
    __syncthreads();
    if (threadIdx.x == 0) {
        unsigned* bar = b.bar;
        __builtin_amdgcn_s_waitcnt(0);
        unsigned nloc = b.st[0], nx = b.st[1];
        if (nloc == 0u) { xcd_barrier_complete(bar, b.x, nloc, nx); b.st[0] = nloc; b.st[1] = nx; }
        const unsigned old = xb_add(&bar[XB_XSUB(b.x)], 1u);
        const unsigned gen = old / nloc;
        if (old + 1u == (gen + 1u) * nloc) {
            __builtin_amdgcn_fence(__ATOMIC_RELEASE, "agent");
            asm volatile("s_waitcnt vmcnt(0)" ::: "memory");
            const unsigned og = xb_add(&bar[XB_TOP], 1u);
            const unsigned tg = og / nx;
            if (og + 1u == (tg + 1u) * nx) xb_add(&bar[XB_TOPGEN], 1u);
            else XB_SPIN(xb_ld(&bar[XB_TOPGEN]) == tg, bar);
            __builtin_amdgcn_fence(__ATOMIC_ACQUIRE, "agent");
            xb_add(&bar[XB_XGEN(b.x)], 1u);
            asm volatile("s_waitcnt vmcnt(0)" ::: "memory");
        } else {
            XB_SPIN(xb_ld(&bar[XB_XGEN(b.x)]) == gen, bar);
            __builtin_amdgcn_fence(__ATOMIC_ACQUIRE, "agent");
            asm volatile("s_waitcnt vmcnt(0)" ::: "memory");
        }
    }
    __syncthreads();
}


__device__ __forceinline__ void p0_mod_item(const Params& p, LAS unsigned char* lds, int item) {
    const int tid = opaque_tid();
    const int layer = item / 144, cgp = item % 144, col0 = cgp * 64;
    const float* c = p.in[1]; const float* cctx = p.in[3];
    const float* W = p.in[4] + (size_t)layer * 1024 * 9216; const float* bias = p.in[5] + (size_t)layer * 9216;
    float* mout = (float*)(p.ws + WS_MOD) + (size_t)layer * 33 * 9216;
    LAS float* S = (LAS float*)lds;
    __syncthreads();
    for (int i = tid; i < 33 * 1024; i += NTHREADS) { const int r = i >> 10, k = i & 1023; const float v = r < 32 ? c[r * 1024 + k] : cctx[k]; S[i] = silu_f(v); }
    __syncthreads();
    const int col = tid & 63, ks = tid >> 6;
    float acc[33];
#pragma unroll
    for (int r = 0; r < 33; ++r) acc[r] = 0.f;
    for (int k4 = 0; k4 < 32; ++k4) {
        const int k = ks * 128 + k4 * 4;
        const float w0 = W[(size_t)(k + 0) * 9216 + col0 + col], w1 = W[(size_t)(k + 1) * 9216 + col0 + col], w2 = W[(size_t)(k + 2) * 9216 + col0 + col], w3 = W[(size_t)(k + 3) * 9216 + col0 + col];
#pragma unroll
        for (int r = 0; r < 33; ++r) { const f32x4 s4 = *(const LAS f32x4*)(S + r * 1024 + k); acc[r] += w0 * s4[0] + w1 * s4[1] + w2 * s4[2] + w3 * s4[3]; }
    }
    __syncthreads();
    LAS float* red = (LAS float*)lds;
#pragma unroll
    for (int r = 0; r < 33; ++r) red[(ks * 33 + r) * 64 + col] = acc[r];
    __syncthreads();
    for (int i = tid; i < 33 * 64; i += NTHREADS) {
        const int r = i >> 6, cc = i & 63; float s = 0.f;
#pragma unroll
        for (int q = 0; q < 8; ++q) s += red[(q * 33 + r) * 64 + cc];
        mout[(size_t)r * 9216 + col0 + cc] = s + bias[col0 + cc];
    }
    __syncthreads();
}

__device__ __forceinline__ void p0_transpose_item(const float* W, int K, int N, bf16_t* WT, int k0, int n0, int drow0, LAS float* scr, int lane) {
#pragma unroll 8
    for (int i = 0; i < 32; ++i) { const int kk = 2 * i + (lane >> 5); scr[kk * 33 + (lane & 31)] = W[(size_t)(k0 + kk) * N + n0 + (lane & 31)]; }
    asm volatile("s_waitcnt lgkmcnt(0)" ::: "memory");
    const int c = lane & 7;
#pragma unroll
    for (int j = 0; j < 4; ++j) { const int n = (lane >> 3) + 8 * j; const LAS float* s = scr + (8 * c) * 33 + n;
        u32x4 o; o.x = cvt_pk_bf16(s[0 * 33], s[1 * 33]); o.y = cvt_pk_bf16(s[2 * 33], s[3 * 33]); o.z = cvt_pk_bf16(s[4 * 33], s[5 * 33]); o.w = cvt_pk_bf16(s[6 * 33], s[7 * 33]);
        *(u32x4*)(WT + (size_t)(drow0 + n) * K + k0 + 8 * c) = o; }
    asm volatile("s_waitcnt lgkmcnt(0)" ::: "memory");
}

__device__ __forceinline__ void phase0(const Params& p, LAS unsigned char* lds) {
    const int tid = opaque_tid(), wid = tid >> 6, lane = tid & 63;
    if (blockIdx.x == 0) { unsigned* bar = (unsigned*)(p.ws + WS_BAR); for (int i = tid; i < 4096; i += NTHREADS) bar[i] = 0u; }
    if (blockIdx.x == gridDim.x - 1) {
        const float* lbp = p.in[11]; float* lbo = (float*)(p.ws + WS_LB);
        for (int i = tid; i < 2048; i += NTHREADS) { const int dir = i >> 10, col = i & 1023;
            const float l0 = lbp[(dir * 3 + 0) * 1024 + col], l1 = lbp[(dir * 3 + 1) * 1024 + col], l2 = lbp[(dir * 3 + 2) * 1024 + col];
            const float mx = fmaxf(l0, fmaxf(l1, l2)); const float e0 = __expf(l0 - mx), e1 = __expf(l1 - mx), e2 = __expf(l2 - mx);
            lbo[i] = e0 / (e0 + e1 + e2); }
    }
    if (blockIdx.x == gridDim.x - 2) {
        const float* wsp = p.in[17]; bf16_t* wsb = (bf16_t*)(p.ws + WS_WSB);
        for (int i = tid; i < 8 * 128 * 128 / 4; i += NTHREADS) { const f32x4 w = *(const f32x4*)(wsp + 4 * i); u32x2 o; o.x = cvt_pk_bf16(w[0], w[1]); o.y = cvt_pk_bf16(w[2], w[3]); *(u32x2*)(wsb + 4 * i) = o; }
    }
    for (int it = blockIdx.x; it < 288; it += gridDim.x) p0_mod_item(p, lds, it);
    __syncthreads();
    LAS float* scr = (LAS float*)lds + wid * (64 * 33);
    const int gw = blockIdx.x * 8 + wid, nw = gridDim.x * 8;
    for (int mi = 0; mi < 12; ++mi) {
        const float* W; bf16_t* WT; int K, N, mode = 0;
        if (mi < 4) { W = p.in[8] + (size_t)mi * 1024 * 5632; WT = (bf16_t*)(p.ws + WS_FIN) + (size_t)mi * 5632 * 1024; K = 1024; N = 5632; mode = 1; }
        else if (mi < 8) { W = p.in[9] + (size_t)(mi - 4) * 2816 * 1024; WT = (bf16_t*)(p.ws + WS_FOUT) + (size_t)(mi - 4) * 1024 * 2816; K = 2816; N = 1024; }
        else if (mi == 8) { W = p.in[10]; WT = (bf16_t*)(p.ws + WS_HIN); K = 1024; N = 5120; }
        else if (mi == 9) { W = p.in[13]; WT = (bf16_t*)(p.ws + WS_HOUT); K = 1024; N = 1024; }
        else if (mi == 10) { W = p.in[14]; WT = (bf16_t*)(p.ws + WS_CIN); K = 1024; N = 6144; }
        else { W = p.in[19]; WT = (bf16_t*)(p.ws + WS_COUT); K = 3072; N = 1024; }
        const int nblk = N / 32, nitems = (K / 64) * nblk;
        for (int it = gw; it < nitems; it += nw) {
            const int kb = it / nblk, nb = it % nblk, n0 = nb * 32;
            int drow0 = n0;
            if (mode == 1) { const int j = n0 < FH ? n0 : n0 - FH; drow0 = 256 * (j >> 7) + (n0 < FH ? 0 : 128) + (j & 127); }
            p0_transpose_item(W, K, N, WT, kb * 64, n0, drow0, scr, lane);
        }
    }
}

struct RowArgs {
    const float* xs_x; const float* xs_c; int nrows;
    const bf16_t* y; float ysc; const float* m; int k; const float* g; const float* b;
    float* xd; bf16_t* hd; const float* m2; int k2;
};
__device__ __forceinline__ void row_phase(const RowArgs& a) {
    const int tid0 = opaque_tid(); const int wid = tid0 >> 6, lane = tid0 & 63;
    for (int row = blockIdx.x * 8 + wid; row < a.nrows; row += gridDim.x * 8) {
        const int mrow = row < MX ? (row >> 11) : 32;
        const float* xr = row < MX ? a.xs_x + (size_t)row * D : a.xs_c + (size_t)(row - MX) * D;
        f32x4 v[4];
#pragma unroll
        for (int j = 0; j < 4; ++j) v[j] = *(const f32x4*)(xr + j * 256 + lane * 4);
        if (a.y) {
            const float* gp = a.m + (size_t)mrow * 9216 + (3 * a.k + 2) * 1024;
            float s = 0.f;
#pragma unroll
            for (int j = 0; j < 4; ++j) {
                const u32x2 yy = *(const u32x2*)(a.y + (size_t)row * D + j * 256 + lane * 4);
                const f32x4 gt = *(const f32x4*)(gp + j * 256 + lane * 4);
                v[j][0] = DN_ALPHA * v[j][0] + gt[0] * a.ysc * bf_lo(yy.x); v[j][1] = DN_ALPHA * v[j][1] + gt[1] * a.ysc * bf_hi(yy.x);
                v[j][2] = DN_ALPHA * v[j][2] + gt[2] * a.ysc * bf_lo(yy.y); v[j][3] = DN_ALPHA * v[j][3] + gt[3] * a.ysc * bf_hi(yy.y);
                s += (v[j][0] + v[j][1]) + (v[j][2] + v[j][3]);
            }
            const float mean = wave_sum(s) * (1.f / D); float s2 = 0.f;
#pragma unroll
            for (int j = 0; j < 4; ++j) { v[j] = v[j] - mean; s2 += (v[j][0] * v[j][0] + v[j][1] * v[j][1]) + (v[j][2] * v[j][2] + v[j][3] * v[j][3]); }
            const float rstd = __builtin_amdgcn_rsqf(wave_sum(s2) * (1.f / D) + LN_EPS);
#pragma unroll
            for (int j = 0; j < 4; ++j) { const f32x4 gg = *(const f32x4*)(a.g + j * 256 + lane * 4), bb = *(const f32x4*)(a.b + j * 256 + lane * 4); v[j] = v[j] * rstd * gg + bb; }
            if (a.xd && row < MX) {
#pragma unroll
                for (int j = 0; j < 4; ++j) *(f32x4*)(a.xd + (size_t)row * D + j * 256 + lane * 4) = v[j];
            }
        }
        if (a.hd) {
            const float* shp = a.m2 + (size_t)mrow * 9216 + (3 * a.k2) * 1024; const float* scp = shp + 1024;
#pragma unroll
            for (int j = 0; j < 4; ++j) {
                const f32x4 sh = *(const f32x4*)(shp + j * 256 + lane * 4), sc = *(const f32x4*)(scp + j * 256 + lane * 4);
                const f32x4 h = v[j] * (sc + 1.f) + sh;
                u32x2 o; o.x = cvt_pk_bf16(h[0], h[1]); o.y = cvt_pk_bf16(h[2], h[3]);
                *(u32x2*)(a.hd + (size_t)row * D + j * 256 + lane * 4) = o;
            }
        }
    }
}

constexpr int GLA_DIRB = 74240;
__device__ __forceinline__ void gla_phase(const Params& p, LAS unsigned char* lds) {
    const int tid = opaque_tid(), dir = tid >> 8, tl = tid & 255, w = tl >> 6, lane = tl & 63, fr = lane & 15, fq = lane >> 4;
    const int cp = lane, qt = w;
    bf16_t* P = (bf16_t*)(p.ws + WS_BIG); bf16_t* R = (bf16_t*)(p.ws + WS_A0);
    const float* normw = p.in[12];
    LAS unsigned char* base = lds + dir * GLA_DIRB;
    LAS bf16_t* Qin = (LAS bf16_t*)base;
    LAS bf16_t* Kin = (LAS bf16_t*)(base + 17408);
    LAS bf16_t* Sc = Kin;
    LAS bf16_t* KinT = (LAS bf16_t*)(base + 34816);
    LAS bf16_t* VT = (LAS bf16_t*)(base + 53248);
    LAS float* tot = (LAS float*)(base + 71680);
    LAS float* dec = (LAS float*)(base + 73728);
    for (int item = blockIdx.x; item < NB * 8; item += gridDim.x) {
        const int b = item >> 3, h = item & 7;
        f32x4 Sacc[8][2];
#pragma unroll
        for (int m = 0; m < 8; ++m) { Sacc[m][0] = (f32x4){0.f, 0.f, 0.f, 0.f}; Sacc[m][1] = (f32x4){0.f, 0.f, 0.f, 0.f}; }
        unsigned rq[16], rv[16], rl[16];
        auto chunk_row = [&](int ci, int t) -> size_t {
            const bool isc = ci < 4; const int lc = isc ? ci : ci - 4, L = isc ? CTXL : SEQ; const int rbase = isc ? MX + b * CTXL : b * SEQ;
            const int tok = dir == 0 ? 64 * lc + t : L - 1 - (64 * lc + t);
            return (size_t)(rbase + tok);
        };
        auto load_chunk = [&](int ci) {
            const bf16_t* rp = P + chunk_row(ci, 16 * qt) * HG5 + h * 128 + 2 * cp;
            const long step = dir == 0 ? (long)HG5 : -(long)HG5;
#pragma unroll
            for (int i = 0; i < 16; ++i) {
                rq[i] = *(const unsigned*)rp; rv[i] = *(const unsigned*)(rp + 1024); rl[i] = *(const unsigned*)(rp + (2 + dir) * 1024);
                rp += step; asm volatile("" : "+v"(rp));
            }
        };
        __syncthreads();
        load_chunk(0);
        for (int ci = 0; ci < 36; ++ci) {
            const bool isc = ci < 4;
            {
                float run0 = 0.f, run1 = 0.f;
#pragma unroll
                for (int i = 0; i < 16; ++i) { run0 += bf_lo(rl[i]); run1 += bf_hi(rl[i]); }
                *(LAS f32x2*)(tot + qt * 128 + 2 * cp) = (f32x2){run0, run1};
#pragma unroll
                for (int hh = 0; hh < 2; ++hh) {
                    u32x4 a, c;
#pragma unroll
                    for (int u = 0; u < 4; ++u) { const int ip = 4 * hh + u;
                        a[u] = (rv[2 * ip] & 0xffffu) | (rv[2 * ip + 1] << 16); c[u] = (rv[2 * ip] >> 16) | (rv[2 * ip + 1] & 0xffff0000u); }
                    *(LAS u32x4*)(VT + (2 * cp) * 72 + 16 * qt + 8 * hh) = a;
                    *(LAS u32x4*)(VT + (2 * cp + 1) * 72 + 16 * qt + 8 * hh) = c;
                }
                __syncthreads();
                float pre0 = 0.f, pre1 = 0.f, all0 = 0.f, all1 = 0.f;
#pragma unroll
                for (int q = 0; q < 4; ++q) { const f32x2 tq = *(const LAS f32x2*)(tot + q * 128 + 2 * cp); if (q < qt) { pre0 += tq[0]; pre1 += tq[1]; } all0 += tq[0]; all1 += tq[1]; }
                if (qt == 0) *(LAS f32x2*)(dec + 2 * cp) = (f32x2){__expf(all0), __expf(all1)};
                float iebp0 = __expf(-pre0), iebp1 = __expf(-pre1);
                float bb0 = pre0, bb1 = pre1;
#pragma unroll
                for (int hh = 0; hh < 2; ++hh) {
                    u32x4 a, c;
#pragma unroll
                    for (int u4 = 0; u4 < 4; ++u4) {
                        float kin0[2], kin1[2];
#pragma unroll
                        for (int u = 0; u < 2; ++u) {
                            const int i = 8 * hh + 2 * u4 + u, t = 16 * qt + i;
                            bb0 += bf_lo(rl[i]); bb1 += bf_hi(rl[i]);
                            const float eb0 = __expf(bb0), eb1 = __expf(bb1), ieb0 = __expf(-bb0), ieb1 = __expf(-bb1);
                            const float k0 = 1.f - eb0 * iebp0, k1 = 1.f - eb1 * iebp1;
                            iebp0 = ieb0; iebp1 = ieb1;
                            kin0[u] = k0 * ieb0; kin1[u] = k1 * ieb1;
                            *(LAS unsigned*)(Qin + t * 136 + 2 * cp) = cvt_pk_bf16(bf_lo(rq[i]) * eb0, bf_hi(rq[i]) * eb1);
                            *(LAS unsigned*)(Kin + t * 136 + 2 * cp) = cvt_pk_bf16(kin0[u], kin1[u]);
                        }
                        a[u4] = cvt_pk_bf16(kin0[0], kin0[1]); c[u4] = cvt_pk_bf16(kin1[0], kin1[1]);
                    }
                    *(LAS u32x4*)(KinT + (2 * cp) * 72 + 16 * qt + 8 * hh) = a;
                    *(LAS u32x4*)(KinT + (2 * cp + 1) * 72 + 16 * qt + 8 * hh) = c;
                    __builtin_amdgcn_sched_barrier(0);
                }
            }
            __syncthreads();
            if (ci + 1 < 36) load_chunk(ci + 1);
            f32x4 sacc[4];
            if (!isc) {
                bf16x8 qf[4];
#pragma unroll
                for (int ks = 0; ks < 4; ++ks) qf[ks] = *(const LAS bf16x8*)(Qin + (16 * w + fr) * 136 + 32 * ks + 8 * fq);
#pragma unroll
                for (int ms = 0; ms < 4; ++ms) {
                    sacc[ms] = (f32x4){0.f, 0.f, 0.f, 0.f};
                    if (ms <= w) {
#pragma unroll
                        for (int ks = 0; ks < 4; ++ks) { const bf16x8 kf = *(const LAS bf16x8*)(Kin + (16 * ms + fr) * 136 + 32 * ks + 8 * fq);
                            sacc[ms] = __builtin_amdgcn_mfma_f32_16x16x32_bf16(kf, qf[ks], sacc[ms], 0, 0, 0); }
                    }
                }
            }
            __syncthreads();
            if (!isc) {
#pragma unroll
                for (int ms = 0; ms < 4; ++ms) {
                    f32x4 v = sacc[ms];
                    if (ms == w) {
#pragma unroll
                        for (int j = 0; j < 4; ++j) v[j] = (4 * fq + j <= fr) ? v[j] : 0.f;
                    }
                    u32x2 o; o.x = cvt_pk_bf16(v[0], v[1]); o.y = cvt_pk_bf16(v[2], v[3]);
                    *(LAS u32x2*)(Sc + (16 * w + fr) * 72 + 16 * ms + 4 * fq) = o;
                }
            }
            __syncthreads();
            __builtin_amdgcn_sched_barrier(0);
            bf16x8 vfrag[2][2];
#pragma unroll
            for (int n = 0; n < 2; ++n)
#pragma unroll
                for (int ks = 0; ks < 2; ++ks) vfrag[n][ks] = *(const LAS bf16x8*)(VT + (32 * w + 16 * n + fr) * 72 + 32 * ks + 8 * fq);
            if (!isc) {
                f32x4 oacc[2][4];
#pragma unroll
                for (int n = 0; n < 2; ++n)
#pragma unroll
                    for (int tt = 0; tt < 4; ++tt) oacc[n][tt] = (f32x4){0.f, 0.f, 0.f, 0.f};
#pragma unroll
                for (int kk = 0; kk < 4; ++kk) {
                    bf16x8 sf[2];
#pragma unroll
                    for (int n = 0; n < 2; ++n) {
                        u32x4 pk; pk.x = cvt_pk_bf16(Sacc[2 * kk][n][0], Sacc[2 * kk][n][1]); pk.y = cvt_pk_bf16(Sacc[2 * kk][n][2], Sacc[2 * kk][n][3]);
                        pk.z = cvt_pk_bf16(Sacc[2 * kk + 1][n][0], Sacc[2 * kk + 1][n][1]); pk.w = cvt_pk_bf16(Sacc[2 * kk + 1][n][2], Sacc[2 * kk + 1][n][3]);
                        sf[n] = __builtin_bit_cast(bf16x8, pk);
                    }
#pragma unroll
                    for (int tt = 0; tt < 4; ++tt) {
                        const LAS bf16_t* qp = Qin + (16 * tt + fr) * 136 + 32 * kk + 4 * fq;
                        const u32x2 lo = *(const LAS u32x2*)qp, hi = *(const LAS u32x2*)(qp + 16);
                        const bf16x8 qfr = __builtin_bit_cast(bf16x8, ((u32x4){lo.x, lo.y, hi.x, hi.y}));
#pragma unroll
                        for (int n = 0; n < 2; ++n) oacc[n][tt] = __builtin_amdgcn_mfma_f32_16x16x32_bf16(sf[n], qfr, oacc[n][tt], 0, 0, 0);
                    }
                }
                __builtin_amdgcn_sched_barrier(0);
#pragma unroll
                for (int tt = 0; tt < 4; ++tt)
#pragma unroll
                    for (int ks = 0; ks < 2; ++ks) {
                        if (ks == 1 && tt < 2) continue;
                        const bf16x8 scf = *(const LAS bf16x8*)(Sc + (16 * tt + fr) * 72 + 32 * ks + 8 * fq);
#pragma unroll
                        for (int n = 0; n < 2; ++n) oacc[n][tt] = __builtin_amdgcn_mfma_f32_16x16x32_bf16(vfrag[n][ks], scf, oacc[n][tt], 0, 0, 0);
                    }
                __builtin_amdgcn_sched_barrier(0);
#pragma unroll
                for (int tt = 0; tt < 4; ++tt) {
                    bf16_t* op = P + chunk_row(ci, 16 * tt + fr) * HG5 + (2 + dir) * 1024 + h * 128 + 32 * w + 4 * fq;
#pragma unroll
                    for (int n = 0; n < 2; ++n) { u32x2 o; o.x = cvt_pk_bf16(oacc[n][tt][0], oacc[n][tt][1]); o.y = cvt_pk_bf16(oacc[n][tt][2], oacc[n][tt][3]); *(u32x2*)(op + 16 * n) = o; }
                }
            }
            __builtin_amdgcn_sched_barrier(0);
#pragma unroll
            for (int m = 0; m < 8; ++m) {
#pragma unroll
                for (int ks = 0; ks < 2; ++ks) { const bf16x8 kf = *(const LAS bf16x8*)(KinT + (16 * m + fr) * 72 + 32 * ks + 8 * fq);
#pragma unroll
                    for (int n = 0; n < 2; ++n) Sacc[m][n] = __builtin_amdgcn_mfma_f32_16x16x32_bf16(kf, vfrag[n][ks], Sacc[m][n], 0, 0, 0); }
                const f32x4 dv = *(const LAS f32x4*)(dec + 16 * m + 4 * fq);
                Sacc[m][0] *= dv; Sacc[m][1] *= dv;
            }
            __syncthreads();
        }
        __threadfence(); __syncthreads(); __threadfence();
        {
            const int wid = tid >> 6, lane = tid & 63, sub = lane >> 4, l16 = lane & 15;
            const f32x4 w0 = *(const f32x4*)(normw + 8 * l16), w1 = *(const f32x4*)(normw + 8 * l16 + 4);
#pragma unroll 4
            for (int it = 0; it < 64; ++it) {
                const int t = it * 32 + wid * 4 + sub; const size_t row = (size_t)b * SEQ + t;
                const bf16_t* rp = P + row * HG5 + h * 128 + 8 * l16;
                const u32x4 of = *(const u32x4*)(rp + 2048), ob = *(const u32x4*)(rp + 3072), gg = *(const u32x4*)(rp + 4096);
                float o[8];
                o[0] = bf_lo(of.x) + bf_lo(ob.x); o[1] = bf_hi(of.x) + bf_hi(ob.x); o[2] = bf_lo(of.y) + bf_lo(ob.y); o[3] = bf_hi(of.y) + bf_hi(ob.y);
                o[4] = bf_lo(of.z) + bf_lo(ob.z); o[5] = bf_hi(of.z) + bf_hi(ob.z); o[6] = bf_lo(of.w) + bf_lo(ob.w); o[7] = bf_hi(of.w) + bf_hi(ob.w);
                float ss = 0.f;
#pragma unroll
                for (int i = 0; i < 8; ++i) ss += o[i] * o[i];
                ss += __shfl_xor(ss, 1); ss += __shfl_xor(ss, 2); ss += __shfl_xor(ss, 4); ss += __shfl_xor(ss, 8);
                const float rs = __builtin_amdgcn_rsqf(ss * (1.f / 128.f) + RMS_EPS);
                u32x4 r;
                r.x = cvt_pk_bf16(o[0] * rs * w0[0] * bf_lo(gg.x), o[1] * rs * w0[1] * bf_hi(gg.x));
                r.y = cvt_pk_bf16(o[2] * rs * w0[2] * bf_lo(gg.y), o[3] * rs * w0[3] * bf_hi(gg.y));
                r.z = cvt_pk_bf16(o[4] * rs * w1[0] * bf_lo(gg.z), o[5] * rs * w1[1] * bf_hi(gg.z));
                r.w = cvt_pk_bf16(o[6] * rs * w1[2] * bf_lo(gg.w), o[7] * rs * w1[3] * bf_hi(gg.w));
                *(u32x4*)(R + row * D + h * 128 + 8 * l16) = r;
            }
        }
        __syncthreads();
    }
}

__device__ __forceinline__ void cm_gate_phase(const Params& p, LAS unsigned char* lds) {
    const int tid = opaque_tid(), wid = tid >> 6, lane = tid & 63, fr = lane & 15, fq = lane >> 4;
    bf16_t* UV = (bf16_t*)(p.ws + WS_BIG);
    const float* vg = p.in[15]; const float* vb = p.in[16]; const float* bs = p.in[18];
    const bf16_t* WSB = (const bf16_t*)(p.ws + WS_WSB);
    LAS bf16_t* Wl = (LAS bf16_t*)lds; LAS bf16_t* Vl = (LAS bf16_t*)(lds + 34816); LAS float* st = (LAS float*)(lds + 34816 + 100352); LAS float* bl = st + 256;
    const int c8 = lane < 48 ? lane : 47;
    for (int ch = blockIdx.x; ch < MX / 128; ch += gridDim.x) {
        const size_t row0 = (size_t)ch * 128;
        __syncthreads();
        for (int rr = 0; rr < 8; ++rr) {
            const int r = wid * 16 + 2 * rr; const bf16_t* vp = UV + (row0 + r) * 6144 + 3072;
            u32x4 x[2][6]; float s[2] = {0.f, 0.f};
#pragma unroll
            for (int q = 0; q < 2; ++q)
#pragma unroll
                for (int i = 0; i < 6; ++i) x[q][i] = *(const u32x4*)(vp + (size_t)q * 6144 + (i * 64 + lane) * 8);
#pragma unroll
            for (int q = 0; q < 2; ++q)
#pragma unroll
                for (int i = 0; i < 6; ++i) s[q] += (bf_lo(x[q][i].x) + bf_hi(x[q][i].x)) + (bf_lo(x[q][i].y) + bf_hi(x[q][i].y)) + (bf_lo(x[q][i].z) + bf_hi(x[q][i].z)) + (bf_lo(x[q][i].w) + bf_hi(x[q][i].w));
            float mean[2], s2[2] = {0.f, 0.f};
#pragma unroll
            for (int q = 0; q < 2; ++q) mean[q] = wave_sum(s[q]) * (1.f / 3072.f);
#pragma unroll
            for (int q = 0; q < 2; ++q)
#pragma unroll
                for (int i = 0; i < 6; ++i) { float d;
                    d = bf_lo(x[q][i].x) - mean[q]; s2[q] += d * d; d = bf_hi(x[q][i].x) - mean[q]; s2[q] += d * d; d = bf_lo(x[q][i].y) - mean[q]; s2[q] += d * d; d = bf_hi(x[q][i].y) - mean[q]; s2[q] += d * d;
                    d = bf_lo(x[q][i].z) - mean[q]; s2[q] += d * d; d = bf_hi(x[q][i].z) - mean[q]; s2[q] += d * d; d = bf_lo(x[q][i].w) - mean[q]; s2[q] += d * d; d = bf_hi(x[q][i].w) - mean[q]; s2[q] += d * d; }
#pragma unroll
            for (int q = 0; q < 2; ++q) { const float rstd = __builtin_amdgcn_rsqf(wave_sum(s2[q]) * (1.f / 3072.f) + LN_EPS); if (lane == 0) { st[2 * (r + q)] = mean[q]; st[2 * (r + q) + 1] = rstd; } }
        }
        for (int g = 0; g < 8; ++g) {
            __syncthreads();
#pragma unroll
            for (int i = 0; i < 4; ++i) { const int idx = tid + NTHREADS * i, r = idx >> 4, cc = idx & 15;
                *(LAS u32x4*)(Wl + r * 136 + cc * 8) = *(const u32x4*)(WSB + (size_t)g * 16384 + r * 128 + cc * 8); }
            if (tid < 128) bl[tid] = bs[g * 128 + tid];
            {
                const float* gp = vg + g * 384 + c8 * 8; const float* bp = vb + g * 384 + c8 * 8;
                const f32x4 g0 = *(const f32x4*)gp, g1 = *(const f32x4*)(gp + 4), b0 = *(const f32x4*)bp, b1 = *(const f32x4*)(bp + 4);
                const bf16_t* xp = UV + (row0 + wid) * 6144 + 3072 + g * 384 + c8 * 8;
#pragma unroll
                for (int hb = 0; hb < 2; ++hb) {
                    u32x4 xv[8];
#pragma unroll
                    for (int i = 0; i < 8; ++i) { xv[i] = *(const u32x4*)xp; xp += 8 * 6144; asm volatile("" : "+v"(xp)); }
#pragma unroll
                    for (int i = 0; i < 8; ++i) { const int sr = wid + 8 * (8 * hb + i);
                        const f32x2 ms = *(const LAS f32x2*)(st + 2 * sr); const float mean = ms[0], rstd = ms[1]; const u32x4 x = xv[i];
                        u32x4 o;
                        o.x = cvt_pk_bf16((bf_lo(x.x) - mean) * rstd * g0[0] + b0[0], (bf_hi(x.x) - mean) * rstd * g0[1] + b0[1]);
                        o.y = cvt_pk_bf16((bf_lo(x.y) - mean) * rstd * g0[2] + b0[2], (bf_hi(x.y) - mean) * rstd * g0[3] + b0[3]);
                        o.z = cvt_pk_bf16((bf_lo(x.z) - mean) * rstd * g1[0] + b1[0], (bf_hi(x.z) - mean) * rstd * g1[1] + b1[1]);
                        o.w = cvt_pk_bf16((bf_lo(x.w) - mean) * rstd * g1[2] + b1[2], (bf_hi(x.w) - mean) * rstd * g1[3] + b1[3]);
                        if (lane < 48) *(LAS u32x4*)(Vl + sr * 392 + c8 * 8) = o; }
                }
            }
            __syncthreads();
            u32x2 uu[8][3];
            { const bf16_t* up = UV + (row0 + fr) * 6144 + g * 384 + wid * 48 + 4 * fq;
#pragma unroll
            for (int m = 0; m < 8; ++m) {
#pragma unroll
                for (int n = 0; n < 3; ++n) uu[m][n] = *(const u32x2*)(up + n * 16);
                up += 16 * 6144; asm volatile("" : "+v"(up)); } }
            f32x4 acc[3][8];
#pragma unroll
            for (int n = 0; n < 3; ++n)
#pragma unroll
                for (int m = 0; m < 8; ++m) acc[n][m] = (f32x4){0.f, 0.f, 0.f, 0.f};
#pragma unroll 1
            for (int ks = 0; ks < 4; ++ks) {
                bf16x8 af[3];
#pragma unroll
                for (int n = 0; n < 3; ++n) {
                    const LAS bf16_t* vp = Vl + (32 * ks + 8 * fq) * 392 + wid * 48 + n * 16 + fr;
#pragma unroll
                    for (int i = 0; i < 8; ++i) af[n][i] = (short)vp[i * 392];
                }
#pragma unroll
                for (int m = 0; m < 8; ++m) {
                    const bf16x8 bfrag = *(const LAS bf16x8*)(Wl + (16 * m + fr) * 136 + 32 * ks + 8 * fq);
#pragma unroll
                    for (int n = 0; n < 3; ++n) acc[n][m] = __builtin_amdgcn_mfma_f32_16x16x32_bf16(af[n], bfrag, acc[n][m], 0, 0, 0);
                    if (m & 1) __builtin_amdgcn_sched_barrier(0);
                }
            }
            bf16_t* zp = UV + (row0 + fr) * 6144 + g * 384 + wid * 48 + 4 * fq;
#pragma unroll
            for (int m = 0; m < 8; ++m) {
                const float bias = bl[16 * m + fr];
#pragma unroll
                for (int n = 0; n < 3; ++n) {
                    const u32x2 u2 = uu[m][n];
                    u32x2 o; o.x = cvt_pk_bf16(bf_lo(u2.x) * (acc[n][m][0] + bias), bf_hi(u2.x) * (acc[n][m][1] + bias));
                    o.y = cvt_pk_bf16(bf_lo(u2.y) * (acc[n][m][2] + bias), bf_hi(u2.y) * (acc[n][m][3] + bias));
                    *(u32x2*)(zp + n * 16) = o;
                }
                zp += 16 * 6144; asm volatile("" : "+v"(zp));
            }
        }
    }
}

#ifndef EN_MASK
#define EN_MASK 255
#endif
constexpr int EN = EN_MASK;
__global__ void __launch_bounds__(NTHREADS, 2) fwd_megakernel(Params p) {
    extern __shared__ __attribute__((aligned(16))) unsigned char lds_raw[];
    LAS unsigned char* lds = (LAS unsigned char*)lds_raw;
    cg::grid_group grid = cg::this_grid();
    volatile LAS unsigned* xst = (volatile LAS unsigned*)(lds + LDS_BYTES - 16);
    if (threadIdx.x == 0) { xst[0] = 0u; xst[1] = 0u; }
    XcdBarrier xb; xb.bar = (unsigned*)(p.ws + WS_BAR); xb.x = 0; xb.st = xst;
    const float* x_in = p.in[0]; const float* ctx_in = p.in[2];
    const float* mod0 = (const float*)(p.ws + WS_MOD); const float* mod1 = mod0 + (size_t)33 * 9216;
    const float* lbv = (const float*)(p.ws + WS_LB);
    const float* ln_g = p.in[6]; const float* ln_b = p.in[7];
    bf16_t* A0 = (bf16_t*)(p.ws + WS_A0); bf16_t* BIG = (bf16_t*)(p.ws + WS_BIG);
    const bf16_t* FIN = (const bf16_t*)(p.ws + WS_FIN); const bf16_t* FOUT = (const bf16_t*)(p.ws + WS_FOUT);
    const bf16_t* HIN = (const bf16_t*)(p.ws + WS_HIN); const bf16_t* HOUT = (const bf16_t*)(p.ws + WS_HOUT);
    const bf16_t* CIN = (const bf16_t*)(p.ws + WS_CIN); const bf16_t* COUT = (const bf16_t*)(p.ws + WS_COUT);
    const size_t FIN_SZ = (size_t)5632 * 1024, FOUT_SZ = (size_t)1024 * 2816;
    for (int ph = p.ph_lo; ph < p.ph_hi; ++ph) {
        int kind;
        switch (ph) {
        case 0: kind = 0; break;
        case 1: case 4: case 8: case 11: case 14: case 18: case 21: kind = 1; break;
        case 2: case 9: case 12: case 19: kind = 2; break;
        case 3: case 7: case 10: case 13: case 17: case 20: kind = 3; break;
        case 5: kind = 4; break;
        case 6: kind = 5; break;
        case 15: kind = 6; break;
        default: kind = 7; break;
        }
        if (kind == 0) { if (EN & 1) phase0(p, lds); }
        else if (kind == 1) {
            RowArgs a;
            a.xs_x = p.out; a.xs_c = nullptr; a.nrows = MX; a.y = A0; a.ysc = 0.5f; a.xd = p.out; a.hd = A0;
            if (ph == 1) { a.xs_x = x_in; a.xs_c = ctx_in; a.nrows = MT; a.y = nullptr; a.m = mod0; a.k = 0; a.g = ln_g; a.b = ln_b; a.m2 = mod0; a.k2 = 0; }
            else if (ph == 4) { a.xs_x = x_in; a.xs_c = ctx_in; a.nrows = MT; a.m = mod0; a.k = 0; a.g = ln_g + 0 * D; a.b = ln_b + 0 * D; a.m2 = mod0; a.k2 = 1; }
            else if (ph == 8) { a.y = BIG; a.ysc = 1.f; a.m = mod0; a.k = 1; a.g = ln_g + 1 * D; a.b = ln_b + 1 * D; a.m2 = mod0; a.k2 = 2; }
            else if (ph == 11) { a.m = mod0; a.k = 2; a.g = ln_g + 2 * D; a.b = ln_b + 2 * D; a.m2 = mod1; a.k2 = 0; }
            else if (ph == 14) { a.m = mod1; a.k = 0; a.g = ln_g + 3 * D; a.b = ln_b + 3 * D; a.m2 = mod1; a.k2 = 1; }
            else if (ph == 18) { a.ysc = 1.f; a.m = mod1; a.k = 1; a.g = ln_g + 4 * D; a.b = ln_b + 4 * D; a.m2 = mod1; a.k2 = 2; }
            else { a.m = mod1; a.k = 2; a.g = ln_g + 5 * D; a.b = ln_b + 5 * D; a.hd = nullptr; a.m2 = mod1; a.k2 = 0; }
            if (EN & 2) row_phase(a);
        } else if (kind == 2) {
            const int wi = ph == 2 ? 0 : (ph == 9 ? 1 : (ph == 12 ? 2 : 3));
            if (EN & 4) run_gemm<1>(lds, A0, D, FIN + wi * FIN_SZ, ph == 2 ? MT : MX, 2 * FH, D, BIG, FH, nullptr);
        } else if (kind == 3) {
            const bf16_t* A = BIG; int lda = FH, M = MX, K = FH; const bf16_t* Bt; bf16_t* O = A0;
            if (ph == 3) { Bt = FOUT; M = MT; }
            else if (ph == 7) { A = A0; lda = D; K = D; Bt = HOUT; O = BIG; }
            else if (ph == 10) Bt = FOUT + 1 * FOUT_SZ;
            else if (ph == 13) Bt = FOUT + 2 * FOUT_SZ;
            else if (ph == 17) { lda = 2 * CMI; K = CMI; Bt = COUT; }
            else Bt = FOUT + 3 * FOUT_SZ;
            if (EN & 8) run_gemm<0>(lds, A, lda, Bt, M, D, K, O, D, nullptr);
        } else if (kind == 4) { if (EN & 16) run_gemm<2>(lds, A0, D, HIN, MT, HG5, D, BIG, HG5, lbv); }
        else if (kind == 5) { if (EN & 32) gla_phase(p, lds); }
        else if (kind == 6) { if (EN & 64) run_gemm<3>(lds, A0, D, CIN, MX, 2 * CMI, D, BIG, 2 * CMI, nullptr); }
        else { if (EN & 128) cm_gate_phase(p, lds); }
        if (ph + 1 < p.ph_hi) {
            if (ph == 0) { grid.sync(); xb = xcd_barrier_post((unsigned*)(p.ws + WS_BAR), xst); }
            else xcd_barrier(xb);
        }
    }
}

extern "C" void kernel_launch(void* const* d_in, const int* in_sizes, int n_in, void* d_out, int out_size, void* d_ws, size_t ws_size, hipStream_t stream) {
    static int grid_blocks = 0;
    if (grid_blocks == 0) {
        if (n_in != 20 || out_size != MX * D || ws_size < WS_END) { fprintf(stderr, "kernel_launch: unexpected shapes (n_in %d out %d ws %zu need %zu)\n", n_in, out_size, ws_size, (size_t)WS_END); grid_blocks = -1; return; }
        int dev = 0, cus = 0, per_cu = 0;
        hipGetDevice(&dev);
        hipDeviceGetAttribute(&cus, hipDeviceAttributeMultiprocessorCount, dev);
        if (hipFuncSetAttribute((const void*)fwd_megakernel, hipFuncAttributeMaxDynamicSharedMemorySize, LDS_BYTES) != hipSuccess) { fprintf(stderr, "kernel_launch: hipFuncSetAttribute failed\n"); grid_blocks = -1; return; }
        if (hipOccupancyMaxActiveBlocksPerMultiprocessor(&per_cu, (const void*)fwd_megakernel, NTHREADS, LDS_BYTES) != hipSuccess || per_cu < 1) { fprintf(stderr, "kernel_launch: occupancy query says %d\n", per_cu); per_cu = 1; }
        (void)hipGetLastError();
        grid_blocks = cus * 1;
    }
    if (grid_blocks < 0) return;
    Params p{};
    for (int i = 0; i < 20; ++i) p.in[i] = (const float*)d_in[i];
    p.out = (float*)d_out; p.ws = (unsigned char*)d_ws; p.ph_lo = 0; p.ph_hi = 22;
    void* args[] = {&p};
    hipError_t e = hipLaunchCooperativeKernel((const void*)fwd_megakernel, dim3(grid_blocks), dim3(NTHREADS), args, LDS_BYTES, stream);
    if (e != hipSuccess) fprintf(stderr, "cooperative launch failed: %s (grid %d)\n", hipGetErrorString(e), grid_blocks);
}
```

```cpp
#include <hip/hip_runtime.h>
#include <hip/hip_cooperative_groups.h>
#include <cstdio>
#include <cstdint>
namespace cg = cooperative_groups;

#define LAS __attribute__((address_space(3)))
typedef unsigned short bf16_t;
typedef short bf16x8 __attribute__((ext_vector_type(8)));
typedef float f32x4 __attribute__((ext_vector_type(4)));
typedef float f32x2 __attribute__((ext_vector_type(2)));
typedef unsigned u32x4 __attribute__((ext_vector_type(4)));
typedef unsigned u32x2 __attribute__((ext_vector_type(2)));

constexpr int D = 1024, NB = 32, SEQ = 2048, CTXL = 256;
constexpr int MX = NB * SEQ;
constexpr int MC = NB * CTXL;
constexpr int MT = MX + MC;
constexpr int FH = 2816, HG5 = 5 * D, CMI = 3072, NMOD = 9;
constexpr float DN_ALPHA = 1.41421356237309515f;
constexpr float LN_EPS = 1e-5f, RMS_EPS = 1e-6f;
constexpr int LDS_BYTES = 149504;
constexpr int NTHREADS = 512;

constexpr size_t WS_MOD = 0;
constexpr size_t WS_LB = WS_MOD + (size_t)2 * 33 * 9216 * 4;
constexpr size_t WS_BAR = WS_LB + 2 * 1024 * 4;
constexpr size_t WS_FIN = WS_BAR + 4096 * 4;
constexpr size_t WS_FOUT = WS_FIN + (size_t)4 * 5632 * 1024 * 2;
constexpr size_t WS_HIN = WS_FOUT + (size_t)4 * 1024 * 2816 * 2;
constexpr size_t WS_HOUT = WS_HIN + (size_t)5120 * 1024 * 2;
constexpr size_t WS_CIN = WS_HOUT + (size_t)1024 * 1024 * 2;
constexpr size_t WS_COUT = WS_CIN + (size_t)6144 * 1024 * 2;
constexpr size_t WS_WSB = WS_COUT + (size_t)1024 * 3072 * 2;
constexpr size_t WS_A0 = WS_WSB + (size_t)8 * 128 * 128 * 2;
constexpr size_t WS_BIG = WS_A0 + (size_t)MT * 1024 * 2;
constexpr size_t WS_END = WS_BIG + (size_t)MX * 6144 * 2;

struct Params {
    const float* in[20];
    float* out;
    unsigned char* ws;
    int ph_lo, ph_hi;
};

__device__ __forceinline__ unsigned cvt_pk_bf16(float lo, float hi) { unsigned r; asm volatile("v_cvt_pk_bf16_f32 %0, %1, %2" : "=v"(r) : "v"(lo), "v"(hi)); return r; }
__device__ __forceinline__ int opaque_tid() { int t = threadIdx.x; asm volatile("" : "+v"(t)); return t; }
__device__ __forceinline__ float bf_lo(unsigned u) { return __uint_as_float(u << 16); }
__device__ __forceinline__ float bf_hi(unsigned u) { return __uint_as_float(u & 0xffff0000u); }
__device__ __forceinline__ float wave_sum(float v) {
#pragma unroll
    for (int o = 1; o < 64; o <<= 1) v += __shfl_xor(v, o);
    return v;
}
__device__ __forceinline__ float sigmoid_f(float x) { return __builtin_amdgcn_rcpf(1.f + __expf(-x)); }
__device__ __forceinline__ float silu_f(float x) { return x * sigmoid_f(x); }
__device__ __forceinline__ float gelu_tanh_f(float x) { const float u = 0.7978845608028654f * (x + 0.044715f * x * x * x); return x * sigmoid_f(2.f * u); }

namespace pg8 {
constexpr int BM = 256, BK = 64, HALF = 128, HTB = HALF * BK * 2, STAGE_BYTES = 8 * HTB, NXCD = 8, WGM = 8;
__host__ __device__ __forceinline__ int lds_byte(int r, int c) { const int st = (r >> 4) * 2 + (c >> 5), rr = r & 15, cc = c & 31, ob = rr * 64 + cc * 2; return st * 1024 + (ob ^ (((ob >> 9) & 1) << 5)); }
__host__ __device__ __forceinline__ void stage_rc(int b, int& R, int& C) { const int st = b / 1024, sb = b % 1024, swz = sb ^ (((sb >> 9) & 1) << 5); R = (st >> 1) * 16 + swz / 64; C = (st & 1) * 32 + (swz % 64) / 2; }
__host__ __device__ __forceinline__ int perm32(int rho) { const int n = rho >> 4, i = rho & 15; return 8 * (i >> 2) + 4 * n + (i & 3); }

struct Unit { int pm, pn; };
struct Gemm { const bf16_t* A; int lda; const bf16_t* Bt; int M, N, K; };

struct StaticOrder {
    int nM, nN, nwg, G, c;
    __device__ void init(int M, int N, int G_, int c_) { nM = M / BM; nN = N / BM; nwg = nM * nN; G = G_; c = c_; }
    __device__ bool next(int i, Unit& u) const {
        const long L = (long)i * G + c; if (L >= nwg) return false;
        int wgid = (int)L; { const int q = nwg / NXCD, r = nwg % NXCD, xcd = wgid % NXCD, off = wgid / NXCD; wgid = (xcd < r ? xcd * (q + 1) : r * (q + 1) + (xcd - r) * q) + off; }
        const int nig = WGM * nN, gid = wgid / nig, fm = gid * WGM, gsz = (nM - fm) < WGM ? (nM - fm) : WGM;
        u.pm = fm + ((wgid % nig) % gsz); u.pn = (wgid % nig) / gsz; return true;
    }
};

template <int MODE> struct Epi {
    bf16_t* O; int ldo; const float* lb;
    __device__ __forceinline__ void operator()(const f32x4 (&acc)[2][2][4][2], const Unit& u, int wr, int wc, int fr, int fq) const {
        const int row0 = u.pm * BM + wr * 64 + fr;
        if constexpr (MODE == 1) {
            const int col0 = u.pn * 128 + wc * 32 + 8 * fq;
#pragma unroll
            for (int ai = 0; ai < 2; ++ai)
#pragma unroll
                for (int m = 0; m < 4; ++m) {
                    const f32x4 g0 = acc[ai][0][m][0], g1 = acc[ai][0][m][1], u0 = acc[ai][1][m][0], u1 = acc[ai][1][m][1];
                    u32x4 o;
                    o.x = cvt_pk_bf16(silu_f(g0[0]) * u0[0], silu_f(g0[1]) * u0[1]);
                    o.y = cvt_pk_bf16(silu_f(g0[2]) * u0[2], silu_f(g0[3]) * u0[3]);
                    o.z = cvt_pk_bf16(silu_f(g1[0]) * u1[0], silu_f(g1[1]) * u1[1]);
                    o.w = cvt_pk_bf16(silu_f(g1[2]) * u1[2], silu_f(g1[3]) * u1[3]);
                    *(u32x4*)(O + (size_t)(row0 + ai * HALF + m * 16) * ldo + col0) = o;
                    __builtin_amdgcn_sched_barrier(0);
                }
        } else {
            const int seg = u.pn >> 2;
#pragma unroll
            for (int bj = 0; bj < 2; ++bj) {
                const int col0 = u.pn * BM + bj * HALF + wc * 32 + 8 * fq;
                f32x4 l0 = {0.f, 0.f, 0.f, 0.f}, l1 = {0.f, 0.f, 0.f, 0.f};
                if (MODE == 2 && (seg == 2 || seg == 3)) { const float* lp = lb + (seg - 2) * 1024 + (col0 & 1023); l0 = *(const f32x4*)lp; l1 = *(const f32x4*)(lp + 4); }
#pragma unroll
                for (int ai = 0; ai < 2; ++ai)
#pragma unroll
                    for (int m = 0; m < 4; ++m) {
                        f32x4 v0 = acc[ai][bj][m][0], v1 = acc[ai][bj][m][1];
                        if constexpr (MODE == 3) {
#pragma unroll
                            for (int i = 0; i < 4; ++i) { v0[i] = gelu_tanh_f(v0[i]); v1[i] = gelu_tanh_f(v1[i]); }
                        }
                        if constexpr (MODE == 2) {
                            if (seg == 0 || seg == 4) {
#pragma unroll
                                for (int i = 0; i < 4; ++i) { v0[i] = silu_f(v0[i]); v1[i] = silu_f(v1[i]); }
                            } else if (seg >= 2) {
#pragma unroll
                                for (int i = 0; i < 4; ++i) {
                                    v0[i] = __logf(l0[i] + (1.f - l0[i]) * sigmoid_f(v0[i]));
                                    v1[i] = __logf(l1[i] + (1.f - l1[i]) * sigmoid_f(v1[i]));
                                }
                            }
                        }
                        u32x4 o;
                        o.x = cvt_pk_bf16(v0[0], v0[1]); o.y = cvt_pk_bf16(v0[2], v0[3]); o.z = cvt_pk_bf16(v1[0], v1[1]); o.w = cvt_pk_bf16(v1[2], v1[3]);
                        *(u32x4*)(O + (size_t)(row0 + ai * HALF + m * 16) * ldo + col0) = o;
                        __builtin_amdgcn_sched_barrier(0);
                    }
            }
        }
    }
};

template <class EpiT>
__device__ __forceinline__ void gemm_phase(LAS unsigned char* lds, const Gemm g, const StaticOrder& S, const EpiT& E) {
    const int tid = opaque_tid(), wid = __builtin_amdgcn_readfirstlane(tid >> 6), lane = tid & 63, wr = wid >> 2, wc = wid & 3, fr = lane & 15, fq = lane >> 4;
    const int K = g.K, nt = K / BK, lda = g.lda;
    unsigned voffA[2], voffB[2];
#pragma unroll
    for (int i = 0; i < 2; ++i) { int R, C; stage_rc(tid * 16 + i * 8192, R, C); const int Rb = (R & ~31) + perm32(R & 31);
        voffA[i] = (unsigned)(R * lda + C) * 2u; voffB[i] = (unsigned)(Rb * K + C) * 2u; }
    const size_t kstep = (size_t)(BK * 2);
    const size_t hstepA = (size_t)HALF * lda * 2, hstepB = (size_t)HALF * K * 2;
    const size_t tstepA = 2 * hstepA, tstepB = 2 * hstepB;
    const unsigned ldsw = (unsigned)wid * 1024u;
    const int aoff = lds_byte(wr * 64 + fr, fq * 8), boff = lds_byte(wc * 32 + fr, fq * 8);
#define PG8_SA(b, h) (((b) * 2 + (h)) * HTB)
#define PG8_SB(b, h) ((4 + (b) * 2 + (h)) * HTB)
#define PG8_STAGE(bufoff, gbase, voff) do { _Pragma("unroll") for (int _i = 0; _i < 2; ++_i) \
        __builtin_amdgcn_global_load_lds((const unsigned*)((const char*)(gbase) + (voff)[_i]), (LAS unsigned*)(lds + (bufoff) + ldsw + _i * 8192), 16, 0, 0); } while (0)
#define PG8_LDA(dst, b, h) do { _Pragma("unroll") for (int m = 0; m < 4; ++m) _Pragma("unroll") for (int k = 0; k < 2; ++k) dst[m][k] = *(const LAS bf16x8*)(lds + PG8_SA(b, h) + aoff + m * 2048 + k * 1024); } while (0)
#define PG8_LDB(dst, b, h) do { _Pragma("unroll") for (int n = 0; n < 2; ++n) _Pragma("unroll") for (int k = 0; k < 2; ++k) dst[n][k] = *(const LAS bf16x8*)(lds + PG8_SB(b, h) + boff + n * 2048 + k * 1024); } while (0)
#define PG8_MMA(ai, bj, At, Bt) do { __builtin_amdgcn_s_setprio(1); _Pragma("unroll") for (int m = 0; m < 4; ++m) _Pragma("unroll") for (int n = 0; n < 2; ++n) _Pragma("unroll") for (int k = 0; k < 2; ++k) \
        acc[ai][bj][m][n] = __builtin_amdgcn_mfma_f32_16x16x32_bf16(Bt[n][k], At[m][k], acc[ai][bj][m][n], 0, 0, 0); __builtin_amdgcn_s_setprio(0); } while (0)
#define PG8_WAIT_V(n) asm volatile("s_waitcnt vmcnt(" #n ")" ::: "memory")
#define PG8_WAIT_L(n) asm volatile("s_waitcnt lgkmcnt(" #n ")" ::: "memory")
#define PG8_BAR __builtin_amdgcn_s_barrier()
#define PG8_SCHED __builtin_amdgcn_sched_barrier(0)
    Unit cur, nxt; int ui = 0;
    if (!S.next(0, cur)) return;
    f32x4 acc[2][2][4][2];
#pragma unroll
    for (int a = 0; a < 2; ++a)
#pragma unroll
        for (int b = 0; b < 2; ++b)
#pragma unroll
            for (int m = 0; m < 4; ++m)
#pragma unroll
                for (int n = 0; n < 2; ++n) acc[a][b][m][n] = (f32x4){0.f, 0.f, 0.f, 0.f};
    bf16x8 At[4][2], B0[2][2], B1[2][2];
    const char* cA = (const char*)g.A + (size_t)cur.pm * tstepA; const char* cB = (const char*)g.Bt + (size_t)cur.pn * tstepB;
    PG8_STAGE(PG8_SB(0, 0), cB, voffB); PG8_STAGE(PG8_SA(0, 0), cA, voffA); PG8_STAGE(PG8_SB(0, 1), cB + hstepB, voffB); PG8_STAGE(PG8_SA(0, 1), cA + hstepA, voffA);
    if (wr == 1) PG8_BAR;
    PG8_WAIT_V(4); PG8_BAR;
    PG8_STAGE(PG8_SB(1, 0), cB + kstep, voffB); PG8_STAGE(PG8_SA(1, 0), cA + kstep, voffA); PG8_STAGE(PG8_SB(1, 1), cB + hstepB + kstep, voffB);
    PG8_WAIT_V(6); PG8_BAR;
    for (;;) {
        const bool has_next = S.next(ui + 1, nxt);
        const char* nA = has_next ? (const char*)g.A + (size_t)nxt.pm * tstepA : cA; const char* nB = has_next ? (const char*)g.Bt + (size_t)nxt.pn * tstepB : cB;
        for (int t = 0; t < nt; t += 2) {
            const bool last = (t == nt - 2);
            const char* a1 = cA + (size_t)(t + 1) * kstep;
            const char* a2 = last ? nA : cA + (size_t)(t + 2) * kstep; const char* b2 = last ? nB : cB + (size_t)(t + 2) * kstep;
            const char* a3 = a2 + kstep; const char* b3 = b2 + kstep;
            PG8_LDB(B0, 0, 0); PG8_SCHED; PG8_LDA(At, 0, 0); PG8_STAGE(PG8_SA(1, 1), a1 + hstepA, voffA);
            PG8_WAIT_L(8); PG8_BAR; PG8_WAIT_L(0); PG8_MMA(0, 0, At, B0); PG8_BAR; PG8_SCHED;
            PG8_LDB(B1, 0, 1); PG8_STAGE(PG8_SB(0, 0), b2, voffB);
            PG8_BAR; PG8_WAIT_L(0); PG8_MMA(0, 1, At, B1); PG8_BAR;
            PG8_LDA(At, 0, 1); PG8_STAGE(PG8_SA(0, 0), a2, voffA);
            PG8_BAR; PG8_WAIT_L(0); PG8_MMA(1, 0, At, B0); PG8_BAR; PG8_SCHED;
            PG8_STAGE(PG8_SB(0, 1), b2 + hstepB, voffB);
            PG8_WAIT_V(6); PG8_BAR; PG8_MMA(1, 1, At, B1); PG8_BAR;
            PG8_LDB(B0, 1, 0); PG8_SCHED; PG8_LDA(At, 1, 0); PG8_STAGE(PG8_SA(0, 1), a2 + hstepA, voffA);
            PG8_WAIT_L(8); PG8_BAR; PG8_WAIT_L(0); PG8_MMA(0, 0, At, B0); PG8_BAR; PG8_SCHED;
            PG8_LDB(B1, 1, 1); PG8_STAGE(PG8_SB(1, 0), b3, voffB);
            PG8_BAR; PG8_WAIT_L(0); PG8_MMA(0, 1, At, B1); PG8_BAR;
            PG8_LDA(At, 1, 1); PG8_STAGE(PG8_SA(1, 0), a3, voffA);
            PG8_BAR; PG8_WAIT_L(0); PG8_MMA(1, 0, At, B0); PG8_BAR; PG8_SCHED;
            PG8_STAGE(PG8_SB(1, 1), b3 + hstepB, voffB);
            PG8_WAIT_V(6); PG8_BAR; PG8_MMA(1, 1, At, B1); PG8_BAR;
        }
        E(acc, cur, wr, wc, fr, fq);
        if (!has_next) break;
#pragma unroll
        for (int a = 0; a < 2; ++a)
#pragma unroll
            for (int b = 0; b < 2; ++b)
#pragma unroll
                for (int m = 0; m < 4; ++m)
#pragma unroll
                    for (int n = 0; n < 2; ++n) acc[a][b][m][n] = (f32x4){0.f, 0.f, 0.f, 0.f};
        cur = nxt; cA = nA; cB = nB; ++ui;
    }
    PG8_WAIT_V(0);
    if (wr == 0) PG8_BAR;
    PG8_BAR;
#undef PG8_SA
#undef PG8_SB
#undef PG8_STAGE
#undef PG8_LDA
#undef PG8_LDB
#undef PG8_MMA
#undef PG8_WAIT_V
#undef PG8_WAIT_L
#undef PG8_BAR
#undef PG8_SCHED
}
}

template <int MODE>
__device__ __forceinline__ void run_gemm(LAS unsigned char* lds, const bf16_t* A, int lda, const bf16_t* Bt, int M, int N, int K, bf16_t* O, int ldo, const float* lb) {
    pg8::Gemm g{A, lda, Bt, M, N, K};
    pg8::StaticOrder S; S.init(M, N, gridDim.x, blockIdx.x);
    pg8::Epi<MODE> E{O, ldo, lb};
    pg8::gemm_phase(lds, g, S, E);
}

#define XB_TMO      128
#define XB_XCNT(j)  (256  + 64 * (j))
#define XB_XSUB(j)  (1280 + 64 * (j))
#define XB_XGEN(j)  (2304 + 64 * (j))
#define XB_TOP      3328
#define XB_TOPGEN   3392
#define XCD_BAR_WORDS 3456
#define XB_SPIN_CAP (1u << 22)
__device__ __forceinline__ unsigned xb_ld(unsigned* p)              { return __hip_atomic_load(p, __ATOMIC_RELAXED, __HIP_MEMORY_SCOPE_AGENT); }
__device__ __forceinline__ unsigned xb_add(unsigned* p, unsigned v) { return __hip_atomic_fetch_add(p, v, __ATOMIC_RELAXED, __HIP_MEMORY_SCOPE_AGENT); }
__device__ __forceinline__ unsigned xb_xcc_id() { return (unsigned)__builtin_amdgcn_s_getreg((3 << 11) | 20) & 0xFu; }
#define XB_SPIN(cond, bar) do { unsigned _sp = 0; while (cond) { __builtin_amdgcn_s_sleep(1); \
    if ((++_sp & 255u) == 0u) { if (xb_ld(&(bar)[XB_TMO])) break; if (_sp > XB_SPIN_CAP) { atomicAdd(&(bar)[XB_TMO], 1u); break; } } } } while (0)
struct XcdBarrier { unsigned* bar; unsigned x; volatile LAS unsigned* st; };
__device__ __forceinline__ XcdBarrier xcd_barrier_post(unsigned* bar, volatile LAS unsigned* st) {
    XcdBarrier b; b.bar = bar; b.x = xb_xcc_id(); b.st = st;
    if (threadIdx.x == 0) (void)xb_add(&bar[XB_XCNT(b.x)], 1u);
    return b;
}
__device__ __forceinline__ void xcd_barrier_complete(unsigned* bar, unsigned x, unsigned& nloc, unsigned& nx) {
    const unsigned G = gridDim.x * gridDim.y * gridDim.z;
    unsigned sum, cnt, mine, sp = 0u;
    for (;;) {
        sum = 0u; cnt = 0u; mine = 0u;
#pragma unroll
        for (unsigned j = 0; j < 16; ++j) { const unsigned c = xb_ld(&bar[XB_XCNT(j)]); sum += c; cnt += (c > 0u) ? 1u : 0u; mine = (j == x) ? c : mine; }
        if (sum == G) break;
        __builtin_amdgcn_s_sleep(1);
        if ((++sp & 255u) == 0u) { if (xb_ld(&bar[XB_TMO])) break; if (sp > XB_SPIN_CAP) { atomicAdd(&bar[XB_TMO], 1u); break; } }
    }
    nloc = mine > 0u ? mine : 1u; nx = cnt > 0u ? cnt : 1u;
}
__device__ __forceinline__ void xcd_barrier(const XcdBarrier& b) {
    asm volatile("s_waitcnt vmcnt(0)" ::: "memory");
    __syncthreads();
    if (threadIdx.x == 0) {
        unsigned* bar = b.bar;
        __builtin_amdgcn_s_waitcnt(0);
        unsigned nloc = b.st[0], nx = b.st[1];
        if (nloc == 0u) { xcd_barrier_complete(bar, b.x, nloc, nx); b.st[0] = nloc; b.st[1] = nx; }
        const unsigned old = xb_add(&bar[XB_XSUB(b.x)], 1u);
        const unsigned gen = old / nloc;
        if (old + 1u == (gen + 1u) * nloc) {
            __builtin_amdgcn_fence(__ATOMIC_RELEASE, "agent");
            asm volatile("s_waitcnt vmcnt(0)" ::: "memory");
            const unsigned og = xb_add(&bar[XB_TOP], 1u);
            const unsigned tg = og / nx;
            if (og + 1u == (tg + 1u) * nx) xb_add(&bar[XB_TOPGEN], 1u);
            else XB_SPIN(xb_ld(&bar[XB_TOPGEN]) == tg, bar);
            __builtin_amdgcn_fence(__ATOMIC_ACQUIRE, "agent");
            xb_add(&bar[XB_XGEN(b.x)], 1u);
            asm volatile("s_waitcnt vmcnt(0)" ::: "memory");
        } else {
            XB_SPIN(xb_ld(&bar[XB_XGEN(b.x)]) == gen, bar);
            __builtin_amdgcn_fence(__ATOMIC_ACQUIRE, "agent");
            asm volatile("s_waitcnt vmcnt(0)" ::: "memory");
        }
    }
    __syncthreads();
}


__device__ __forceinline__ void p0_mod_item(const Params& p, LAS unsigned char* lds, int item) {
    const int tid = opaque_tid();
    const int layer = item / 144, cgp = item % 144, col0 = cgp * 64;
    const float* c = p.in[1]; const float* cctx = p.in[3];
    const float* W = p.in[4] + (size_t)layer * 1024 * 9216; const float* bias = p.in[5] + (size_t)layer * 9216;
    float* mout = (float*)(p.ws + WS_MOD) + (size_t)layer * 33 * 9216;
    LAS float* S = (LAS float*)lds;
    __syncthreads();
    for (int i = tid; i < 33 * 1024; i += NTHREADS) { const int r = i >> 10, k = i & 1023; const float v = r < 32 ? c[r * 1024 + k] : cctx[k]; S[i] = silu_f(v); }
    __syncthreads();
    const int col = tid & 63, ks = tid >> 6;
    float acc[33];
#pragma unroll
    for (int r = 0; r < 33; ++r) acc[r] = 0.f;
    for (int k4 = 0; k4 < 32; ++k4) {
        const int k = ks * 128 + k4 * 4;
        const float w0 = W[(size_t)(k + 0) * 9216 + col0 + col], w1 = W[(size_t)(k + 1) * 9216 + col0 + col], w2 = W[(size_t)(k + 2) * 9216 + col0 + col], w3 = W[(size_t)(k + 3) * 9216 + col0 + col];
#pragma unroll
        for (int r = 0; r < 33; ++r) { const f32x4 s4 = *(const LAS f32x4*)(S + r * 1024 + k); acc[r] += w0 * s4[0] + w1 * s4[1] + w2 * s4[2] + w3 * s4[3]; }
    }
    __syncthreads();
    LAS float* red = (LAS float*)lds;
#pragma unroll
    for (int r = 0; r < 33; ++r) red[(ks * 33 + r) * 64 + col] = acc[r];
    __syncthreads();
    for (int i = tid; i < 33 * 64; i += NTHREADS) {
        const int r = i >> 6, cc = i & 63; float s = 0.f;
#pragma unroll
        for (int q = 0; q < 8; ++q) s += red[(q * 33 + r) * 64 + cc];
        mout[(size_t)r * 9216 + col0 + cc] = s + bias[col0 + cc];
    }
    __syncthreads();
}

__device__ __forceinline__ void p0_transpose_item(const float* W, int K, int N, bf16_t* WT, int k0, int n0, int drow0, LAS float* scr, int lane) {
#pragma unroll 8
    for (int i = 0; i < 32; ++i) { const int kk = 2 * i + (lane >> 5); scr[kk * 33 + (lane & 31)] = W[(size_t)(k0 + kk) * N + n0 + (lane & 31)]; }
    asm volatile("s_waitcnt lgkmcnt(0)" ::: "memory");
    const int c = lane & 7;
#pragma unroll
    for (int j = 0; j < 4; ++j) { const int n = (lane >> 3) + 8 * j; const LAS float* s = scr + (8 * c) * 33 + n;
        u32x4 o; o.x = cvt_pk_bf16(s[0 * 33], s[1 * 33]); o.y = cvt_pk_bf16(s[2 * 33], s[3 * 33]); o.z = cvt_pk_bf16(s[4 * 33], s[5 * 33]); o.w = cvt_pk_bf16(s[6 * 33], s[7 * 33]);
        *(u32x4*)(WT + (size_t)(drow0 + n) * K + k0 + 8 * c) = o; }
    asm volatile("s_waitcnt lgkmcnt(0)" ::: "memory");
}

__device__ __forceinline__ void phase0(const Params& p, LAS unsigned char* lds) {
    const int tid = opaque_tid(), wid = tid >> 6, lane = tid & 63;
    if (blockIdx.x == 0) { unsigned* bar = (unsigned*)(p.ws + WS_BAR); for (int i = tid; i < 4096; i += NTHREADS) bar[i] = 0u; }
    if (blockIdx.x == gridDim.x - 1) {
        const float* lbp = p.in[11]; float* lbo = (float*)(p.ws + WS_LB);
        for (int i = tid; i < 2048; i += NTHREADS) { const int dir = i >> 10, col = i & 1023;
            const float l0 = lbp[(dir * 3 + 0) * 1024 + col], l1 = lbp[(dir * 3 + 1) * 1024 + col], l2 = lbp[(dir * 3 + 2) * 1024 + col];
            const float mx = fmaxf(l0, fmaxf(l1, l2)); const float e0 = __expf(l0 - mx), e1 = __expf(l1 - mx), e2 = __expf(l2 - mx);
            lbo[i] = e0 / (e0 + e1 + e2); }
    }
    if (blockIdx.x == gridDim.x - 2) {
        const float* wsp = p.in[17]; bf16_t* wsb = (bf16_t*)(p.ws + WS_WSB);
        for (int i = tid; i < 8 * 128 * 128 / 4; i += NTHREADS) { const f32x4 w = *(const f32x4*)(wsp + 4 * i); u32x2 o; o.x = cvt_pk_bf16(w[0], w[1]); o.y = cvt_pk_bf16(w[2], w[3]); *(u32x2*)(wsb + 4 * i) = o; }
    }
    for (int it = blockIdx.x; it < 288; it += gridDim.x) p0_mod_item(p, lds, it);
    __syncthreads();
    LAS float* scr = (LAS float*)lds + wid * (64 * 33);
    const int gw = blockIdx.x * 8 + wid, nw = gridDim.x * 8;
    for (int mi = 0; mi < 12; ++mi) {
        const float* W; bf16_t* WT; int K, N, mode = 0;
        if (mi < 4) { W = p.in[8] + (size_t)mi * 1024 * 5632; WT = (bf16_t*)(p.ws + WS_FIN) + (size_t)mi * 5632 * 1024; K = 1024; N = 5632; mode = 1; }
        else if (mi < 8) { W = p.in[9] + (size_t)(mi - 4) * 2816 * 1024; WT = (bf16_t*)(p.ws + WS_FOUT) + (size_t)(mi - 4) * 1024 * 2816; K = 2816; N = 1024; }
        else if (mi == 8) { W = p.in[10]; WT = (bf16_t*)(p.ws + WS_HIN); K = 1024; N = 5120; }
        else if (mi == 9) { W = p.in[13]; WT = (bf16_t*)(p.ws + WS_HOUT); K = 1024; N = 1024; }
        else if (mi == 10) { W = p.in[14]; WT = (bf16_t*)(p.ws + WS_CIN); K = 1024; N = 6144; }
        else { W = p.in[19]; WT = (bf16_t*)(p.ws + WS_COUT); K = 3072; N = 1024; }
        const int nblk = N / 32, nitems = (K / 64) * nblk;
        for (int it = gw; it < nitems; it += nw) {
            const int kb = it / nblk, nb = it % nblk, n0 = nb * 32;
            int drow0 = n0;
            if (mode == 1) { const int j = n0 < FH ? n0 : n0 - FH; drow0 = 256 * (j >> 7) + (n0 < FH ? 0 : 128) + (j & 127); }
            p0_transpose_item(W, K, N, WT, kb * 64, n0, drow0, scr, lane);
        }
    }
}

struct RowArgs {
    const float* xs_x; const float* xs_c; int nrows;
    const bf16_t* y; float ysc; const float* m; int k; const float* g; const float* b;
    float* xd; bf16_t* hd; const float* m2; int k2;
};
__device__ __forceinline__ void row_phase(const RowArgs& a) {
    const int tid0 = opaque_tid(); const int wid = tid0 >> 6, lane = tid0 & 63;
    for (int rowb = blockIdx.x * 16 + wid; rowb < a.nrows; rowb += gridDim.x * 16) {
        f32x4 v[2][4]; int mrow[2];
#pragma unroll
        for (int q = 0; q < 2; ++q) {
            const int row = rowb + 8 * q; mrow[q] = row < MX ? (row >> 11) : 32;
            const float* xr = row < MX ? a.xs_x + (size_t)row * D : a.xs_c + (size_t)(row - MX) * D;
#pragma unroll
            for (int j = 0; j < 4; ++j) v[q][j] = *(const f32x4*)(xr + j * 256 + lane * 4);
        }
        if (a.y) {
            u32x2 yy[2][4]; f32x4 gt[2][4];
#pragma unroll
            for (int q = 0; q < 2; ++q) {
                const int row = rowb + 8 * q; const float* gp = a.m + (size_t)mrow[q] * 9216 + (3 * a.k + 2) * 1024;
#pragma unroll
                for (int j = 0; j < 4; ++j) { yy[q][j] = *(const u32x2*)(a.y + (size_t)row * D + j * 256 + lane * 4); gt[q][j] = *(const f32x4*)(gp + j * 256 + lane * 4); }
            }
            f32x4 gg[4], bb[4];
#pragma unroll
            for (int j = 0; j < 4; ++j) { gg[j] = *(const f32x4*)(a.g + j * 256 + lane * 4); bb[j] = *(const f32x4*)(a.b + j * 256 + lane * 4); }
            float s[2] = {0.f, 0.f};
#pragma unroll
            for (int q = 0; q < 2; ++q)
#pragma unroll
                for (int j = 0; j < 4; ++j) {
                    v[q][j][0] = DN_ALPHA * v[q][j][0] + gt[q][j][0] * a.ysc * bf_lo(yy[q][j].x); v[q][j][1] = DN_ALPHA * v[q][j][1] + gt[q][j][1] * a.ysc * bf_hi(yy[q][j].x);
                    v[q][j][2] = DN_ALPHA * v[q][j][2] + gt[q][j][2] * a.ysc * bf_lo(yy[q][j].y); v[q][j][3] = DN_ALPHA * v[q][j][3] + gt[q][j][3] * a.ysc * bf_hi(yy[q][j].y);
                    s[q] += (v[q][j][0] + v[q][j][1]) + (v[q][j][2] + v[q][j][3]);
                }
            float mean[2], s2[2] = {0.f, 0.f};
#pragma unroll
            for (int q = 0; q < 2; ++q) mean[q] = wave_sum(s[q]) * (1.f / D);
#pragma unroll
            for (int q = 0; q < 2; ++q)
#pragma unroll
                for (int j = 0; j < 4; ++j) { v[q][j] = v[q][j] - mean[q]; s2[q] += (v[q][j][0] * v[q][j][0] + v[q][j][1] * v[q][j][1]) + (v[q][j][2] * v[q][j][2] + v[q][j][3] * v[q][j][3]); }
#pragma unroll
            for (int q = 0; q < 2; ++q) {
                const int row = rowb + 8 * q;
                const float rstd = __builtin_amdgcn_rsqf(wave_sum(s2[q]) * (1.f / D) + LN_EPS);
#pragma unroll
                for (int j = 0; j < 4; ++j) v[q][j] = v[q][j] * rstd * gg[j] + bb[j];
                if (a.xd && row < MX) {
#pragma unroll
                    for (int j = 0; j < 4; ++j) *(f32x4*)(a.xd + (size_t)row * D + j * 256 + lane * 4) = v[q][j];
                }
            }
        }
        if (a.hd) {
#pragma unroll
            for (int q = 0; q < 2; ++q) {
                const int row = rowb + 8 * q;
                const float* shp = a.m2 + (size_t)mrow[q] * 9216 + (3 * a.k2) * 1024; const float* scp = shp + 1024;
#pragma unroll
                for (int j = 0; j < 4; ++j) {
                    const f32x4 sh = *(const f32x4*)(shp + j * 256 + lane * 4), sc = *(const f32x4*)(scp + j * 256 + lane * 4);
                    const f32x4 h = v[q][j] * (sc + 1.f) + sh;
                    u32x2 o; o.x = cvt_pk_bf16(h[0], h[1]); o.y = cvt_pk_bf16(h[2], h[3]);
                    *(u32x2*)(a.hd + (size_t)row * D + j * 256 + lane * 4) = o;
                }
            }
        }
    }
}

constexpr int GLA_DIRB = 74240;
__device__ __forceinline__ void gla_phase(const Params& p, LAS unsigned char* lds) {
    const int tid = opaque_tid(), dir = tid >> 8, tl = tid & 255, w = tl >> 6, lane = tl & 63, fr = lane & 15, fq = lane >> 4;
    const int cp = lane, qt = w;
    bf16_t* P = (bf16_t*)(p.ws + WS_BIG); bf16_t* R = (bf16_t*)(p.ws + WS_A0);
    const float* normw = p.in[12];
    LAS unsigned char* base = lds + dir * GLA_DIRB;
    LAS bf16_t* Qin = (LAS bf16_t*)base;
    LAS bf16_t* Kin = (LAS bf16_t*)(base + 17408);
    LAS bf16_t* Sc = Kin;
    LAS bf16_t* KinT = (LAS bf16_t*)(base + 34816);
    LAS bf16_t* VT = (LAS bf16_t*)(base + 53248);
    LAS float* tot = (LAS float*)(base + 71680);
    LAS float* dec = (LAS float*)(base + 73728);
    for (int item = blockIdx.x; item < NB * 8; item += gridDim.x) {
        const int b = item >> 3, h = item & 7;
        f32x4 Sacc[8][2];
#pragma unroll
        for (int m = 0; m < 8; ++m) { Sacc[m][0] = (f32x4){0.f, 0.f, 0.f, 0.f}; Sacc[m][1] = (f32x4){0.f, 0.f, 0.f, 0.f}; }
        unsigned rq[16], rv[16], rl[16];
        auto chunk_row = [&](int ci, int t) -> size_t {
            const bool isc = ci < 4; const int lc = isc ? ci : ci - 4, L = isc ? CTXL : SEQ; const int rbase = isc ? MX + b * CTXL : b * SEQ;
            const int tok = dir == 0 ? 64 * lc + t : L - 1 - (64 * lc + t);
            return (size_t)(rbase + tok);
        };
        auto load_chunk = [&](int ci) {
            const bf16_t* rp = P + chunk_row(ci, 16 * qt) * HG5 + h * 128 + 2 * cp;
            const long step = dir == 0 ? (long)HG5 : -(long)HG5;
#pragma unroll
            for (int i = 0; i < 16; ++i) {
                rq[i] = *(const unsigned*)rp; rv[i] = *(const unsigned*)(rp + 1024); rl[i] = *(const unsigned*)(rp + (2 + dir) * 1024);
                rp += step; asm volatile("" : "+v"(rp));
            }
        };
        __syncthreads();
        load_chunk(0);
        for (int ci = 0; ci < 36; ++ci) {
            const bool isc = ci < 4;
            {
                float run0 = 0.f, run1 = 0.f;
#pragma unroll
                for (int i = 0; i < 16; ++i) { run0 += bf_lo(rl[i]); run1 += bf_hi(rl[i]); }
                *(LAS f32x2*)(tot + qt * 128 + 2 * cp) = (f32x2){run0, run1};
#pragma unroll
                for (int hh = 0; hh < 2; ++hh) {
                    u32x4 a, c;
#pragma unroll
                    for (int u = 0; u < 4; ++u) { const int ip = 4 * hh + u;
                        a[u] = (rv[2 * ip] & 0xffffu) | (rv[2 * ip + 1] << 16); c[u] = (rv[2 * ip] >> 16) | (rv[2 * ip + 1] & 0xffff0000u); }
                    *(LAS u32x4*)(VT + (2 * cp) * 72 + 16 * qt + 8 * hh) = a;
                    *(LAS u32x4*)(VT + (2 * cp + 1) * 72 + 16 * qt + 8 * hh) = c;
                }
                __syncthreads();
                float pre0 = 0.f, pre1 = 0.f, all0 = 0.f, all1 = 0.f;
#pragma unroll
                for (int q = 0; q < 4; ++q) { const f32x2 tq = *(const LAS f32x2*)(tot + q * 128 + 2 * cp); if (q < qt) { pre0 += tq[0]; pre1 += tq[1]; } all0 += tq[0]; all1 += tq[1]; }
                if (qt == 0) *(LAS f32x2*)(dec + 2 * cp) = (f32x2){__expf(all0), __expf(all1)};
                float iebp0 = __expf(-pre0), iebp1 = __expf(-pre1);
                float bb0 = pre0, bb1 = pre1;
#pragma unroll
                for (int hh = 0; hh < 2; ++hh) {
                    u32x4 a, c;
#pragma unroll
                    for (int u4 = 0; u4 < 4; ++u4) {
                        float kin0[2], kin1[2];
#pragma unroll
                        for (int u = 0; u < 2; ++u) {
                            const int i = 8 * hh + 2 * u4 + u, t = 16 * qt + i;
                            bb0 += bf_lo(rl[i]); bb1 += bf_hi(rl[i]);
                            const float eb0 = __expf(bb0), eb1 = __expf(bb1), ieb0 = __expf(-bb0), ieb1 = __expf(-bb1);
                            const float k0 = 1.f - eb0 * iebp0, k1 = 1.f - eb1 * iebp1;
                            iebp0 = ieb0; iebp1 = ieb1;
                            kin0[u] = k0 * ieb0; kin1[u] = k1 * ieb1;
                            *(LAS unsigned*)(Qin + t * 136 + 2 * cp) = cvt_pk_bf16(bf_lo(rq[i]) * eb0, bf_hi(rq[i]) * eb1);
                            *(LAS unsigned*)(Kin + t * 136 + 2 * cp) = cvt_pk_bf16(kin0[u], kin1[u]);
                        }
                        a[u4] = cvt_pk_bf16(kin0[0], kin0[1]); c[u4] = cvt_pk_bf16(kin1[0], kin1[1]);
                    }
                    *(LAS u32x4*)(KinT + (2 * cp) * 72 + 16 * qt + 8 * hh) = a;
                    *(LAS u32x4*)(KinT + (2 * cp + 1) * 72 + 16 * qt + 8 * hh) = c;
                    __builtin_amdgcn_sched_barrier(0);
                }
            }
            __syncthreads();
            if (ci + 1 < 36) load_chunk(ci + 1);
            f32x4 sacc[4];
            if (!isc) {
                bf16x8 qf[4];
#pragma unroll
                for (int ks = 0; ks < 4; ++ks) qf[ks] = *(const LAS bf16x8*)(Qin + (16 * w + fr) * 136 + 32 * ks + 8 * fq);
#pragma unroll
                for (int ms = 0; ms < 4; ++ms) {
                    sacc[ms] = (f32x4){0.f, 0.f, 0.f, 0.f};
                    if (ms <= w) {
#pragma unroll
                        for (int ks = 0; ks < 4; ++ks) { const bf16x8 kf = *(const LAS bf16x8*)(Kin + (16 * ms + fr) * 136 + 32 * ks + 8 * fq);
                            sacc[ms] = __builtin_amdgcn_mfma_f32_16x16x32_bf16(kf, qf[ks], sacc[ms], 0, 0, 0); }
                    }
                }
            }
            __syncthreads();
            if (!isc) {
#pragma unroll
                for (int ms = 0; ms < 4; ++ms) {
                    f32x4 v = sacc[ms];
                    if (ms == w) {
#pragma unroll
                        for (int j = 0; j < 4; ++j) v[j] = (4 * fq + j <= fr) ? v[j] : 0.f;
                    }
                    u32x2 o; o.x = cvt_pk_bf16(v[0], v[1]); o.y = cvt_pk_bf16(v[2], v[3]);
                    *(LAS u32x2*)(Sc + (16 * w + fr) * 72 + 16 * ms + 4 * fq) = o;
                }
            }
            __syncthreads();
            __builtin_amdgcn_sched_barrier(0);
            bf16x8 vfrag[2][2];
#pragma unroll
            for (int n = 0; n < 2; ++n)
#pragma unroll
                for (int ks = 0; ks < 2; ++ks) vfrag[n][ks] = *(const LAS bf16x8*)(VT + (32 * w + 16 * n + fr) * 72 + 32 * ks + 8 * fq);
            if (!isc) {
                f32x4 oacc[2][4];
#pragma unroll
                for (int n = 0; n < 2; ++n)
#pragma unroll
                    for (int tt = 0; tt < 4; ++tt) oacc[n][tt] = (f32x4){0.f, 0.f, 0.f, 0.f};
#pragma unroll
                for (int kk = 0; kk < 4; ++kk) {
                    bf16x8 sf[2];
#pragma unroll
                    for (int n = 0; n < 2; ++n) {
                        u32x4 pk; pk.x = cvt_pk_bf16(Sacc[2 * kk][n][0], Sacc[2 * kk][n][1]); pk.y = cvt_pk_bf16(Sacc[2 * kk][n][2], Sacc[2 * kk][n][3]);
                        pk.z = cvt_pk_bf16(Sacc[2 * kk + 1][n][0], Sacc[2 * kk + 1][n][1]); pk.w = cvt_pk_bf16(Sacc[2 * kk + 1][n][2], Sacc[2 * kk + 1][n][3]);
                        sf[n] = __builtin_bit_cast(bf16x8, pk);
                    }
#pragma unroll
                    for (int tt = 0; tt < 4; ++tt) {
                        const LAS bf16_t* qp = Qin + (16 * tt + fr) * 136 + 32 * kk + 4 * fq;
                        const u32x2 lo = *(const LAS u32x2*)qp, hi = *(const LAS u32x2*)(qp + 16);
                        const bf16x8 qfr = __builtin_bit_cast(bf16x8, ((u32x4){lo.x, lo.y, hi.x, hi.y}));
#pragma unroll
                        for (int n = 0; n < 2; ++n) oacc[n][tt] = __builtin_amdgcn_mfma_f32_16x16x32_bf16(sf[n], qfr, oacc[n][tt], 0, 0, 0);
                    }
                }
                __builtin_amdgcn_sched_barrier(0);
#pragma unroll
                for (int tt = 0; tt < 4; ++tt)
#pragma unroll
                    for (int ks = 0; ks < 2; ++ks) {
                        if (ks == 1 && tt < 2) continue;
                        const bf16x8 scf = *(const LAS bf16x8*)(Sc + (16 * tt + fr) * 72 + 32 * ks + 8 * fq);
#pragma unroll
                        for (int n = 0; n < 2; ++n) oacc[n][tt] = __builtin_amdgcn_mfma_f32_16x16x32_bf16(vfrag[n][ks], scf, oacc[n][tt], 0, 0, 0);
                    }
                __builtin_amdgcn_sched_barrier(0);
#pragma unroll
                for (int tt = 0; tt < 4; ++tt) {
                    bf16_t* op = P + chunk_row(ci, 16 * tt + fr) * HG5 + (2 + dir) * 1024 + h * 128 + 32 * w + 4 * fq;
#pragma unroll
                    for (int n = 0; n < 2; ++n) { u32x2 o; o.x = cvt_pk_bf16(oacc[n][tt][0], oacc[n][tt][1]); o.y = cvt_pk_bf16(oacc[n][tt][2], oacc[n][tt][3]); *(u32x2*)(op + 16 * n) = o; }
                }
            }
            __builtin_amdgcn_sched_barrier(0);
#pragma unroll
            for (int m = 0; m < 8; ++m) {
#pragma unroll
                for (int ks = 0; ks < 2; ++ks) { const bf16x8 kf = *(const LAS bf16x8*)(KinT + (16 * m + fr) * 72 + 32 * ks + 8 * fq);
#pragma unroll
                    for (int n = 0; n < 2; ++n) Sacc[m][n] = __builtin_amdgcn_mfma_f32_16x16x32_bf16(kf, vfrag[n][ks], Sacc[m][n], 0, 0, 0); }
                const f32x4 dv = *(const LAS f32x4*)(dec + 16 * m + 4 * fq);
                Sacc[m][0] *= dv; Sacc[m][1] *= dv;
            }
            __syncthreads();
        }
        __threadfence(); __syncthreads(); __threadfence();
        {
            const int wid = tid >> 6, lane = tid & 63, sub = lane >> 4, l16 = lane & 15;
            const f32x4 w0 = *(const f32x4*)(normw + 8 * l16), w1 = *(const f32x4*)(normw + 8 * l16 + 4);
#pragma unroll 4
            for (int it = 0; it < 64; ++it) {
                const int t = it * 32 + wid * 4 + sub; const size_t row = (size_t)b * SEQ + t;
                const bf16_t* rp = P + row * HG5 + h * 128 + 8 * l16;
                const u32x4 of = *(const u32x4*)(rp + 2048), ob = *(const u32x4*)(rp + 3072), gg = *(const u32x4*)(rp + 4096);
                float o[8];
                o[0] = bf_lo(of.x) + bf_lo(ob.x); o[1] = bf_hi(of.x) + bf_hi(ob.x); o[2] = bf_lo(of.y) + bf_lo(ob.y); o[3] = bf_hi(of.y) + bf_hi(ob.y);
                o[4] = bf_lo(of.z) + bf_lo(ob.z); o[5] = bf_hi(of.z) + bf_hi(ob.z); o[6] = bf_lo(of.w) + bf_lo(ob.w); o[7] = bf_hi(of.w) + bf_hi(ob.w);
                float ss = 0.f;
#pragma unroll
                for (int i = 0; i < 8; ++i) ss += o[i] * o[i];
                ss += __shfl_xor(ss, 1); ss += __shfl_xor(ss, 2); ss += __shfl_xor(ss, 4); ss += __shfl_xor(ss, 8);
                const float rs = __builtin_amdgcn_rsqf(ss * (1.f / 128.f) + RMS_EPS);
                u32x4 r;
                r.x = cvt_pk_bf16(o[0] * rs * w0[0] * bf_lo(gg.x), o[1] * rs * w0[1] * bf_hi(gg.x));
                r.y = cvt_pk_bf16(o[2] * rs * w0[2] * bf_lo(gg.y), o[3] * rs * w0[3] * bf_hi(gg.y));
                r.z = cvt_pk_bf16(o[4] * rs * w1[0] * bf_lo(gg.z), o[5] * rs * w1[1] * bf_hi(gg.z));
                r.w = cvt_pk_bf16(o[6] * rs * w1[2] * bf_lo(gg.w), o[7] * rs * w1[3] * bf_hi(gg.w));
                *(u32x4*)(R + row * D + h * 128 + 8 * l16) = r;
            }
        }
        __syncthreads();
    }
}

__device__ __forceinline__ void cm_gate_phase(const Params& p, LAS unsigned char* lds) {
    const int tid = opaque_tid(), wid = tid >> 6, lane = tid & 63, fr = lane & 15, fq = lane >> 4;
    bf16_t* UV = (bf16_t*)(p.ws + WS_BIG);
    const float* vg = p.in[15]; const float* vb = p.in[16]; const float* bs = p.in[18];
    const bf16_t* WSB = (const bf16_t*)(p.ws + WS_WSB);
    LAS bf16_t* Wl = (LAS bf16_t*)lds; LAS bf16_t* Vl = (LAS bf16_t*)(lds + 34816); LAS float* st = (LAS float*)(lds + 34816 + 100352); LAS float* bl = st + 256;
    const int c8 = lane < 48 ? lane : 47;
    for (int ch = blockIdx.x; ch < MX / 128; ch += gridDim.x) {
        const size_t row0 = (size_t)ch * 128;
        __syncthreads();
        for (int rr = 0; rr < 8; ++rr) {
            const int r = wid * 16 + 2 * rr; const bf16_t* vp = UV + (row0 + r) * 6144 + 3072;
            u32x4 x[2][6]; float s[2] = {0.f, 0.f};
#pragma unroll
            for (int q = 0; q < 2; ++q)
#pragma unroll
                for (int i = 0; i < 6; ++i) x[q][i] = *(const u32x4*)(vp + (size_t)q * 6144 + (i * 64 + lane) * 8);
#pragma unroll
            for (int q = 0; q < 2; ++q)
#pragma unroll
                for (int i = 0; i < 6; ++i) s[q] += (bf_lo(x[q][i].x) + bf_hi(x[q][i].x)) + (bf_lo(x[q][i].y) + bf_hi(x[q][i].y)) + (bf_lo(x[q][i].z) + bf_hi(x[q][i].z)) + (bf_lo(x[q][i].w) + bf_hi(x[q][i].w));
            float mean[2], s2[2] = {0.f, 0.f};
#pragma unroll
            for (int q = 0; q < 2; ++q) mean[q] = wave_sum(s[q]) * (1.f / 3072.f);
#pragma unroll
            for (int q = 0; q < 2; ++q)
#pragma unroll
                for (int i = 0; i < 6; ++i) { float d;
                    d = bf_lo(x[q][i].x) - mean[q]; s2[q] += d * d; d = bf_hi(x[q][i].x) - mean[q]; s2[q] += d * d; d = bf_lo(x[q][i].y) - mean[q]; s2[q] += d * d; d = bf_hi(x[q][i].y) - mean[q]; s2[q] += d * d;
                    d = bf_lo(x[q][i].z) - mean[q]; s2[q] += d * d; d = bf_hi(x[q][i].z) - mean[q]; s2[q] += d * d; d = bf_lo(x[q][i].w) - mean[q]; s2[q] += d * d; d = bf_hi(x[q][i].w) - mean[q]; s2[q] += d * d; }
#pragma unroll
            for (int q = 0; q < 2; ++q) { const float rstd = __builtin_amdgcn_rsqf(wave_sum(s2[q]) * (1.f / 3072.f) + LN_EPS); if (lane == 0) { st[2 * (r + q)] = mean[q]; st[2 * (r + q) + 1] = rstd; } }
        }
        for (int g = 0; g < 8; ++g) {
            __syncthreads();
#pragma unroll
            for (int i = 0; i < 4; ++i) { const int idx = tid + NTHREADS * i, r = idx >> 4, cc = idx & 15;
                *(LAS u32x4*)(Wl + r * 136 + cc * 8) = *(const u32x4*)(WSB + (size_t)g * 16384 + r * 128 + cc * 8); }
            if (tid < 128) bl[tid] = bs[g * 128 + tid];
            {
                const float* gp = vg + g * 384 + c8 * 8; const float* bp = vb + g * 384 + c8 * 8;
                const f32x4 g0 = *(const f32x4*)gp, g1 = *(const f32x4*)(gp + 4), b0 = *(const f32x4*)bp, b1 = *(const f32x4*)(bp + 4);
                const bf16_t* xp = UV + (row0 + wid) * 6144 + 3072 + g * 384 + c8 * 8;
#pragma unroll
                for (int hb = 0; hb < 2; ++hb) {
                    u32x4 xv[8];
#pragma unroll
                    for (int i = 0; i < 8; ++i) { xv[i] = *(const u32x4*)xp; xp += 8 * 6144; asm volatile("" : "+v"(xp)); }
#pragma unroll
                    for (int i = 0; i < 8; ++i) { const int sr = wid + 8 * (8 * hb + i);
                        const f32x2 ms = *(const LAS f32x2*)(st + 2 * sr); const float mean = ms[0], rstd = ms[1]; const u32x4 x = xv[i];
                        u32x4 o;
                        o.x = cvt_pk_bf16((bf_lo(x.x) - mean) * rstd * g0[0] + b0[0], (bf_hi(x.x) - mean) * rstd * g0[1] + b0[1]);
                        o.y = cvt_pk_bf16((bf_lo(x.y) - mean) * rstd * g0[2] + b0[2], (bf_hi(x.y) - mean) * rstd * g0[3] + b0[3]);
                        o.z = cvt_pk_bf16((bf_lo(x.z) - mean) * rstd * g1[0] + b1[0], (bf_hi(x.z) - mean) * rstd * g1[1] + b1[1]);
                        o.w = cvt_pk_bf16((bf_lo(x.w) - mean) * rstd * g1[2] + b1[2], (bf_hi(x.w) - mean) * rstd * g1[3] + b1[3]);
                        if (lane < 48) *(LAS u32x4*)(Vl + sr * 392 + c8 * 8) = o; }
                }
            }
            __syncthreads();
            u32x2 uu[8][3];
            { const bf16_t* up = UV + (row0 + fr) * 6144 + g * 384 + wid * 48 + 4 * fq;
#pragma unroll
            for (int m = 0; m < 8; ++m) {
#pragma unroll
                for (int n = 0; n < 3; ++n) uu[m][n] = *(const u32x2*)(up + n * 16);
                up += 16 * 6144; asm volatile("" : "+v"(up)); } }
            f32x4 acc[3][8];
#pragma unroll
            for (int n = 0; n < 3; ++n)
#pragma unroll
                for (int m = 0; m < 8; ++m) acc[n][m] = (f32x4){0.f, 0.f, 0.f, 0.f};
#pragma unroll 1
            for (int ks = 0; ks < 4; ++ks) {
                bf16x8 af[3];
#pragma unroll
                for (int n = 0; n < 3; ++n) {
                    const LAS bf16_t* vp = Vl + (32 * ks + 8 * fq) * 392 + wid * 48 + n * 16 + fr;
#pragma unroll
                    for (int i = 0; i < 8; ++i) af[n][i] = (short)vp[i * 392];
                }
#pragma unroll
                for (int m = 0; m < 8; ++m) {
                    const bf16x8 bfrag = *(const LAS bf16x8*)(Wl + (16 * m + fr) * 136 + 32 * ks + 8 * fq);
#pragma unroll
                    for (int n = 0; n < 3; ++n) acc[n][m] = __builtin_amdgcn_mfma_f32_16x16x32_bf16(af[n], bfrag, acc[n][m], 0, 0, 0);
                    if (m & 1) __builtin_amdgcn_sched_barrier(0);
                }
            }
            bf16_t* zp = UV + (row0 + fr) * 6144 + g * 384 + wid * 48 + 4 * fq;
#pragma unroll
            for (int m = 0; m < 8; ++m) {
                const float bias = bl[16 * m + fr];
#pragma unroll
                for (int n = 0; n < 3; ++n) {
                    const u32x2 u2 = uu[m][n];
                    u32x2 o; o.x = cvt_pk_bf16(bf_lo(u2.x) * (acc[n][m][0] + bias), bf_hi(u2.x) * (acc[n][m][1] + bias));
                    o.y = cvt_pk_bf16(bf_lo(u2.y) * (acc[n][m][2] + bias), bf_hi(u2.y) * (acc[n][m][3] + bias));
                    *(u32x2*)(zp + n * 16) = o;
                }
                zp += 16 * 6144; asm volatile("" : "+v"(zp));
            }
        }
    }
}

#ifndef EN_MASK
#define EN_MASK 255
#endif
constexpr int EN = EN_MASK;
__global__ void __launch_bounds__(NTHREADS, 2) fwd_megakernel(Params p) {
    extern __shared__ __attribute__((aligned(16))) unsigned char lds_raw[];
    LAS unsigned char* lds = (LAS unsigned char*)lds_raw;
    cg::grid_group grid = cg::this_grid();
    volatile LAS unsigned* xst = (volatile LAS unsigned*)(lds + LDS_BYTES - 16);
    if (threadIdx.x == 0) { xst[0] = 0u; xst[1] = 0u; }
    XcdBarrier xb; xb.bar = (unsigned*)(p.ws + WS_BAR); xb.x = 0; xb.st = xst;
    const float* x_in = p.in[0]; const float* ctx_in = p.in[2];
    const float* mod0 = (const float*)(p.ws + WS_MOD); const float* mod1 = mod0 + (size_t)33 * 9216;
    const float* lbv = (const float*)(p.ws + WS_LB);
    const float* ln_g = p.in[6]; const float* ln_b = p.in[7];
    bf16_t* A0 = (bf16_t*)(p.ws + WS_A0); bf16_t* BIG = (bf16_t*)(p.ws + WS_BIG);
    const bf16_t* FIN = (const bf16_t*)(p.ws + WS_FIN); const bf16_t* FOUT = (const bf16_t*)(p.ws + WS_FOUT);
    const bf16_t* HIN = (const bf16_t*)(p.ws + WS_HIN); const bf16_t* HOUT = (const bf16_t*)(p.ws + WS_HOUT);
    const bf16_t* CIN = (const bf16_t*)(p.ws + WS_CIN); const bf16_t* COUT = (const bf16_t*)(p.ws + WS_COUT);
    const size_t FIN_SZ = (size_t)5632 * 1024, FOUT_SZ = (size_t)1024 * 2816;
    for (int ph = p.ph_lo; ph < p.ph_hi; ++ph) {
        int kind;
        switch (ph) {
        case 0: kind = 0; break;
        case 1: case 4: case 8: case 11: case 14: case 18: case 21: kind = 1; break;
        case 2: case 9: case 12: case 19: kind = 2; break;
        case 3: case 7: case 10: case 13: case 17: case 20: kind = 3; break;
        case 5: kind = 4; break;
        case 6: kind = 5; break;
        case 15: kind = 6; break;
        default: kind = 7; break;
        }
        if (kind == 0) { if (EN & 1) phase0(p, lds); }
        else if (kind == 1) {
            RowArgs a;
            a.xs_x = p.out; a.xs_c = nullptr; a.nrows = MX; a.y = A0; a.ysc = 0.5f; a.xd = p.out; a.hd = A0;
            if (ph == 1) { a.xs_x = x_in; a.xs_c = ctx_in; a.nrows = MT; a.y = nullptr; a.m = mod0; a.k = 0; a.g = ln_g; a.b = ln_b; a.m2 = mod0; a.k2 = 0; }
            else if (ph == 4) { a.xs_x = x_in; a.xs_c = ctx_in; a.nrows = MT; a.m = mod0; a.k = 0; a.g = ln_g + 0 * D; a.b = ln_b + 0 * D; a.m2 = mod0; a.k2 = 1; }
            else if (ph == 8) { a.y = BIG; a.ysc = 1.f; a.m = mod0; a.k = 1; a.g = ln_g + 1 * D; a.b = ln_b + 1 * D; a.m2 = mod0; a.k2 = 2; }
            else if (ph == 11) { a.m = mod0; a.k = 2; a.g = ln_g + 2 * D; a.b = ln_b + 2 * D; a.m2 = mod1; a.k2 = 0; }
            else if (ph == 14) { a.m = mod1; a.k = 0; a.g = ln_g + 3 * D; a.b = ln_b + 3 * D; a.m2 = mod1; a.k2 = 1; }
            else if (ph == 18) { a.ysc = 1.f; a.m = mod1; a.k = 1; a.g = ln_g + 4 * D; a.b = ln_b + 4 * D; a.m2 = mod1; a.k2 = 2; }
            else { a.m = mod1; a.k = 2; a.g = ln_g + 5 * D; a.b = ln_b + 5 * D; a.hd = nullptr; a.m2 = mod1; a.k2 = 0; }
            if (EN & 2) row_phase(a);
        } else if (kind == 2) {
            const int wi = ph == 2 ? 0 : (ph == 9 ? 1 : (ph == 12 ? 2 : 3));
            if (EN & 4) run_gemm<1>(lds, A0, D, FIN + wi * FIN_SZ, ph == 2 ? MT : MX, 2 * FH, D, BIG, FH, nullptr);
        } else if (kind == 3) {
            const bf16_t* A = BIG; int lda = FH, M = MX, K = FH; const bf16_t* Bt; bf16_t* O = A0;
            if (ph == 3) { Bt = FOUT; M = MT; }
            else if (ph == 7) { A = A0; lda = D; K = D; Bt = HOUT; O = BIG; }
            else if (ph == 10) Bt = FOUT + 1 * FOUT_SZ;
            else if (ph == 13) Bt = FOUT + 2 * FOUT_SZ;
            else if (ph == 17) { lda = 2 * CMI; K = CMI; Bt = COUT; }
            else Bt = FOUT + 3 * FOUT_SZ;
            if (EN & 8) run_gemm<0>(lds, A, lda, Bt, M, D, K, O, D, nullptr);
        } else if (kind == 4) { if (EN & 16) run_gemm<2>(lds, A0, D, HIN, MT, HG5, D, BIG, HG5, lbv); }
        else if (kind == 5) { if (EN & 32) gla_phase(p, lds); }
        else if (kind == 6) { if (EN & 64) run_gemm<3>(lds, A0, D, CIN, MX, 2 * CMI, D, BIG, 2 * CMI, nullptr); }
        else { if (EN & 128) cm_gate_phase(p, lds); }
        if (ph + 1 < p.ph_hi) {
            if (ph == 0) { grid.sync(); xb = xcd_barrier_post((unsigned*)(p.ws + WS_BAR), xst); }
            else xcd_barrier(xb);
        }
    }
}

extern "C" void kernel_launch(void* const* d_in, const int* in_sizes, int n_in, void* d_out, int out_size, void* d_ws, size_t ws_size, hipStream_t stream) {
    static int grid_blocks = 0;
    if (grid_blocks == 0) {
        if (n_in != 20 || out_size != MX * D || ws_size < WS_END) { fprintf(stderr, "kernel_launch: unexpected shapes (n_in %d out %d ws %zu need %zu)\n", n_in, out_size, ws_size, (size_t)WS_END); grid_blocks = -1; return; }
        int dev = 0, cus = 0, per_cu = 0;
        hipGetDevice(&dev);
        hipDeviceGetAttribute(&cus, hipDeviceAttributeMultiprocessorCount, dev);
        if (hipFuncSetAttribute((const void*)fwd_megakernel, hipFuncAttributeMaxDynamicSharedMemorySize, LDS_BYTES) != hipSuccess) { fprintf(stderr, "kernel_launch: hipFuncSetAttribute failed\n"); grid_blocks = -1; return; }
        if (hipOccupancyMaxActiveBlocksPerMultiprocessor(&per_cu, (const void*)fwd_megakernel, NTHREADS, LDS_BYTES) != hipSuccess || per_cu < 1) { fprintf(stderr, "kernel_launch: occupancy query says %d\n", per_cu); per_cu = 1; }
        (void)hipGetLastError();
        grid_blocks = cus * 1;
    }
    if (grid_blocks < 0) return;
    Params p{};
    for (int i = 0; i < 20; ++i) p.in[i] = (const float*)d_in[i];
    p.out = (float*)d_out; p.ws = (unsigned char*)d_ws; p.ph_lo = 0; p.ph_hi = 22;
    void* args[] = {&p};
    hipError_t e = hipLaunchCooperativeKernel((const void*)fwd_megakernel, dim3(grid_blocks), dim3(NTHREADS), args, LDS_BYTES, stream);
    if (e != hipSuccess) fprintf(stderr, "cooperative launch failed: %s (grid %d)\n", hipGetErrorString(e), grid_blocks);
}
```

```cpp
#include <hip/hip_runtime.h>
#include <hip/hip_cooperative_groups.h>
#include <cstdio>
#include <cstdint>
namespace cg = cooperative_groups;

#define LAS __attribute__((address_space(3)))
typedef unsigned short bf16_t;
typedef short bf16x8 __attribute__((ext_vector_type(8)));
typedef float f32x4 __attribute__((ext_vector_type(4)));
typedef float f32x2 __attribute__((ext_vector_type(2)));
typedef unsigned u32x4 __attribute__((ext_vector_type(4)));
typedef unsigned u32x2 __attribute__((ext_vector_type(2)));

constexpr int D = 1024, NB = 32, SEQ = 2048, CTXL = 256;
constexpr int MX = NB * SEQ;
constexpr int MC = NB * CTXL;
constexpr int MT = MX + MC;
constexpr int FH = 2816, HG5 = 5 * D, CMI = 3072, NMOD = 9;
constexpr float DN_ALPHA = 1.41421356237309515f;
constexpr float LN_EPS = 1e-5f, RMS_EPS = 1e-6f;
constexpr int LDS_BYTES = 149504;
constexpr int NTHREADS = 512;

constexpr size_t WS_MOD = 0;
constexpr size_t WS_LB = WS_MOD + (size_t)2 * 33 * 9216 * 4;
constexpr size_t WS_BAR = WS_LB + 2 * 1024 * 4;
constexpr size_t WS_FIN = WS_BAR + 4096 * 4;
constexpr size_t WS_FOUT = WS_FIN + (size_t)4 * 5632 * 1024 * 2;
constexpr size_t WS_HIN = WS_FOUT + (size_t)4 * 1024 * 2816 * 2;
constexpr size_t WS_HOUT = WS_HIN + (size_t)5120 * 1024 * 2;
constexpr size_t WS_CIN = WS_HOUT + (size_t)1024 * 1024 * 2;
constexpr size_t WS_COUT = WS_CIN + (size_t)6144 * 1024 * 2;
constexpr size_t WS_WSB = WS_COUT + (size_t)1024 * 3072 * 2;
constexpr size_t WS_A0 = WS_WSB + (size_t)8 * 128 * 128 * 2;
constexpr size_t WS_BIG = WS_A0 + (size_t)MT * 1024 * 2;
constexpr size_t WS_END = WS_BIG + (size_t)MX * 6144 * 2;

struct Params {
    const float* in[20];
    float* out;
    unsigned char* ws;
    int ph_lo, ph_hi;
};

__device__ __forceinline__ unsigned cvt_pk_bf16(float lo, float hi) { unsigned r; asm volatile("v_cvt_pk_bf16_f32 %0, %1, %2" : "=v"(r) : "v"(lo), "v"(hi)); return r; }
__device__ __forceinline__ int opaque_tid() { int t = threadIdx.x; asm volatile("" : "+v"(t)); return t; }
__device__ __forceinline__ float bf_lo(unsigned u) { return __uint_as_float(u << 16); }
__device__ __forceinline__ float bf_hi(unsigned u) { return __uint_as_float(u & 0xffff0000u); }
__device__ __forceinline__ float wave_sum(float v) {
#pragma unroll
    for (int o = 1; o < 64; o <<= 1) v += __shfl_xor(v, o);
    return v;
}
__device__ __forceinline__ float sigmoid_f(float x) { return __builtin_amdgcn_rcpf(1.f + __expf(-x)); }
__device__ __forceinline__ float silu_f(float x) { return x * sigmoid_f(x); }
__device__ __forceinline__ float gelu_tanh_f(float x) { const float u = 0.7978845608028654f * (x + 0.044715f * x * x * x); return x * sigmoid_f(2.f * u); }

namespace pg8 {
constexpr int BM = 256, BK = 64, HALF = 128, HTB = HALF * BK * 2, STAGE_BYTES = 8 * HTB, NXCD = 8, WGM = 8;
__host__ __device__ __forceinline__ int lds_byte(int r, int c) { const int st = (r >> 4) * 2 + (c >> 5), rr = r & 15, cc = c & 31, ob = rr * 64 + cc * 2; return st * 1024 + (ob ^ (((ob >> 9) & 1) << 5)); }
__host__ __device__ __forceinline__ void stage_rc(int b, int& R, int& C) { const int st = b / 1024, sb = b % 1024, swz = sb ^ (((sb >> 9) & 1) << 5); R = (st >> 1) * 16 + swz / 64; C = (st & 1) * 32 + (swz % 64) / 2; }
__host__ __device__ __forceinline__ int perm32(int rho) { const int n = rho >> 4, i = rho & 15; return 8 * (i >> 2) + 4 * n + (i & 3); }

struct Unit { int pm, pn; };
struct Gemm { const bf16_t* A; int lda; const bf16_t* Bt; int M, N, K; };

struct StaticOrder {
    int nM, nN, nwg, G, c;
    __device__ void init(int M, int N, int G_, int c_) { nM = M / BM; nN = N / BM; nwg = nM * nN; G = G_; c = c_; }
    __device__ bool next(int i, Unit& u) const {
        const long L = (long)i * G + c; if (L >= nwg) return false;
        int wgid = (int)L; { const int q = nwg / NXCD, r = nwg % NXCD, xcd = wgid % NXCD, off = wgid / NXCD; wgid = (xcd < r ? xcd * (q + 1) : r * (q + 1) + (xcd - r) * q) + off; }
        const int nig = WGM * nN, gid = wgid / nig, fm = gid * WGM, gsz = (nM - fm) < WGM ? (nM - fm) : WGM;
        u.pm = fm + ((wgid % nig) % gsz); u.pn = (wgid % nig) / gsz; return true;
    }
};

template <int MODE> struct Epi {
    bf16_t* O; int ldo; const float* lb;
    __device__ __forceinline__ void operator()(const f32x4 (&acc)[2][2][4][2], const Unit& u, int wr, int wc, int fr, int fq) const {
        const int row0 = u.pm * BM + wr * 64 + fr;
        if constexpr (MODE == 1) {
            const int col0 = u.pn * 128 + wc * 32 + 8 * fq;
#pragma unroll
            for (int ai = 0; ai < 2; ++ai)
#pragma unroll
                for (int m = 0; m < 4; ++m) {
                    const f32x4 g0 = acc[ai][0][m][0], g1 = acc[ai][0][m][1], u0 = acc[ai][1][m][0], u1 = acc[ai][1][m][1];
                    u32x4 o;
                    o.x = cvt_pk_bf16(silu_f(g0[0]) * u0[0], silu_f(g0[1]) * u0[1]);
                    o.y = cvt_pk_bf16(silu_f(g0[2]) * u0[2], silu_f(g0[3]) * u0[3]);
                    o.z = cvt_pk_bf16(silu_f(g1[0]) * u1[0], silu_f(g1[1]) * u1[1]);
                    o.w = cvt_pk_bf16(silu_f(g1[2]) * u1[2], silu_f(g1[3]) * u1[3]);
                    *(u32x4*)(O + (size_t)(row0 + ai * HALF + m * 16) * ldo + col0) = o;
                    __builtin_amdgcn_sched_barrier(0);
                }
        } else {
            const int seg = u.pn >> 2;
#pragma unroll
            for (int bj = 0; bj < 2; ++bj) {
                const int col0 = u.pn * BM + bj * HALF + wc * 32 + 8 * fq;
                f32x4 l0 = {0.f, 0.f, 0.f, 0.f}, l1 = {0.f, 0.f, 0.f, 0.f};
                if (MODE == 2 && (seg == 2 || seg == 3)) { const float* lp = lb + (seg - 2) * 1024 + (col0 & 1023); l0 = *(const f32x4*)lp; l1 = *(const f32x4*)(lp + 4); }
#pragma unroll
                for (int ai = 0; ai < 2; ++ai)
#pragma unroll
                    for (int m = 0; m < 4; ++m) {
                        f32x4 v0 = acc[ai][bj][m][0], v1 = acc[ai][bj][m][1];
                        if constexpr (MODE == 3) {
#pragma unroll
                            for (int i = 0; i < 4; ++i) { v0[i] = gelu_tanh_f(v0[i]); v1[i] = gelu_tanh_f(v1[i]); }
                        }
                        if constexpr (MODE == 2) {
                            if (seg == 0 || seg == 4) {
#pragma unroll
                                for (int i = 0; i < 4; ++i) { v0[i] = silu_f(v0[i]); v1[i] = silu_f(v1[i]); }
                            } else if (seg >= 2) {
#pragma unroll
                                for (int i = 0; i < 4; ++i) {
                                    v0[i] = __logf(l0[i] + (1.f - l0[i]) * sigmoid_f(v0[i]));
                                    v1[i] = __logf(l1[i] + (1.f - l1[i]) * sigmoid_f(v1[i]));
                                }
                            }
                        }
                        u32x4 o;
                        o.x = cvt_pk_bf16(v0[0], v0[1]); o.y = cvt_pk_bf16(v0[2], v0[3]); o.z = cvt_pk_bf16(v1[0], v1[1]); o.w = cvt_pk_bf16(v1[2], v1[3]);
                        *(u32x4*)(O + (size_t)(row0 + ai * HALF + m * 16) * ldo + col0) = o;
                        __builtin_amdgcn_sched_barrier(0);
                    }
            }
        }
    }
};

template <class EpiT>
__device__ __forceinline__ void gemm_phase(LAS unsigned char* lds, const Gemm g, const StaticOrder& S, const EpiT& E) {
    const int tid = opaque_tid(), wid = __builtin_amdgcn_readfirstlane(tid >> 6), lane = tid & 63, wr = wid >> 2, wc = wid & 3, fr = lane & 15, fq = lane >> 4;
    const int K = g.K, nt = K / BK, lda = g.lda;
    unsigned voffA[2], voffB[2];
#pragma unroll
    for (int i = 0; i < 2; ++i) { int R, C; stage_rc(tid * 16 + i * 8192, R, C); const int Rb = (R & ~31) + perm32(R & 31);
        voffA[i] = (unsigned)(R * lda + C) * 2u; voffB[i] = (unsigned)(Rb * K + C) * 2u; }
    const size_t kstep = (size_t)(BK * 2);
    const size_t hstepA = (size_t)HALF * lda * 2, hstepB = (size_t)HALF * K * 2;
    const size_t tstepA = 2 * hstepA, tstepB = 2 * hstepB;
    const unsigned ldsw = (unsigned)wid * 1024u;
    const int aoff = lds_byte(wr * 64 + fr, fq * 8), boff = lds_byte(wc * 32 + fr, fq * 8);
#define PG8_SA(b, h) (((b) * 2 + (h)) * HTB)
#define PG8_SB(b, h) ((4 + (b) * 2 + (h)) * HTB)
#define PG8_STAGE(bufoff, gbase, voff) do { _Pragma("unroll") for (int _i = 0; _i < 2; ++_i) \
        __builtin_amdgcn_global_load_lds((const unsigned*)((const char*)(gbase) + (voff)[_i]), (LAS unsigned*)(lds + (bufoff) + ldsw + _i * 8192), 16, 0, 0); } while (0)
#define PG8_LDA(dst, b, h) do { _Pragma("unroll") for (int m = 0; m < 4; ++m) _Pragma("unroll") for (int k = 0; k < 2; ++k) dst[m][k] = *(const LAS bf16x8*)(lds + PG8_SA(b, h) + aoff + m * 2048 + k * 1024); } while (0)
#define PG8_LDB(dst, b, h) do { _Pragma("unroll") for (int n = 0; n < 2; ++n) _Pragma("unroll") for (int k = 0; k < 2; ++k) dst[n][k] = *(const LAS bf16x8*)(lds + PG8_SB(b, h) + boff + n * 2048 + k * 1024); } while (0)
#define PG8_MMA(ai, bj, At, Bt) do { __builtin_amdgcn_s_setprio(1); _Pragma("unroll") for (int m = 0; m < 4; ++m) _Pragma("unroll") for (int n = 0; n < 2; ++n) _Pragma("unroll") for (int k = 0; k < 2; ++k) \
        acc[ai][bj][m][n] = __builtin_amdgcn_mfma_f32_16x16x32_bf16(Bt[n][k], At[m][k], acc[ai][bj][m][n], 0, 0, 0); __builtin_amdgcn_s_setprio(0); } while (0)
#define PG8_WAIT_V(n) asm volatile("s_waitcnt vmcnt(" #n ")" ::: "memory")
#define PG8_WAIT_L(n) asm volatile("s_waitcnt lgkmcnt(" #n ")" ::: "memory")
#define PG8_BAR __builtin_amdgcn_s_barrier()
#define PG8_SCHED __builtin_amdgcn_sched_barrier(0)
    Unit cur, nxt; int ui = 0;
    if (!S.next(0, cur)) return;
    f32x4 acc[2][2][4][2];
#pragma unroll
    for (int a = 0; a < 2; ++a)
#pragma unroll
        for (int b = 0; b < 2; ++b)
#pragma unroll
            for (int m = 0; m < 4; ++m)
#pragma unroll
                for (int n = 0; n < 2; ++n) acc[a][b][m][n] = (f32x4){0.f, 0.f, 0.f, 0.f};
    bf16x8 At[4][2], B0[2][2], B1[2][2];
    const char* cA = (const char*)g.A + (size_t)cur.pm * tstepA; const char* cB = (const char*)g.Bt + (size_t)cur.pn * tstepB;
    PG8_STAGE(PG8_SB(0, 0), cB, voffB); PG8_STAGE(PG8_SA(0, 0), cA, voffA); PG8_STAGE(PG8_SB(0, 1), cB + hstepB, voffB); PG8_STAGE(PG8_SA(0, 1), cA + hstepA, voffA);
    if (wr == 1) PG8_BAR;
    PG8_WAIT_V(4); PG8_BAR;
    PG8_STAGE(PG8_SB(1, 0), cB + kstep, voffB); PG8_STAGE(PG8_SA(1, 0), cA + kstep, voffA); PG8_STAGE(PG8_SB(1, 1), cB + hstepB + kstep, voffB);
    PG8_WAIT_V(6); PG8_BAR;
    for (;;) {
        const bool has_next = S.next(ui + 1, nxt);
        const char* nA = has_next ? (const char*)g.A + (size_t)nxt.pm * tstepA : cA; const char* nB = has_next ? (const char*)g.Bt + (size_t)nxt.pn * tstepB : cB;
        for (int t = 0; t < nt; t += 2) {
            const bool last = (t == nt - 2);
            const char* a1 = cA + (size_t)(t + 1) * kstep;
            const char* a2 = last ? nA : cA + (size_t)(t + 2) * kstep; const char* b2 = last ? nB : cB + (size_t)(t + 2) * kstep;
            const char* a3 = a2 + kstep; const char* b3 = b2 + kstep;
            PG8_LDB(B0, 0, 0); PG8_SCHED; PG8_LDA(At, 0, 0); PG8_STAGE(PG8_SA(1, 1), a1 + hstepA, voffA);
            PG8_WAIT_L(8); PG8_BAR; PG8_WAIT_L(0); PG8_MMA(0, 0, At, B0); PG8_BAR; PG8_SCHED;
            PG8_LDB(B1, 0, 1); PG8_STAGE(PG8_SB(0, 0), b2, voffB);
            PG8_BAR; PG8_WAIT_L(0); PG8_MMA(0, 1, At, B1); PG8_BAR;
            PG8_LDA(At, 0, 1); PG8_STAGE(PG8_SA(0, 0), a2, voffA);
            PG8_BAR; PG8_WAIT_L(0); PG8_MMA(1, 0, At, B0); PG8_BAR; PG8_SCHED;
            PG8_STAGE(PG8_SB(0, 1), b2 + hstepB, voffB);
            PG8_WAIT_V(6); PG8_BAR; PG8_MMA(1, 1, At, B1); PG8_BAR;
            PG8_LDB(B0, 1, 0); PG8_SCHED; PG8_LDA(At, 1, 0); PG8_STAGE(PG8_SA(0, 1), a2 + hstepA, voffA);
            PG8_WAIT_L(8); PG8_BAR; PG8_WAIT_L(0); PG8_MMA(0, 0, At, B0); PG8_BAR; PG8_SCHED;
            PG8_LDB(B1, 1, 1); PG8_STAGE(PG8_SB(1, 0), b3, voffB);
            PG8_BAR; PG8_WAIT_L(0); PG8_MMA(0, 1, At, B1); PG8_BAR;
            PG8_LDA(At, 1, 1); PG8_STAGE(PG8_SA(1, 0), a3, voffA);
            PG8_BAR; PG8_WAIT_L(0); PG8_MMA(1, 0, At, B0); PG8_BAR; PG8_SCHED;
            PG8_STAGE(PG8_SB(1, 1), b3 + hstepB, voffB);
            PG8_WAIT_V(6); PG8_BAR; PG8_MMA(1, 1, At, B1); PG8_BAR;
        }
        E(acc, cur, wr, wc, fr, fq);
        if (!has_next) break;
#pragma unroll
        for (int a = 0; a < 2; ++a)
#pragma unroll
            for (int b = 0; b < 2; ++b)
#pragma unroll
                for (int m = 0; m < 4; ++m)
#pragma unroll
                    for (int n = 0; n < 2; ++n) acc[a][b][m][n] = (f32x4){0.f, 0.f, 0.f, 0.f};
        cur = nxt; cA = nA; cB = nB; ++ui;
    }
    PG8_WAIT_V(0);
    if (wr == 0) PG8_BAR;
    PG8_BAR;
#undef PG8_SA
#undef PG8_SB
#undef PG8_STAGE
#undef PG8_LDA
#undef PG8_LDB
#undef PG8_MMA
#undef PG8_WAIT_V
#undef PG8_WAIT_L
#undef PG8_BAR
#undef PG8_SCHED
}
}

template <int MODE>
__device__ __forceinline__ void run_gemm(LAS unsigned char* lds, const bf16_t* A, int lda, const bf16_t* Bt, int M, int N, int K, bf16_t* O, int ldo, const float* lb) {
    pg8::Gemm g{A, lda, Bt, M, N, K};
    pg8::StaticOrder S; S.init(M, N, gridDim.x, blockIdx.x);
    pg8::Epi<MODE> E{O, ldo, lb};
    pg8::gemm_phase(lds, g, S, E);
}

#define XB_TMO      128
#define XB_XCNT(j)  (256  + 64 * (j))
#define XB_XSUB(j)  (1280 + 64 * (j))
#define XB_XGEN(j)  (2304 + 64 * (j))
#define XB_TOP      3328
#define XB_TOPGEN   3392
#define XCD_BAR_WORDS 3456
#define XB_SPIN_CAP (1u << 22)
__device__ __forceinline__ unsigned xb_ld(unsigned* p)              { return __hip_atomic_load(p, __ATOMIC_RELAXED, __HIP_MEMORY_SCOPE_AGENT); }
__device__ __forceinline__ unsigned xb_add(unsigned* p, unsigned v) { return __hip_atomic_fetch_add(p, v, __ATOMIC_RELAXED, __HIP_MEMORY_SCOPE_AGENT); }
__device__ __forceinline__ unsigned xb_xcc_id() { return (unsigned)__builtin_amdgcn_s_getreg((3 << 11) | 20) & 0xFu; }
#define XB_SPIN(cond, bar) do { unsigned _sp = 0; while (cond) { __builtin_amdgcn_s_sleep(1); \
    if ((++_sp & 255u) == 0u) { if (xb_ld(&(bar)[XB_TMO])) break; if (_sp > XB_SPIN_CAP) { atomicAdd(&(bar)[XB_TMO], 1u); break; } } } } while (0)
struct XcdBarrier { unsigned* bar; unsigned x; volatile LAS unsigned* st; };
__device__ __forceinline__ XcdBarrier xcd_barrier_post(unsigned* bar, volatile LAS unsigned* st) {
    XcdBarrier b; b.bar = bar; b.x = xb_xcc_id(); b.st = st;
    if (threadIdx.x == 0) (void)xb_add(&bar[XB_XCNT(b.x)], 1u);
    return b;
}
__device__ __forceinline__ void xcd_barrier_complete(unsigned* bar, unsigned x, unsigned& nloc, unsigned& nx) {
    const unsigned G = gridDim.x * gridDim.y * gridDim.z;
    unsigned sum, cnt, mine, sp = 0u;
    for (;;) {
        sum = 0u; cnt = 0u; mine = 0u;
#pragma unroll
        for (unsigned j = 0; j < 16; ++j) { const unsigned c = xb_ld(&bar[XB_XCNT(j)]); sum += c; cnt += (c > 0u) ? 1u : 0u; mine = (j == x) ? c : mine; }
        if (sum == G) break;
        __builtin_amdgcn_s_sleep(1);
        if ((++sp & 255u) == 0u) { if (xb_ld(&bar[XB_TMO])) break; if (sp > XB_SPIN_CAP) { atomicAdd(&bar[XB_TMO], 1u); break; } }
    }
    nloc = mine > 0u ? mine : 1u; nx = cnt > 0u ? cnt : 1u;
}
__device__ __forceinline__ void xcd_barrier(const XcdBarrier& b) {
    asm volatile("s_waitcnt vmcnt(0)" ::: "memory");
    __syncthreads();
    if (threadIdx.x == 0) {
        unsigned* bar = b.bar;
        __builtin_amdgcn_s_waitcnt(0);
        unsigned nloc = b.st[0], nx = b.st[1];
        if (nloc == 0u) { xcd_barrier_complete(bar, b.x, nloc, nx); b.st[0] = nloc; b.st[1] = nx; }
        const unsigned old = xb_add(&bar[XB_XSUB(b.x)], 1u);
        const unsigned gen = old / nloc;
        if (old + 1u == (gen + 1u) * nloc) {
            __builtin_amdgcn_fence(__ATOMIC_RELEASE, "agent");
            asm volatile("s_waitcnt vmcnt(0)" ::: "memory");
            const unsigned og = xb_add(&bar[XB_TOP], 1u);
            const unsigned tg = og / nx;
            if (og + 1u == (tg + 1u) * nx) xb_add(&bar[XB_TOPGEN], 1u);
            else XB_SPIN(xb_ld(&bar[XB_TOPGEN]) == tg, bar);
            __builtin_amdgcn_fence(__ATOMIC_ACQUIRE, "agent");
            xb_add(&bar[XB_XGEN(b.x)], 1u);
            asm volatile("s_waitcnt vmcnt(0)" ::: "memory");
        } else {
            XB_SPIN(xb_ld(&bar[XB_XGEN(b.x)]) == gen, bar);
            __builtin_amdgcn_fence(__ATOMIC_ACQUIRE, "agent");
            asm volatile("s_waitcnt vmcnt(0)" ::: "memory");
        }
    }
    __syncthreads();
}


__device__ __forceinline__ void p0_mod_item(const Params& p, LAS unsigned char* lds, int item) {
    const int tid = opaque_tid();
    const int layer = item / 144, cgp = item % 144, col0 = cgp * 64;
    const float* c = p.in[1]; const float* cctx = p.in[3];
    const float* W = p.in[4] + (size_t)layer * 1024 * 9216; const float* bias = p.in[5] + (size_t)layer * 9216;
    float* mout = (float*)(p.ws + WS_MOD) + (size_t)layer * 33 * 9216;
    LAS float* S = (LAS float*)lds;
    __syncthreads();
    for (int i = tid; i < 33 * 1024; i += NTHREADS) { const int r = i >> 10, k = i & 1023; const float v = r < 32 ? c[r * 1024 + k] : cctx[k]; S[i] = silu_f(v); }
    __syncthreads();
    const int col = tid & 63, ks = tid >> 6;
    float acc[33];
#pragma unroll
    for (int r = 0; r < 33; ++r) acc[r] = 0.f;
    for (int k4 = 0; k4 < 32; ++k4) {
        const int k = ks * 128 + k4 * 4;
        const float w0 = W[(size_t)(k + 0) * 9216 + col0 + col], w1 = W[(size_t)(k + 1) * 9216 + col0 + col], w2 = W[(size_t)(k + 2) * 9216 + col0 + col], w3 = W[(size_t)(k + 3) * 9216 + col0 + col];
#pragma unroll
        for (int r = 0; r < 33; ++r) { const f32x4 s4 = *(const LAS f32x4*)(S + r * 1024 + k); acc[r] += w0 * s4[0] + w1 * s4[1] + w2 * s4[2] + w3 * s4[3]; }
    }
    __syncthreads();
    LAS float* red = (LAS float*)lds;
#pragma unroll
    for (int r = 0; r < 33; ++r) red[(ks * 33 + r) * 64 + col] = acc[r];
    __syncthreads();
    for (int i = tid; i < 33 * 64; i += NTHREADS) {
        const int r = i >> 6, cc = i & 63; float s = 0.f;
#pragma unroll
        for (int q = 0; q < 8; ++q) s += red[(q * 33 + r) * 64 + cc];
        mout[(size_t)r * 9216 + col0 + cc] = s + bias[col0 + cc];
    }
    __syncthreads();
}

__device__ __forceinline__ void p0_transpose_item(const float* W, int K, int N, bf16_t* WT, int k0, int n0, int drow0, LAS float* scr, int lane) {
#pragma unroll 8
    for (int i = 0; i < 32; ++i) { const int kk = 2 * i + (lane >> 5); scr[kk * 33 + (lane & 31)] = W[(size_t)(k0 + kk) * N + n0 + (lane & 31)]; }
    asm volatile("s_waitcnt lgkmcnt(0)" ::: "memory");
    const int c = lane & 7;
#pragma unroll
    for (int j = 0; j < 4; ++j) { const int n = (lane >> 3) + 8 * j; const LAS float* s = scr + (8 * c) * 33 + n;
        u32x4 o; o.x = cvt_pk_bf16(s[0 * 33], s[1 * 33]); o.y = cvt_pk_bf16(s[2 * 33], s[3 * 33]); o.z = cvt_pk_bf16(s[4 * 33], s[5 * 33]); o.w = cvt_pk_bf16(s[6 * 33], s[7 * 33]);
        *(u32x4*)(WT + (size_t)(drow0 + n) * K + k0 + 8 * c) = o; }
    asm volatile("s_waitcnt lgkmcnt(0)" ::: "memory");
}

__device__ __forceinline__ void phase0(const Params& p, LAS unsigned char* lds) {
    const int tid = opaque_tid(), wid = tid >> 6, lane = tid & 63;
    if (blockIdx.x == 0) { unsigned* bar = (unsigned*)(p.ws + WS_BAR); for (int i = tid; i < 4096; i += NTHREADS) bar[i] = 0u; }
    if (blockIdx.x == gridDim.x - 1) {
        const float* lbp = p.in[11]; float* lbo = (float*)(p.ws + WS_LB);
        for (int i = tid; i < 2048; i += NTHREADS) { const int dir = i >> 10, col = i & 1023;
            const float l0 = lbp[(dir * 3 + 0) * 1024 + col], l1 = lbp[(dir * 3 + 1) * 1024 + col], l2 = lbp[(dir * 3 + 2) * 1024 + col];
            const float mx = fmaxf(l0, fmaxf(l1, l2)); const float e0 = __expf(l0 - mx), e1 = __expf(l1 - mx), e2 = __expf(l2 - mx);
            lbo[i] = e0 / (e0 + e1 + e2); }
    }
    if (blockIdx.x == gridDim.x - 2) {
        const float* wsp = p.in[17]; bf16_t* wsb = (bf16_t*)(p.ws + WS_WSB);
        for (int i = tid; i < 8 * 128 * 128 / 4; i += NTHREADS) { const f32x4 w = *(const f32x4*)(wsp + 4 * i); u32x2 o; o.x = cvt_pk_bf16(w[0], w[1]); o.y = cvt_pk_bf16(w[2], w[3]); *(u32x2*)(wsb + 4 * i) = o; }
    }
    for (int it = blockIdx.x; it < 288; it += gridDim.x) p0_mod_item(p, lds, it);
    __syncthreads();
    LAS float* scr = (LAS float*)lds + wid * (64 * 33);
    const int gw = blockIdx.x * 8 + wid, nw = gridDim.x * 8;
    for (int mi = 0; mi < 12; ++mi) {
        const float* W; bf16_t* WT; int K, N, mode = 0;
        if (mi < 4) { W = p.in[8] + (size_t)mi * 1024 * 5632; WT = (bf16_t*)(p.ws + WS_FIN) + (size_t)mi * 5632 * 1024; K = 1024; N = 5632; mode = 1; }
        else if (mi < 8) { W = p.in[9] + (size_t)(mi - 4) * 2816 * 1024; WT = (bf16_t*)(p.ws + WS_FOUT) + (size_t)(mi - 4) * 1024 * 2816; K = 2816; N = 1024; }
        else if (mi == 8) { W = p.in[10]; WT = (bf16_t*)(p.ws + WS_HIN); K = 1024; N = 5120; }
        else if (mi == 9) { W = p.in[13]; WT = (bf16_t*)(p.ws + WS_HOUT); K = 1024; N = 1024; }
        else if (mi == 10) { W = p.in[14]; WT = (bf16_t*)(p.ws + WS_CIN); K = 1024; N = 6144; }
        else { W = p.in[19]; WT = (bf16_t*)(p.ws + WS_COUT); K = 3072; N = 1024; }
        const int nblk = N / 32, nitems = (K / 64) * nblk;
        for (int it = gw; it < nitems; it += nw) {
            const int kb = it / nblk, nb = it % nblk, n0 = nb * 32;
            int drow0 = n0;
            if (mode == 1) { const int j = n0 < FH ? n0 : n0 - FH; drow0 = 256 * (j >> 7) + (n0 < FH ? 0 : 128) + (j & 127); }
            p0_transpose_item(W, K, N, WT, kb * 64, n0, drow0, scr, lane);
        }
    }
}

struct RowArgs {
    const float* xs_x; const float* xs_c; int nrows;
    const bf16_t* y; float ysc; const float* m; int k; const float* g; const float* b;
    float* xd; bf16_t* hd; const float* m2; int k2;
};
__device__ __forceinline__ void row_phase(const RowArgs& a) {
    const int tid0 = opaque_tid(); const int wid = tid0 >> 6, lane = tid0 & 63;
    constexpr int NR = 4;
    for (int rowb = blockIdx.x * (8 * NR) + wid; rowb < a.nrows; rowb += gridDim.x * (8 * NR)) {
        const int mrow = rowb < MX ? (rowb >> 11) : 32;
        f32x4 v[NR][4];
#pragma unroll
        for (int q = 0; q < NR; ++q) {
            const int row = rowb + 8 * q;
            const float* xr = row < MX ? a.xs_x + (size_t)row * D : a.xs_c + (size_t)(row - MX) * D;
#pragma unroll
            for (int j = 0; j < 4; ++j) v[q][j] = *(const f32x4*)(xr + j * 256 + lane * 4);
        }
        if (a.y) {
            u32x2 yy[NR][4]; f32x4 gt[4];
            const float* gp = a.m + (size_t)mrow * 9216 + (3 * a.k + 2) * 1024;
#pragma unroll
            for (int q = 0; q < NR; ++q) {
                const int row = rowb + 8 * q;
#pragma unroll
                for (int j = 0; j < 4; ++j) yy[q][j] = *(const u32x2*)(a.y + (size_t)row * D + j * 256 + lane * 4);
            }
#pragma unroll
            for (int j = 0; j < 4; ++j) gt[j] = *(const f32x4*)(gp + j * 256 + lane * 4) * a.ysc;
            float s[NR];
#pragma unroll
            for (int q = 0; q < NR; ++q) {
                s[q] = 0.f;
#pragma unroll
                for (int j = 0; j < 4; ++j) {
                    v[q][j][0] = DN_ALPHA * v[q][j][0] + gt[j][0] * bf_lo(yy[q][j].x); v[q][j][1] = DN_ALPHA * v[q][j][1] + gt[j][1] * bf_hi(yy[q][j].x);
                    v[q][j][2] = DN_ALPHA * v[q][j][2] + gt[j][2] * bf_lo(yy[q][j].y); v[q][j][3] = DN_ALPHA * v[q][j][3] + gt[j][3] * bf_hi(yy[q][j].y);
                    s[q] += (v[q][j][0] + v[q][j][1]) + (v[q][j][2] + v[q][j][3]);
                }
            }
            float mean[NR], s2[NR];
#pragma unroll
            for (int q = 0; q < NR; ++q) mean[q] = wave_sum(s[q]) * (1.f / D);
#pragma unroll
            for (int q = 0; q < NR; ++q) {
                s2[q] = 0.f;
#pragma unroll
                for (int j = 0; j < 4; ++j) { v[q][j] = v[q][j] - mean[q]; s2[q] += (v[q][j][0] * v[q][j][0] + v[q][j][1] * v[q][j][1]) + (v[q][j][2] * v[q][j][2] + v[q][j][3] * v[q][j][3]); }
            }
            f32x4 gg[4], bb[4];
#pragma unroll
            for (int j = 0; j < 4; ++j) { gg[j] = *(const f32x4*)(a.g + j * 256 + lane * 4); bb[j] = *(const f32x4*)(a.b + j * 256 + lane * 4); }
#pragma unroll
            for (int q = 0; q < NR; ++q) {
                const int row = rowb + 8 * q;
                const float rstd = __builtin_amdgcn_rsqf(wave_sum(s2[q]) * (1.f / D) + LN_EPS);
#pragma unroll
                for (int j = 0; j < 4; ++j) v[q][j] = v[q][j] * rstd * gg[j] + bb[j];
                if (a.xd && row < MX) {
#pragma unroll
                    for (int j = 0; j < 4; ++j) *(f32x4*)(a.xd + (size_t)row * D + j * 256 + lane * 4) = v[q][j];
                }
            }
        }
        if (a.hd) {
            const float* shp = a.m2 + (size_t)mrow * 9216 + (3 * a.k2) * 1024; const float* scp = shp + 1024;
            f32x4 sh[4], sc[4];
#pragma unroll
            for (int j = 0; j < 4; ++j) { sh[j] = *(const f32x4*)(shp + j * 256 + lane * 4); sc[j] = *(const f32x4*)(scp + j * 256 + lane * 4) + 1.f; }
#pragma unroll
            for (int q = 0; q < NR; ++q) {
                const int row = rowb + 8 * q;
#pragma unroll
                for (int j = 0; j < 4; ++j) {
                    const f32x4 h = v[q][j] * sc[j] + sh[j];
                    u32x2 o; o.x = cvt_pk_bf16(h[0], h[1]); o.y = cvt_pk_bf16(h[2], h[3]);
                    *(u32x2*)(a.hd + (size_t)row * D + j * 256 + lane * 4) = o;
                }
            }
        }
    }
}

constexpr int GLA_DIRB = 74240;
__device__ __forceinline__ void gla_phase(const Params& p, LAS unsigned char* lds) {
    const int tid = opaque_tid(), dir = tid >> 8, tl = tid & 255, w = tl >> 6, lane = tl & 63, fr = lane & 15, fq = lane >> 4;
    const int cp = lane, qt = w;
    bf16_t* P = (bf16_t*)(p.ws + WS_BIG); bf16_t* R = (bf16_t*)(p.ws + WS_A0);
    const float* normw = p.in[12];
    LAS unsigned char* base = lds + dir * GLA_DIRB;
    LAS bf16_t* Qin = (LAS bf16_t*)base;
    LAS bf16_t* Kin = (LAS bf16_t*)(base + 17408);
    LAS bf16_t* Sc = Kin;
    LAS bf16_t* KinT = (LAS bf16_t*)(base + 34816);
    LAS bf16_t* VT = (LAS bf16_t*)(base + 53248);
    LAS float* tot = (LAS float*)(base + 71680);
    LAS float* dec = (LAS float*)(base + 73728);
    for (int item = blockIdx.x; item < NB * 8; item += gridDim.x) {
        const int b = item >> 3, h = item & 7;
        f32x4 Sacc[8][2];
#pragma unroll
        for (int m = 0; m < 8; ++m) { Sacc[m][0] = (f32x4){0.f, 0.f, 0.f, 0.f}; Sacc[m][1] = (f32x4){0.f, 0.f, 0.f, 0.f}; }
        unsigned rq[16], rv[16], rl[16];
        auto chunk_row = [&](int ci, int t) -> size_t {
            const bool isc = ci < 4; const int lc = isc ? ci : ci - 4, L = isc ? CTXL : SEQ; const int rbase = isc ? MX + b * CTXL : b * SEQ;
            const int tok = dir == 0 ? 64 * lc + t : L - 1 - (64 * lc + t);
            return (size_t)(rbase + tok);
        };
        auto load_chunk = [&](int ci) {
            const bf16_t* rp = P + chunk_row(ci, 16 * qt) * HG5 + h * 128 + 2 * cp;
            const long step = dir == 0 ? (long)HG5 : -(long)HG5;
#pragma unroll
            for (int i = 0; i < 16; ++i) {
                rq[i] = *(const unsigned*)rp; rv[i] = *(const unsigned*)(rp + 1024); rl[i] = *(const unsigned*)(rp + (2 + dir) * 1024);
                rp += step; asm volatile("" : "+v"(rp));
            }
        };
        __syncthreads();
        load_chunk(0);
        for (int ci = 0; ci < 36; ++ci) {
            const bool isc = ci < 4;
            {
                float run0 = 0.f, run1 = 0.f;
#pragma unroll
                for (int i = 0; i < 16; ++i) { run0 += bf_lo(rl[i]); run1 += bf_hi(rl[i]); }
                *(LAS f32x2*)(tot + qt * 128 + 2 * cp) = (f32x2){run0, run1};
#pragma unroll
                for (int hh = 0; hh < 2; ++hh) {
                    u32x4 a, c;
#pragma unroll
                    for (int u = 0; u < 4; ++u) { const int ip = 4 * hh + u;
                        a[u] = (rv[2 * ip] & 0xffffu) | (rv[2 * ip + 1] << 16); c[u] = (rv[2 * ip] >> 16) | (rv[2 * ip + 1] & 0xffff0000u); }
                    *(LAS u32x4*)(VT + (2 * cp) * 72 + 16 * qt + 8 * hh) = a;
                    *(LAS u32x4*)(VT + (2 * cp + 1) * 72 + 16 * qt + 8 * hh) = c;
                }
                __syncthreads();
                float pre0 = 0.f, pre1 = 0.f, all0 = 0.f, all1 = 0.f;
#pragma unroll
                for (int q = 0; q < 4; ++q) { const f32x2 tq = *(const LAS f32x2*)(tot + q * 128 + 2 * cp); if (q < qt) { pre0 += tq[0]; pre1 += tq[1]; } all0 += tq[0]; all1 += tq[1]; }
                if (qt == 0) *(LAS f32x2*)(dec + 2 * cp) = (f32x2){__expf(all0), __expf(all1)};
                float iebp0 = __expf(-pre0), iebp1 = __expf(-pre1);
                float bb0 = pre0, bb1 = pre1;
#pragma unroll
                for (int hh = 0; hh < 2; ++hh) {
                    u32x4 a, c;
#pragma unroll
                    for (int u4 = 0; u4 < 4; ++u4) {
                        float kin0[2], kin1[2];
#pragma unroll
                        for (int u = 0; u < 2; ++u) {
                            const int i = 8 * hh + 2 * u4 + u, t = 16 * qt + i;
                            bb0 += bf_lo(rl[i]); bb1 += bf_hi(rl[i]);
                            const float eb0 = __expf(bb0), eb1 = __expf(bb1), ieb0 = __expf(-bb0), ieb1 = __expf(-bb1);
                            const float k0 = 1.f - eb0 * iebp0, k1 = 1.f - eb1 * iebp1;
                            iebp0 = ieb0; iebp1 = ieb1;
                            kin0[u] = k0 * ieb0; kin1[u] = k1 * ieb1;
                            *(LAS unsigned*)(Qin + t * 136 + 2 * cp) = cvt_pk_bf16(bf_lo(rq[i]) * eb0, bf_hi(rq[i]) * eb1);
                            *(LAS unsigned*)(Kin + t * 136 + 2 * cp) = cvt_pk_bf16(kin0[u], kin1[u]);
                        }
                        a[u4] = cvt_pk_bf16(kin0[0], kin0[1]); c[u4] = cvt_pk_bf16(kin1[0], kin1[1]);
                    }
                    *(LAS u32x4*)(KinT + (2 * cp) * 72 + 16 * qt + 8 * hh) = a;
                    *(LAS u32x4*)(KinT + (2 * cp + 1) * 72 + 16 * qt + 8 * hh) = c;
                    __builtin_amdgcn_sched_barrier(0);
                }
            }
            __syncthreads();
            if (ci + 1 < 36) load_chunk(ci + 1);
            f32x4 sacc[4];
            if (!isc) {
                bf16x8 qf[4];
#pragma unroll
                for (int ks = 0; ks < 4; ++ks) qf[ks] = *(const LAS bf16x8*)(Qin + (16 * w + fr) * 136 + 32 * ks + 8 * fq);
#pragma unroll
                for (int ms = 0; ms < 4; ++ms) {
                    sacc[ms] = (f32x4){0.f, 0.f, 0.f, 0.f};
                    if (ms <= w) {
#pragma unroll
                        for (int ks = 0; ks < 4; ++ks) { const bf16x8 kf = *(const LAS bf16x8*)(Kin + (16 * ms + fr) * 136 + 32 * ks + 8 * fq);
                            sacc[ms] = __builtin_amdgcn_mfma_f32_16x16x32_bf16(kf, qf[ks], sacc[ms], 0, 0, 0); }
                    }
                }
            }
            __syncthreads();
            if (!isc) {
#pragma unroll
                for (int ms = 0; ms < 4; ++ms) {
                    f32x4 v = sacc[ms];
                    if (ms == w) {
#pragma unroll
                        for (int j = 0; j < 4; ++j) v[j] = (4 * fq + j <= fr) ? v[j] : 0.f;
                    }
                    u32x2 o; o.x = cvt_pk_bf16(v[0], v[1]); o.y = cvt_pk_bf16(v[2], v[3]);
                    *(LAS u32x2*)(Sc + (16 * w + fr) * 72 + 16 * ms + 4 * fq) = o;
                }
            }
            __syncthreads();
            __builtin_amdgcn_sched_barrier(0);
            bf16x8 vfrag[2][2];
#pragma unroll
            for (int n = 0; n < 2; ++n)
#pragma unroll
                for (int ks = 0; ks < 2; ++ks) vfrag[n][ks] = *(const LAS bf16x8*)(VT + (32 * w + 16 * n + fr) * 72 + 32 * ks + 8 * fq);
            if (!isc) {
                f32x4 oacc[2][4];
#pragma unroll
                for (int n = 0; n < 2; ++n)
#pragma unroll
                    for (int tt = 0; tt < 4; ++tt) oacc[n][tt] = (f32x4){0.f, 0.f, 0.f, 0.f};
#pragma unroll
                for (int kk = 0; kk < 4; ++kk) {
                    bf16x8 sf[2];
#pragma unroll
                    for (int n = 0; n < 2; ++n) {
                        u32x4 pk; pk.x = cvt_pk_bf16(Sacc[2 * kk][n][0], Sacc[2 * kk][n][1]); pk.y = cvt_pk_bf16(Sacc[2 * kk][n][2], Sacc[2 * kk][n][3]);
                        pk.z = cvt_pk_bf16(Sacc[2 * kk + 1][n][0], Sacc[2 * kk + 1][n][1]); pk.w = cvt_pk_bf16(Sacc[2 * kk + 1][n][2], Sacc[2 * kk + 1][n][3]);
                        sf[n] = __builtin_bit_cast(bf16x8, pk);
                    }
#pragma unroll
                    for (int tt = 0; tt < 4; ++tt) {
                        const LAS bf16_t* qp = Qin + (16 * tt + fr) * 136 + 32 * kk + 4 * fq;
                        const u32x2 lo = *(const LAS u32x2*)qp, hi = *(const LAS u32x2*)(qp + 16);
                        const bf16x8 qfr = __builtin_bit_cast(bf16x8, ((u32x4){lo.x, lo.y, hi.x, hi.y}));
#pragma unroll
                        for (int n = 0; n < 2; ++n) oacc[n][tt] = __builtin_amdgcn_mfma_f32_16x16x32_bf16(sf[n], qfr, oacc[n][tt], 0, 0, 0);
                    }
                }
                __builtin_amdgcn_sched_barrier(0);
#pragma unroll
                for (int tt = 0; tt < 4; ++tt)
#pragma unroll
                    for (int ks = 0; ks < 2; ++ks) {
                        if (ks == 1 && tt < 2) continue;
                        const bf16x8 scf = *(const LAS bf16x8*)(Sc + (16 * tt + fr) * 72 + 32 * ks + 8 * fq);
#pragma unroll
                        for (int n = 0; n < 2; ++n) oacc[n][tt] = __builtin_amdgcn_mfma_f32_16x16x32_bf16(vfrag[n][ks], scf, oacc[n][tt], 0, 0, 0);
                    }
                __builtin_amdgcn_sched_barrier(0);
#pragma unroll
                for (int tt = 0; tt < 4; ++tt) {
                    bf16_t* op = P + chunk_row(ci, 16 * tt + fr) * HG5 + (2 + dir) * 1024 + h * 128 + 32 * w + 4 * fq;
#pragma unroll
                    for (int n = 0; n < 2; ++n) { u32x2 o; o.x = cvt_pk_bf16(oacc[n][tt][0], oacc[n][tt][1]); o.y = cvt_pk_bf16(oacc[n][tt][2], oacc[n][tt][3]); *(u32x2*)(op + 16 * n) = o; }
                }
            }
            __builtin_amdgcn_sched_barrier(0);
#pragma unroll
            for (int m = 0; m < 8; ++m) {
#pragma unroll
                for (int ks = 0; ks < 2; ++ks) { const bf16x8 kf = *(const LAS bf16x8*)(KinT + (16 * m + fr) * 72 + 32 * ks + 8 * fq);
#pragma unroll
                    for (int n = 0; n < 2; ++n) Sacc[m][n] = __builtin_amdgcn_mfma_f32_16x16x32_bf16(kf, vfrag[n][ks], Sacc[m][n], 0, 0, 0); }
                const f32x4 dv = *(const LAS f32x4*)(dec + 16 * m + 4 * fq);
                Sacc[m][0] *= dv; Sacc[m][1] *= dv;
            }
            __syncthreads();
        }
        __threadfence(); __syncthreads(); __threadfence();
        {
            const int wid = tid >> 6, lane = tid & 63, sub = lane >> 4, l16 = lane & 15;
            const f32x4 w0 = *(const f32x4*)(normw + 8 * l16), w1 = *(const f32x4*)(normw + 8 * l16 + 4);
#pragma unroll 4
            for (int it = 0; it < 64; ++it) {
                const int t = it * 32 + wid * 4 + sub; const size_t row = (size_t)b * SEQ + t;
                const bf16_t* rp = P + row * HG5 + h * 128 + 8 * l16;
                const u32x4 of = *(const u32x4*)(rp + 2048), ob = *(const u32x4*)(rp + 3072), gg = *(const u32x4*)(rp + 4096);
                float o[8];
                o[0] = bf_lo(of.x) + bf_lo(ob.x); o[1] = bf_hi(of.x) + bf_hi(ob.x); o[2] = bf_lo(of.y) + bf_lo(ob.y); o[3] = bf_hi(of.y) + bf_hi(ob.y);
                o[4] = bf_lo(of.z) + bf_lo(ob.z); o[5] = bf_hi(of.z) + bf_hi(ob.z); o[6] = bf_lo(of.w) + bf_lo(ob.w); o[7] = bf_hi(of.w) + bf_hi(ob.w);
                float ss = 0.f;
#pragma unroll
                for (int i = 0; i < 8; ++i) ss += o[i] * o[i];
                ss += __shfl_xor(ss, 1); ss += __shfl_xor(ss, 2); ss += __shfl_xor(ss, 4); ss += __shfl_xor(ss, 8);
                const float rs = __builtin_amdgcn_rsqf(ss * (1.f / 128.f) + RMS_EPS);
                u32x4 r;
                r.x = cvt_pk_bf16(o[0] * rs * w0[0] * bf_lo(gg.x), o[1] * rs * w0[1] * bf_hi(gg.x));
                r.y = cvt_pk_bf16(o[2] * rs * w0[2] * bf_lo(gg.y), o[3] * rs * w0[3] * bf_hi(gg.y));
                r.z = cvt_pk_bf16(o[4] * rs * w1[0] * bf_lo(gg.z), o[5] * rs * w1[1] * bf_hi(gg.z));
                r.w = cvt_pk_bf16(o[6] * rs * w1[2] * bf_lo(gg.w), o[7] * rs * w1[3] * bf_hi(gg.w));
                *(u32x4*)(R + row * D + h * 128 + 8 * l16) = r;
            }
        }
        __syncthreads();
    }
}

__device__ __forceinline__ void cm_gate_phase(const Params& p, LAS unsigned char* lds) {
    const int tid = opaque_tid(), wid = tid >> 6, lane = tid & 63, fr = lane & 15, fq = lane >> 4;
    bf16_t* UV = (bf16_t*)(p.ws + WS_BIG);
    const float* vg = p.in[15]; const float* vb = p.in[16]; const float* bs = p.in[18];
    const bf16_t* WSB = (const bf16_t*)(p.ws + WS_WSB);
    LAS bf16_t* Wl = (LAS bf16_t*)lds; LAS bf16_t* Vl = (LAS bf16_t*)(lds + 34816); LAS float* st = (LAS float*)(lds + 34816 + 100352); LAS float* bl = st + 256;
    const int c8 = lane < 48 ? lane : 47;
    for (int ch = blockIdx.x; ch < MX / 128; ch += gridDim.x) {
        const size_t row0 = (size_t)ch * 128;
        __syncthreads();
        for (int rr = 0; rr < 8; ++rr) {
            const int r = wid * 16 + 2 * rr; const bf16_t* vp = UV + (row0 + r) * 6144 + 3072;
            u32x4 x[2][6]; float s[2] = {0.f, 0.f};
#pragma unroll
            for (int q = 0; q < 2; ++q)
#pragma unroll
                for (int i = 0; i < 6; ++i) x[q][i] = *(const u32x4*)(vp + (size_t)q * 6144 + (i * 64 + lane) * 8);
#pragma unroll
            for (int q = 0; q < 2; ++q)
#pragma unroll
                for (int i = 0; i < 6; ++i) s[q] += (bf_lo(x[q][i].x) + bf_hi(x[q][i].x)) + (bf_lo(x[q][i].y) + bf_hi(x[q][i].y)) + (bf_lo(x[q][i].z) + bf_hi(x[q][i].z)) + (bf_lo(x[q][i].w) + bf_hi(x[q][i].w));
            float mean[2], s2[2] = {0.f, 0.f};
#pragma unroll
            for (int q = 0; q < 2; ++q) mean[q] = wave_sum(s[q]) * (1.f / 3072.f);
#pragma unroll
            for (int q = 0; q < 2; ++q)
#pragma unroll
                for (int i = 0; i < 6; ++i) { float d;
                    d = bf_lo(x[q][i].x) - mean[q]; s2[q] += d * d; d = bf_hi(x[q][i].x) - mean[q]; s2[q] += d * d; d = bf_lo(x[q][i].y) - mean[q]; s2[q] += d * d; d = bf_hi(x[q][i].y) - mean[q]; s2[q] += d * d;
                    d = bf_lo(x[q][i].z) - mean[q]; s2[q] += d * d; d = bf_hi(x[q][i].z) - mean[q]; s2[q] += d * d; d = bf_lo(x[q][i].w) - mean[q]; s2[q] += d * d; d = bf_hi(x[q][i].w) - mean[q]; s2[q] += d * d; }
#pragma unroll
            for (int q = 0; q < 2; ++q) { const float rstd = __builtin_amdgcn_rsqf(wave_sum(s2[q]) * (1.f / 3072.f) + LN_EPS); if (lane == 0) { st[2 * (r + q)] = mean[q]; st[2 * (r + q) + 1] = rstd; } }
        }
        for (int g = 0; g < 8; ++g) {
            __syncthreads();
#pragma unroll
            for (int i = 0; i < 4; ++i) { const int idx = tid + NTHREADS * i, r = idx >> 4, cc = idx & 15;
                *(LAS u32x4*)(Wl + r * 136 + cc * 8) = *(const u32x4*)(WSB + (size_t)g * 16384 + r * 128 + cc * 8); }
            if (tid < 128) bl[tid] = bs[g * 128 + tid];
            {
                const float* gp = vg + g * 384 + c8 * 8; const float* bp = vb + g * 384 + c8 * 8;
                const f32x4 g0 = *(const f32x4*)gp, g1 = *(const f32x4*)(gp + 4), b0 = *(const f32x4*)bp, b1 = *(const f32x4*)(bp + 4);
                const bf16_t* xp = UV + (row0 + wid) * 6144 + 3072 + g * 384 + c8 * 8;
#pragma unroll
                for (int hb = 0; hb < 2; ++hb) {
                    u32x4 xv[8];
#pragma unroll
                    for (int i = 0; i < 8; ++i) { xv[i] = *(const u32x4*)xp; xp += 8 * 6144; asm volatile("" : "+v"(xp)); }
#pragma unroll
                    for (int i = 0; i < 8; ++i) { const int sr = wid + 8 * (8 * hb + i);
                        const f32x2 ms = *(const LAS f32x2*)(st + 2 * sr); const float mean = ms[0], rstd = ms[1]; const u32x4 x = xv[i];
                        u32x4 o;
                        o.x = cvt_pk_bf16((bf_lo(x.x) - mean) * rstd * g0[0] + b0[0], (bf_hi(x.x) - mean) * rstd * g0[1] + b0[1]);
                        o.y = cvt_pk_bf16((bf_lo(x.y) - mean) * rstd * g0[2] + b0[2], (bf_hi(x.y) - mean) * rstd * g0[3] + b0[3]);
                        o.z = cvt_pk_bf16((bf_lo(x.z) - mean) * rstd * g1[0] + b1[0], (bf_hi(x.z) - mean) * rstd * g1[1] + b1[1]);
                        o.w = cvt_pk_bf16((bf_lo(x.w) - mean) * rstd * g1[2] + b1[2], (bf_hi(x.w) - mean) * rstd * g1[3] + b1[3]);
                        if (lane < 48) *(LAS u32x4*)(Vl + sr * 392 + c8 * 8) = o; }
                }
            }
            __syncthreads();
            u32x2 uu[8][3];
            { const bf16_t* up = UV + (row0 + fr) * 6144 + g * 384 + wid * 48 + 4 * fq;
#pragma unroll
            for (int m = 0; m < 8; ++m) {
#pragma unroll
                for (int n = 0; n < 3; ++n) uu[m][n] = *(const u32x2*)(up + n * 16);
                up += 16 * 6144; asm volatile("" : "+v"(up)); } }
            f32x4 acc[3][8];
#pragma unroll
            for (int n = 0; n < 3; ++n)
#pragma unroll
                for (int m = 0; m < 8; ++m) acc[n][m] = (f32x4){0.f, 0.f, 0.f, 0.f};
#pragma unroll 1
            for (int ks = 0; ks < 4; ++ks) {
                bf16x8 af[3];
#pragma unroll
                for (int n = 0; n < 3; ++n) {
                    const LAS bf16_t* vp = Vl + (32 * ks + 8 * fq) * 392 + wid * 48 + n * 16 + fr;
#pragma unroll
                    for (int i = 0; i < 8; ++i) af[n][i] = (short)vp[i * 392];
                }
#pragma unroll
                for (int m = 0; m < 8; ++m) {
                    const bf16x8 bfrag = *(const LAS bf16x8*)(Wl + (16 * m + fr) * 136 + 32 * ks + 8 * fq);
#pragma unroll
                    for (int n = 0; n < 3; ++n) acc[n][m] = __builtin_amdgcn_mfma_f32_16x16x32_bf16(af[n], bfrag, acc[n][m], 0, 0, 0);
                    if (m & 1) __builtin_amdgcn_sched_barrier(0);
                }
            }
            bf16_t* zp = UV + (row0 + fr) * 6144 + g * 384 + wid * 48 + 4 * fq;
#pragma unroll
            for (int m = 0; m < 8; ++m) {
                const float bias = bl[16 * m + fr];
#pragma unroll
                for (int n = 0; n < 3; ++n) {
                    const u32x2 u2 = uu[m][n];
                    u32x2 o; o.x = cvt_pk_bf16(bf_lo(u2.x) * (acc[n][m][0] + bias), bf_hi(u2.x) * (acc[n][m][1] + bias));
                    o.y = cvt_pk_bf16(bf_lo(u2.y) * (acc[n][m][2] + bias), bf_hi(u2.y) * (acc[n][m][3] + bias));
                    *(u32x2*)(zp + n * 16) = o;
                }
                zp += 16 * 6144; asm volatile("" : "+v"(zp));
            }
        }
    }
}

#ifndef EN_MASK
#define EN_MASK 255
#endif
constexpr int EN = EN_MASK;
__global__ void __launch_bounds__(NTHREADS, 2) fwd_megakernel(Params p) {
    extern __shared__ __attribute__((aligned(16))) unsigned char lds_raw[];
    LAS unsigned char* lds = (LAS unsigned char*)lds_raw;
    cg::grid_group grid = cg::this_grid();
    volatile LAS unsigned* xst = (volatile LAS unsigned*)(lds + LDS_BYTES - 16);
    if (threadIdx.x == 0) { xst[0] = 0u; xst[1] = 0u; }
    XcdBarrier xb; xb.bar = (unsigned*)(p.ws + WS_BAR); xb.x = 0; xb.st = xst;
    const float* x_in = p.in[0]; const float* ctx_in = p.in[2];
    const float* mod0 = (const float*)(p.ws + WS_MOD); const float* mod1 = mod0 + (size_t)33 * 9216;
    const float* lbv = (const float*)(p.ws + WS_LB);
    const float* ln_g = p.in[6]; const float* ln_b = p.in[7];
    bf16_t* A0 = (bf16_t*)(p.ws + WS_A0); bf16_t* BIG = (bf16_t*)(p.ws + WS_BIG);
    const bf16_t* FIN = (const bf16_t*)(p.ws + WS_FIN); const bf16_t* FOUT = (const bf16_t*)(p.ws + WS_FOUT);
    const bf16_t* HIN = (const bf16_t*)(p.ws + WS_HIN); const bf16_t* HOUT = (const bf16_t*)(p.ws + WS_HOUT);
    const bf16_t* CIN = (const bf16_t*)(p.ws + WS_CIN); const bf16_t* COUT = (const bf16_t*)(p.ws + WS_COUT);
    const size_t FIN_SZ = (size_t)5632 * 1024, FOUT_SZ = (size_t)1024 * 2816;
    for (int ph = p.ph_lo; ph < p.ph_hi; ++ph) {
        int kind;
        switch (ph) {
        case 0: kind = 0; break;
        case 1: case 4: case 8: case 11: case 14: case 18: case 21: kind = 1; break;
        case 2: case 9: case 12: case 19: kind = 2; break;
        case 3: case 7: case 10: case 13: case 17: case 20: kind = 3; break;
        case 5: kind = 4; break;
        case 6: kind = 5; break;
        case 15: kind = 6; break;
        default: kind = 7; break;
        }
        if (kind == 0) { if (EN & 1) phase0(p, lds); }
        else if (kind == 1) {
            RowArgs a;
            a.xs_x = p.out; a.xs_c = nullptr; a.nrows = MX; a.y = A0; a.ysc = 0.5f; a.xd = p.out; a.hd = A0;
            if (ph == 1) { a.xs_x = x_in; a.xs_c = ctx_in; a.nrows = MT; a.y = nullptr; a.m = mod0; a.k = 0; a.g = ln_g; a.b = ln_b; a.m2 = mod0; a.k2 = 0; }
            else if (ph == 4) { a.xs_x = x_in; a.xs_c = ctx_in; a.nrows = MT; a.m = mod0; a.k = 0; a.g = ln_g + 0 * D; a.b = ln_b + 0 * D; a.m2 = mod0; a.k2 = 1; }
            else if (ph == 8) { a.y = BIG; a.ysc = 1.f; a.m = mod0; a.k = 1; a.g = ln_g + 1 * D; a.b = ln_b + 1 * D; a.m2 = mod0; a.k2 = 2; }
            else if (ph == 11) { a.m = mod0; a.k = 2; a.g = ln_g + 2 * D; a.b = ln_b + 2 * D; a.m2 = mod1; a.k2 = 0; }
            else if (ph == 14) { a.m = mod1; a.k = 0; a.g = ln_g + 3 * D; a.b = ln_b + 3 * D; a.m2 = mod1; a.k2 = 1; }
            else if (ph == 18) { a.ysc = 1.f; a.m = mod1; a.k = 1; a.g = ln_g + 4 * D; a.b = ln_b + 4 * D; a.m2 = mod1; a.k2 = 2; }
            else { a.m = mod1; a.k = 2; a.g = ln_g + 5 * D; a.b = ln_b + 5 * D; a.hd = nullptr; a.m2 = mod1; a.k2 = 0; }
            if (EN & 2) row_phase(a);
        } else if (kind == 2) {
            const int wi = ph == 2 ? 0 : (ph == 9 ? 1 : (ph == 12 ? 2 : 3));
            if (EN & 4) run_gemm<1>(lds, A0, D, FIN + wi * FIN_SZ, ph == 2 ? MT : MX, 2 * FH, D, BIG, FH, nullptr);
        } else if (kind == 3) {
            const bf16_t* A = BIG; int lda = FH, M = MX, K = FH; const bf16_t* Bt; bf16_t* O = A0;
            if (ph == 3) { Bt = FOUT; M = MT; }
            else if (ph == 7) { A = A0; lda = D; K = D; Bt = HOUT; O = BIG; }
            else if (ph == 10) Bt = FOUT + 1 * FOUT_SZ;
            else if (ph == 13) Bt = FOUT + 2 * FOUT_SZ;
            else if (ph == 17) { lda = 2 * CMI; K = CMI; Bt = COUT; }
            else Bt = FOUT + 3 * FOUT_SZ;
            if (EN & 8) run_gemm<0>(lds, A, lda, Bt, M, D, K, O, D, nullptr);
        } else if (kind == 4) { if (EN & 16) run_gemm<2>(lds, A0, D, HIN, MT, HG5, D, BIG, HG5, lbv); }
        else if (kind == 5) { if (EN & 32) gla_phase(p, lds); }
        else if (kind == 6) { if (EN & 64) run_gemm<3>(lds, A0, D, CIN, MX, 2 * CMI, D, BIG, 2 * CMI, nullptr); }
        else { if (EN & 128) cm_gate_phase(p, lds); }
        if (ph + 1 < p.ph_hi) {
            if (ph == 0) { grid.sync(); xb = xcd_barrier_post((unsigned*)(p.ws + WS_BAR), xst); }
            else xcd_barrier(xb);
        }
    }
}

extern "C" void kernel_launch(void* const* d_in, const int* in_sizes, int n_in, void* d_out, int out_size, void* d_ws, size_t ws_size, hipStream_t stream) {
    static int grid_blocks = 0;
    if (grid_blocks == 0) {
        if (n_in != 20 || out_size != MX * D || ws_size < WS_END) { fprintf(stderr, "kernel_launch: unexpected shapes (n_in %d out %d ws %zu need %zu)\n", n_in, out_size, ws_size, (size_t)WS_END); grid_blocks = -1; return; }
        int dev = 0, cus = 0, per_cu = 0;
        hipGetDevice(&dev);
        hipDeviceGetAttribute(&cus, hipDeviceAttributeMultiprocessorCount, dev);
        if (hipFuncSetAttribute((const void*)fwd_megakernel, hipFuncAttributeMaxDynamicSharedMemorySize, LDS_BYTES) != hipSuccess) { fprintf(stderr, "kernel_launch: hipFuncSetAttribute failed\n"); grid_blocks = -1; return; }
        if (hipOccupancyMaxActiveBlocksPerMultiprocessor(&per_cu, (const void*)fwd_megakernel, NTHREADS, LDS_BYTES) != hipSuccess || per_cu < 1) { fprintf(stderr, "kernel_launch: occupancy query says %d\n", per_cu); per_cu = 1; }
        (void)hipGetLastError();
        grid_blocks = cus * 1;
    }
    if (grid_blocks < 0) return;
    Params p{};
    for (int i = 0; i < 20; ++i) p.in[i] = (const float*)d_in[i];
    p.out = (float*)d_out; p.ws = (unsigned char*)d_ws; p.ph_lo = 0; p.ph_hi = 22;
    void* args[] = {&p};
    hipError_t e = hipLaunchCooperativeKernel((const void*)fwd_megakernel, dim3(grid_blocks), dim3(NTHREADS), args, LDS_BYTES, stream);
    if (e != hipSuccess) fprintf(stderr, "cooperative launch failed: %s (grid %d)\n", hipGetErrorString(e), grid_blocks);
}
```

```cpp
#include <hip/hip_runtime.h>
#include <hip/hip_cooperative_groups.h>
#include <cstdio>
#include <cstdint>
namespace cg = cooperative_groups;

#define LAS __attribute__((address_space(3)))
typedef unsigned short bf16_t;
typedef short bf16x8 __attribute__((ext_vector_type(8)));
typedef float f32x4 __attribute__((ext_vector_type(4)));
typedef float f32x2 __attribute__((ext_vector_type(2)));
typedef unsigned u32x4 __attribute__((ext_vector_type(4)));
typedef unsigned u32x2 __attribute__((ext_vector_type(2)));

constexpr int D = 1024, NB = 32, SEQ = 2048, CTXL = 256;
constexpr int MX = NB * SEQ;
constexpr int MC = NB * CTXL;
constexpr int MT = MX + MC;
constexpr int FH = 2816, HG5 = 5 * D, CMI = 3072, NMOD = 9;
constexpr float DN_ALPHA = 1.41421356237309515f;
constexpr float LN_EPS = 1e-5f, RMS_EPS = 1e-6f;
constexpr int LDS_BYTES = 149504;
constexpr int NTHREADS = 512;

constexpr size_t WS_MOD = 0;
constexpr size_t WS_LB = WS_MOD + (size_t)2 * 33 * 9216 * 4;
constexpr size_t WS_BAR = WS_LB + 2 * 1024 * 4;
constexpr size_t WS_FIN = WS_BAR + 4096 * 4;
constexpr size_t WS_FOUT = WS_FIN + (size_t)4 * 5632 * 1024 * 2;
constexpr size_t WS_HIN = WS_FOUT + (size_t)4 * 1024 * 2816 * 2;
constexpr size_t WS_HOUT = WS_HIN + (size_t)5120 * 1024 * 2;
constexpr size_t WS_CIN = WS_HOUT + (size_t)1024 * 1024 * 2;
constexpr size_t WS_COUT = WS_CIN + (size_t)6144 * 1024 * 2;
constexpr size_t WS_WSB = WS_COUT + (size_t)1024 * 3072 * 2;
constexpr size_t WS_A0 = WS_WSB + (size_t)8 * 128 * 128 * 2;
constexpr size_t WS_BIG = WS_A0 + (size_t)MT * 1024 * 2;
constexpr size_t WS_END = WS_BIG + (size_t)MX * 6144 * 2;

struct Params {
    const float* in[20];
    float* out;
    unsigned char* ws;
    int ph_lo, ph_hi;
};

__device__ __forceinline__ unsigned cvt_pk_bf16(float lo, float hi) { unsigned r; asm volatile("v_cvt_pk_bf16_f32 %0, %1, %2" : "=v"(r) : "v"(lo), "v"(hi)); return r; }
__device__ __forceinline__ int opaque_tid() { int t = threadIdx.x; asm volatile("" : "+v"(t)); return t; }
__device__ __forceinline__ void lds_barrier() { asm volatile("s_waitcnt lgkmcnt(0)" ::: "memory"); __builtin_amdgcn_s_barrier(); asm volatile("" ::: "memory"); }
__device__ __forceinline__ float bf_lo(unsigned u) { return __uint_as_float(u << 16); }
__device__ __forceinline__ float bf_hi(unsigned u) { return __uint_as_float(u & 0xffff0000u); }
__device__ __forceinline__ float wave_sum(float v) {
#pragma unroll
    for (int o = 1; o < 64; o <<= 1) v += __shfl_xor(v, o);
    return v;
}
__device__ __forceinline__ float sigmoid_f(float x) { return __builtin_amdgcn_rcpf(1.f + __expf(-x)); }
__device__ __forceinline__ float silu_f(float x) { return x * sigmoid_f(x); }
__device__ __forceinline__ float gelu_tanh_f(float x) { const float u = 0.7978845608028654f * (x + 0.044715f * x * x * x); return x * sigmoid_f(2.f * u); }

namespace pg8 {
constexpr int BM = 256, BK = 64, HALF = 128, HTB = HALF * BK * 2, STAGE_BYTES = 8 * HTB, NXCD = 8, WGM = 8;
__host__ __device__ __forceinline__ int lds_byte(int r, int c) { const int st = (r >> 4) * 2 + (c >> 5), rr = r & 15, cc = c & 31, ob = rr * 64 + cc * 2; return st * 1024 + (ob ^ (((ob >> 9) & 1) << 5)); }
__host__ __device__ __forceinline__ void stage_rc(int b, int& R, int& C) { const int st = b / 1024, sb = b % 1024, swz = sb ^ (((sb >> 9) & 1) << 5); R = (st >> 1) * 16 + swz / 64; C = (st & 1) * 32 + (swz % 64) / 2; }
__host__ __device__ __forceinline__ int perm32(int rho) { const int n = rho >> 4, i = rho & 15; return 8 * (i >> 2) + 4 * n + (i & 3); }

struct Unit { int pm, pn; };
struct Gemm { const bf16_t* A; int lda; const bf16_t* Bt; int M, N, K; };

struct StaticOrder {
    int nM, nN, nwg, G, c;
    __device__ void init(int M, int N, int G_, int c_) { nM = M / BM; nN = N / BM; nwg = nM * nN; G = G_; c = c_; }
    __device__ bool next(int i, Unit& u) const {
        const long L = (long)i * G + c; if (L >= nwg) return false;
        int wgid = (int)L; { const int q = nwg / NXCD, r = nwg % NXCD, xcd = wgid % NXCD, off = wgid / NXCD; wgid = (xcd < r ? xcd * (q + 1) : r * (q + 1) + (xcd - r) * q) + off; }
        const int nig = WGM * nN, gid = wgid / nig, fm = gid * WGM, gsz = (nM - fm) < WGM ? (nM - fm) : WGM;
        u.pm = fm + ((wgid % nig) % gsz); u.pn = (wgid % nig) / gsz; return true;
    }
};

template <int MODE> struct Epi {
    static constexpr int NSTORE = (MODE == 1) ? 8 : 16;
    bf16_t* O; int ldo; const float* lb;
    __device__ __forceinline__ void operator()(const f32x4 (&acc)[2][2][4][2], const Unit& u, int wr, int wc, int fr, int fq) const {
        const int row0 = u.pm * BM + wr * 64 + fr;
        if constexpr (MODE == 1) {
            const int col0 = u.pn * 128 + wc * 32 + 8 * fq;
#pragma unroll
            for (int ai = 0; ai < 2; ++ai)
#pragma unroll
                for (int m = 0; m < 4; ++m) {
                    const f32x4 g0 = acc[ai][0][m][0], g1 = acc[ai][0][m][1], u0 = acc[ai][1][m][0], u1 = acc[ai][1][m][1];
                    u32x4 o;
                    o.x = cvt_pk_bf16(silu_f(g0[0]) * u0[0], silu_f(g0[1]) * u0[1]);
                    o.y = cvt_pk_bf16(silu_f(g0[2]) * u0[2], silu_f(g0[3]) * u0[3]);
                    o.z = cvt_pk_bf16(silu_f(g1[0]) * u1[0], silu_f(g1[1]) * u1[1]);
                    o.w = cvt_pk_bf16(silu_f(g1[2]) * u1[2], silu_f(g1[3]) * u1[3]);
                    *(u32x4*)(O + (size_t)(row0 + ai * HALF + m * 16) * ldo + col0) = o;
                    __builtin_amdgcn_sched_barrier(0);
                }
        } else {
            const int seg = u.pn >> 2;
#pragma unroll
            for (int bj = 0; bj < 2; ++bj) {
                const int col0 = u.pn * BM + bj * HALF + wc * 32 + 8 * fq;
                f32x4 l0 = {0.f, 0.f, 0.f, 0.f}, l1 = {0.f, 0.f, 0.f, 0.f};
                if (MODE == 2 && (seg == 2 || seg == 3)) { const float* lp = lb + (seg - 2) * 1024 + (col0 & 1023); l0 = *(const f32x4*)lp; l1 = *(const f32x4*)(lp + 4); }
#pragma unroll
                for (int ai = 0; ai < 2; ++ai)
#pragma unroll
                    for (int m = 0; m < 4; ++m) {
                        f32x4 v0 = acc[ai][bj][m][0], v1 = acc[ai][bj][m][1];
                        if constexpr (MODE == 3) {
#pragma unroll
                            for (int i = 0; i < 4; ++i) { v0[i] = gelu_tanh_f(v0[i]); v1[i] = gelu_tanh_f(v1[i]); }
                        }
                        if constexpr (MODE == 2) {
                            if (seg == 0 || seg == 4) {
#pragma unroll
                                for (int i = 0; i < 4; ++i) { v0[i] = silu_f(v0[i]); v1[i] = silu_f(v1[i]); }
                            } else if (seg >= 2) {
#pragma unroll
                                for (int i = 0; i < 4; ++i) {
                                    v0[i] = __logf(l0[i] + (1.f - l0[i]) * sigmoid_f(v0[i]));
                                    v1[i] = __logf(l1[i] + (1.f - l1[i]) * sigmoid_f(v1[i]));
                                }
                            }
                        }
                        u32x4 o;
                        o.x = cvt_pk_bf16(v0[0], v0[1]); o.y = cvt_pk_bf16(v0[2], v0[3]); o.z = cvt_pk_bf16(v1[0], v1[1]); o.w = cvt_pk_bf16(v1[2], v1[3]);
                        *(u32x4*)(O + (size_t)(row0 + ai * HALF + m * 16) * ldo + col0) = o;
                        __builtin_amdgcn_sched_barrier(0);
                    }
            }
        }
    }
};

template <class EpiT>
__device__ __forceinline__ void gemm_phase(LAS unsigned char* lds, const Gemm g, const StaticOrder& S, const EpiT& E) {
    const int tid = opaque_tid(), wid = __builtin_amdgcn_readfirstlane(tid >> 6), lane = tid & 63, wr = wid >> 2, wc = wid & 3, fr = lane & 15, fq = lane >> 4;
    const int K = g.K, nt = K / BK, lda = g.lda;
    unsigned voffA[2], voffB[2];
#pragma unroll
    for (int i = 0; i < 2; ++i) { int R, C; stage_rc(tid * 16 + i * 8192, R, C); const int Rb = (R & ~31) + perm32(R & 31);
        voffA[i] = (unsigned)(R * lda + C) * 2u; voffB[i] = (unsigned)(Rb * K + C) * 2u; }
    const size_t kstep = (size_t)(BK * 2);
    const size_t hstepA = (size_t)HALF * lda * 2, hstepB = (size_t)HALF * K * 2;
    const size_t tstepA = 2 * hstepA, tstepB = 2 * hstepB;
    const unsigned ldsw = (unsigned)wid * 1024u;
    const int aoff = lds_byte(wr * 64 + fr, fq * 8), boff = lds_byte(wc * 32 + fr, fq * 8);
#define PG8_SA(b, h) (((b) * 2 + (h)) * HTB)
#define PG8_SB(b, h) ((4 + (b) * 2 + (h)) * HTB)
#define PG8_STAGE(bufoff, gbase, voff) do { _Pragma("unroll") for (int _i = 0; _i < 2; ++_i) \
        __builtin_amdgcn_global_load_lds((const unsigned*)((const char*)(gbase) + (voff)[_i]), (LAS unsigned*)(lds + (bufoff) + ldsw + _i * 8192), 16, 0, 0); } while (0)
#define PG8_LDA(dst, b, h) do { _Pragma("unroll") for (int m = 0; m < 4; ++m) _Pragma("unroll") for (int k = 0; k < 2; ++k) dst[m][k] = *(const LAS bf16x8*)(lds + PG8_SA(b, h) + aoff + m * 2048 + k * 1024); } while (0)
#define PG8_LDB(dst, b, h) do { _Pragma("unroll") for (int n = 0; n < 2; ++n) _Pragma("unroll") for (int k = 0; k < 2; ++k) dst[n][k] = *(const LAS bf16x8*)(lds + PG8_SB(b, h) + boff + n * 2048 + k * 1024); } while (0)
#define PG8_MMA(ai, bj, At, Bt) do { __builtin_amdgcn_s_setprio(1); _Pragma("unroll") for (int m = 0; m < 4; ++m) _Pragma("unroll") for (int n = 0; n < 2; ++n) _Pragma("unroll") for (int k = 0; k < 2; ++k) \
        acc[ai][bj][m][n] = __builtin_amdgcn_mfma_f32_16x16x32_bf16(Bt[n][k], At[m][k], acc[ai][bj][m][n], 0, 0, 0); __builtin_amdgcn_s_setprio(0); } while (0)
#define PG8_WAIT_V(n) asm volatile("s_waitcnt vmcnt(" #n ")" ::: "memory")
#define PG8_WAIT_L(n) asm volatile("s_waitcnt lgkmcnt(" #n ")" ::: "memory")
#define PG8_BAR __builtin_amdgcn_s_barrier()
#define PG8_SCHED __builtin_amdgcn_sched_barrier(0)
    Unit cur, nxt; int ui = 0;
    if (!S.next(0, cur)) return;
    f32x4 acc[2][2][4][2];
#pragma unroll
    for (int a = 0; a < 2; ++a)
#pragma unroll
        for (int b = 0; b < 2; ++b)
#pragma unroll
            for (int m = 0; m < 4; ++m)
#pragma unroll
                for (int n = 0; n < 2; ++n) acc[a][b][m][n] = (f32x4){0.f, 0.f, 0.f, 0.f};
    bf16x8 At[4][2], B0[2][2], B1[2][2];
    const char* cA = (const char*)g.A + (size_t)cur.pm * tstepA; const char* cB = (const char*)g.Bt + (size_t)cur.pn * tstepB;
    PG8_STAGE(PG8_SB(0, 0), cB, voffB); PG8_STAGE(PG8_SB(0, 1), cB + hstepB, voffB); PG8_STAGE(PG8_SA(0, 0), cA, voffA); PG8_STAGE(PG8_SA(0, 1), cA + hstepA, voffA);
    if (wr == 1) PG8_BAR;
    PG8_WAIT_V(2); PG8_BAR;
    PG8_STAGE(PG8_SB(1, 0), cB + kstep, voffB); PG8_STAGE(PG8_SA(1, 0), cA + kstep, voffA); PG8_STAGE(PG8_SB(1, 1), cB + hstepB + kstep, voffB);
    PG8_WAIT_V(6); PG8_BAR;
    for (;;) {
        const bool has_next = S.next(ui + 1, nxt);
        const char* nA = has_next ? (const char*)g.A + (size_t)nxt.pm * tstepA : cA; const char* nB = has_next ? (const char*)g.Bt + (size_t)nxt.pn * tstepB : cB;
        for (int t = 0; t < nt; t += 2) {
            const bool last = (t == nt - 2);
            const char* a1 = cA + (size_t)(t + 1) * kstep;
            const char* a2 = last ? nA : cA + (size_t)(t + 2) * kstep; const char* b2 = last ? nB : cB + (size_t)(t + 2) * kstep;
            const char* a3 = a2 + kstep; const char* b3 = b2 + kstep;
            const int relax = __builtin_amdgcn_readfirstlane(((t == 0) && (ui > 0)) ? 1 : 0);
            PG8_LDB(B0, 0, 0); PG8_LDB(B1, 0, 1); PG8_SCHED; PG8_LDA(At, 0, 0); PG8_STAGE(PG8_SA(1, 1), a1 + hstepA, voffA);
            asm volatile("s_cmp_lg_u32 %0, 0\n\ts_cbranch_scc1 .Lrelax%=\n\ts_waitcnt vmcnt(8)\n.Lrelax%=:\n\ts_waitcnt vmcnt(%1)" :: "s"(relax), "n"(8 + EpiT::NSTORE) : "memory", "scc");
            PG8_WAIT_L(0); PG8_BAR; PG8_MMA(0, 0, At, B0); PG8_MMA(0, 1, At, B1); PG8_BAR; PG8_SCHED;
            PG8_LDA(At, 0, 1); PG8_STAGE(PG8_SB(0, 0), b2, voffB); PG8_STAGE(PG8_SB(0, 1), b2 + hstepB, voffB); PG8_STAGE(PG8_SA(0, 0), a2, voffA);
            asm volatile("s_cmp_lg_u32 %0, 0\n\ts_cbranch_scc1 .Lrelax%=\n\ts_waitcnt vmcnt(8)\n.Lrelax%=:\n\ts_waitcnt vmcnt(%1)" :: "s"(relax), "n"(8 + EpiT::NSTORE) : "memory", "scc");
            PG8_WAIT_L(0); PG8_BAR; PG8_MMA(1, 0, At, B0); PG8_MMA(1, 1, At, B1); PG8_BAR; PG8_SCHED;
            PG8_LDB(B0, 1, 0); PG8_LDB(B1, 1, 1); PG8_SCHED; PG8_LDA(At, 1, 0); PG8_STAGE(PG8_SA(0, 1), a2 + hstepA, voffA);
            PG8_WAIT_V(8); PG8_WAIT_L(0); PG8_BAR; PG8_MMA(0, 0, At, B0); PG8_MMA(0, 1, At, B1); PG8_BAR; PG8_SCHED;
            PG8_LDA(At, 1, 1); PG8_STAGE(PG8_SB(1, 0), b3, voffB); PG8_STAGE(PG8_SB(1, 1), b3 + hstepB, voffB); PG8_STAGE(PG8_SA(1, 0), a3, voffA);
            PG8_WAIT_V(8); PG8_WAIT_L(0); PG8_BAR; PG8_MMA(1, 0, At, B0); PG8_MMA(1, 1, At, B1); PG8_BAR; PG8_SCHED;
        }
        if (wr == 0) PG8_BAR;
        E(acc, cur, wr, wc, fr, fq);
        if (!has_next) break;
#pragma unroll
        for (int a = 0; a < 2; ++a)
#pragma unroll
            for (int b = 0; b < 2; ++b)
#pragma unroll
                for (int m = 0; m < 4; ++m)
#pragma unroll
                    for (int n = 0; n < 2; ++n) acc[a][b][m][n] = (f32x4){0.f, 0.f, 0.f, 0.f};
        cur = nxt; cA = nA; cB = nB; ++ui;
        if (wr == 1) PG8_BAR;
    }
    PG8_WAIT_V(0);
    PG8_BAR;
#undef PG8_SA
#undef PG8_SB
#undef PG8_STAGE
#undef PG8_LDA
#undef PG8_LDB
#undef PG8_MMA
#undef PG8_WAIT_V
#undef PG8_WAIT_L
#undef PG8_BAR
#undef PG8_SCHED
}
}

template <int MODE>
__device__ __forceinline__ void run_gemm(LAS unsigned char* lds, const bf16_t* A, int lda, const bf16_t* Bt, int M, int N, int K, bf16_t* O, int ldo, const float* lb) {
    pg8::Gemm g{A, lda, Bt, M, N, K};
    pg8::StaticOrder S; S.init(M, N, gridDim.x, blockIdx.x);
    pg8::Epi<MODE> E{O, ldo, lb};
    pg8::gemm_phase(lds, g, S, E);
}

#define XB_TMO      128
#define XB_XCNT(j)  (256  + 64 * (j))
#define XB_XSUB(j)  (1280 + 64 * (j))
#define XB_XGEN(j)  (2304 + 64 * (j))
#define XB_TOP      3328
#define XB_TOPGEN   3392
#define XCD_BAR_WORDS 3456
#define XB_SPIN_CAP (1u << 22)
__device__ __forceinline__ unsigned xb_ld(unsigned* p)              { return __hip_atomic_load(p, __ATOMIC_RELAXED, __HIP_MEMORY_SCOPE_AGENT); }
__device__ __forceinline__ unsigned xb_add(unsigned* p, unsigned v) { return __hip_atomic_fetch_add(p, v, __ATOMIC_RELAXED, __HIP_MEMORY_SCOPE_AGENT); }
__device__ __forceinline__ unsigned xb_xcc_id() { return (unsigned)__builtin_amdgcn_s_getreg((3 << 11) | 20) & 0xFu; }
#define XB_SPIN(cond, bar) do { unsigned _sp = 0; while (cond) { __builtin_amdgcn_s_sleep(1); \
    if ((++_sp & 255u) == 0u) { if (xb_ld(&(bar)[XB_TMO])) break; if (_sp > XB_SPIN_CAP) { atomicAdd(&(bar)[XB_TMO], 1u); break; } } } } while (0)
struct XcdBarrier { unsigned* bar; unsigned x; volatile LAS unsigned* st; };
__device__ __forceinline__ XcdBarrier xcd_barrier_post(unsigned* bar, volatile LAS unsigned* st) {
    XcdBarrier b; b.bar = bar; b.x = xb_xcc_id(); b.st = st;
    if (threadIdx.x == 0) (void)xb_add(&bar[XB_XCNT(b.x)], 1u);
    return b;
}
__device__ __forceinline__ void xcd_barrier_complete(unsigned* bar, unsigned x, unsigned& nloc, unsigned& nx) {
    const unsigned G = gridDim.x * gridDim.y * gridDim.z;
    unsigned sum, cnt, mine, sp = 0u;
    for (;;) {
        sum = 0u; cnt = 0u; mine = 0u;
#pragma unroll
        for (unsigned j = 0; j < 16; ++j) { const unsigned c = xb_ld(&bar[XB_XCNT(j)]); sum += c; cnt += (c > 0u) ? 1u : 0u; mine = (j == x) ? c : mine; }
        if (sum == G) break;
        __builtin_amdgcn_s_sleep(1);
        if ((++sp & 255u) == 0u) { if (xb_ld(&bar[XB_TMO])) break; if (sp > XB_SPIN_CAP) { atomicAdd(&bar[XB_TMO], 1u); break; } }
    }
    nloc = mine > 0u ? mine : 1u; nx = cnt > 0u ? cnt : 1u;
}
__device__ __forceinline__ void xcd_barrier(const XcdBarrier& b) {
    asm volatile("s_waitcnt vmcnt(0)" ::: "memory");
    __syncthreads();
    if (threadIdx.x == 0) {
        unsigned* bar = b.bar;
        __builtin_amdgcn_s_waitcnt(0);
        unsigned nloc = b.st[0], nx = b.st[1];
        if (nloc == 0u) { xcd_barrier_complete(bar, b.x, nloc, nx); b.st[0] = nloc; b.st[1] = nx; }
        const unsigned old = xb_add(&bar[XB_XSUB(b.x)], 1u);
        const unsigned gen = old / nloc;
        if (old + 1u == (gen + 1u) * nloc) {
            __builtin_amdgcn_fence(__ATOMIC_RELEASE, "agent");
            asm volatile("s_waitcnt vmcnt(0)" ::: "memory");
            const unsigned og = xb_add(&bar[XB_TOP], 1u);
            const unsigned tg = og / nx;
            if (og + 1u == (tg + 1u) * nx) xb_add(&bar[XB_TOPGEN], 1u);
            else XB_SPIN(xb_ld(&bar[XB_TOPGEN]) == tg, bar);
            __builtin_amdgcn_fence(__ATOMIC_ACQUIRE, "agent");
            xb_add(&bar[XB_XGEN(b.x)], 1u);
            asm volatile("s_waitcnt vmcnt(0)" ::: "memory");
        } else {
            XB_SPIN(xb_ld(&bar[XB_XGEN(b.x)]) == gen, bar);
            __builtin_amdgcn_fence(__ATOMIC_ACQUIRE, "agent");
            asm volatile("s_waitcnt vmcnt(0)" ::: "memory");
        }
    }
    __syncthreads();
}


__device__ __forceinline__ void p0_mod_item(const Params& p, LAS unsigned char* lds, int item) {
    const int tid = opaque_tid();
    const int layer = item / 144, cgp = item % 144, col0 = cgp * 64;
    const float* c = p.in[1]; const float* cctx = p.in[3];
    const float* W = p.in[4] + (size_t)layer * 1024 * 9216; const float* bias = p.in[5] + (size_t)layer * 9216;
    float* mout = (float*)(p.ws + WS_MOD) + (size_t)layer * 33 * 9216;
    LAS float* S = (LAS float*)lds;
    __syncthreads();
    for (int i = tid; i < 33 * 1024; i += NTHREADS) { const int r = i >> 10, k = i & 1023; const float v = r < 32 ? c[r * 1024 + k] : cctx[k]; S[i] = silu_f(v); }
    __syncthreads();
    const int col = tid & 63, ks = tid >> 6;
    float acc[33];
#pragma unroll
    for (int r = 0; r < 33; ++r) acc[r] = 0.f;
    for (int k4 = 0; k4 < 32; ++k4) {
        const int k = ks * 128 + k4 * 4;
        const float w0 = W[(size_t)(k + 0) * 9216 + col0 + col], w1 = W[(size_t)(k + 1) * 9216 + col0 + col], w2 = W[(size_t)(k + 2) * 9216 + col0 + col], w3 = W[(size_t)(k + 3) * 9216 + col0 + col];
#pragma unroll
        for (int r = 0; r < 33; ++r) { const f32x4 s4 = *(const LAS f32x4*)(S + r * 1024 + k); acc[r] += w0 * s4[0] + w1 * s4[1] + w2 * s4[2] + w3 * s4[3]; }
    }
    __syncthreads();
    LAS float* red = (LAS float*)lds;
#pragma unroll
    for (int r = 0; r < 33; ++r) red[(ks * 33 + r) * 64 + col] = acc[r];
    __syncthreads();
    for (int i = tid; i < 33 * 64; i += NTHREADS) {
        const int r = i >> 6, cc = i & 63; float s = 0.f;
#pragma unroll
        for (int q = 0; q < 8; ++q) s += red[(q * 33 + r) * 64 + cc];
        mout[(size_t)r * 9216 + col0 + cc] = s + bias[col0 + cc];
    }
    __syncthreads();
}

__device__ __forceinline__ void p0_transpose_item(const float* W, int K, int N, bf16_t* WT, int k0, int n0, int drow0, LAS float* scr, int lane) {
#pragma unroll 8
    for (int i = 0; i < 32; ++i) { const int kk = 2 * i + (lane >> 5); scr[kk * 33 + (lane & 31)] = W[(size_t)(k0 + kk) * N + n0 + (lane & 31)]; }
    asm volatile("s_waitcnt lgkmcnt(0)" ::: "memory");
    const int c = lane & 7;
#pragma unroll
    for (int j = 0; j < 4; ++j) { const int n = (lane >> 3) + 8 * j; const LAS float* s = scr + (8 * c) * 33 + n;
        u32x4 o; o.x = cvt_pk_bf16(s[0 * 33], s[1 * 33]); o.y = cvt_pk_bf16(s[2 * 33], s[3 * 33]); o.z = cvt_pk_bf16(s[4 * 33], s[5 * 33]); o.w = cvt_pk_bf16(s[6 * 33], s[7 * 33]);
        *(u32x4*)(WT + (size_t)(drow0 + n) * K + k0 + 8 * c) = o; }
    asm volatile("s_waitcnt lgkmcnt(0)" ::: "memory");
}

__device__ __forceinline__ void phase0(const Params& p, LAS unsigned char* lds) {
    const int tid = opaque_tid(), wid = tid >> 6, lane = tid & 63;
    if (blockIdx.x == 0) { unsigned* bar = (unsigned*)(p.ws + WS_BAR); for (int i = tid; i < 4096; i += NTHREADS) bar[i] = 0u; }
    if (blockIdx.x == gridDim.x - 1) {
        const float* lbp = p.in[11]; float* lbo = (float*)(p.ws + WS_LB);
        for (int i = tid; i < 2048; i += NTHREADS) { const int dir = i >> 10, col = i & 1023;
            const float l0 = lbp[(dir * 3 + 0) * 1024 + col], l1 = lbp[(dir * 3 + 1) * 1024 + col], l2 = lbp[(dir * 3 + 2) * 1024 + col];
            const float mx = fmaxf(l0, fmaxf(l1, l2)); const float e0 = __expf(l0 - mx), e1 = __expf(l1 - mx), e2 = __expf(l2 - mx);
            lbo[i] = e0 / (e0 + e1 + e2); }
    }
    if (blockIdx.x == gridDim.x - 2) {
        const float* wsp = p.in[17]; bf16_t* wsb = (bf16_t*)(p.ws + WS_WSB);
        for (int i = tid; i < 8 * 128 * 128 / 4; i += NTHREADS) { const f32x4 w = *(const f32x4*)(wsp + 4 * i); u32x2 o; o.x = cvt_pk_bf16(w[0], w[1]); o.y = cvt_pk_bf16(w[2], w[3]); *(u32x2*)(wsb + 4 * i) = o; }
    }
    for (int it = blockIdx.x; it < 288; it += gridDim.x) p0_mod_item(p, lds, it);
    __syncthreads();
    LAS float* scr = (LAS float*)lds + wid * (64 * 33);
    const int gw = blockIdx.x * 8 + wid, nw = gridDim.x * 8;
    for (int mi = 0; mi < 12; ++mi) {
        const float* W; bf16_t* WT; int K, N, mode = 0;
        if (mi < 4) { W = p.in[8] + (size_t)mi * 1024 * 5632; WT = (bf16_t*)(p.ws + WS_FIN) + (size_t)mi * 5632 * 1024; K = 1024; N = 5632; mode = 1; }
        else if (mi < 8) { W = p.in[9] + (size_t)(mi - 4) * 2816 * 1024; WT = (bf16_t*)(p.ws + WS_FOUT) + (size_t)(mi - 4) * 1024 * 2816; K = 2816; N = 1024; }
        else if (mi == 8) { W = p.in[10]; WT = (bf16_t*)(p.ws + WS_HIN); K = 1024; N = 5120; }
        else if (mi == 9) { W = p.in[13]; WT = (bf16_t*)(p.ws + WS_HOUT); K = 1024; N = 1024; }
        else if (mi == 10) { W = p.in[14]; WT = (bf16_t*)(p.ws + WS_CIN); K = 1024; N = 6144; }
        else { W = p.in[19]; WT = (bf16_t*)(p.ws + WS_COUT); K = 3072; N = 1024; }
        const int nblk = N / 32, nitems = (K / 64) * nblk;
        for (int it = gw; it < nitems; it += nw) {
            const int kb = it / nblk, nb = it % nblk, n0 = nb * 32;
            int drow0 = n0;
            if (mode == 1) { const int j = n0 < FH ? n0 : n0 - FH; drow0 = 256 * (j >> 7) + (n0 < FH ? 0 : 128) + (j & 127); }
            p0_transpose_item(W, K, N, WT, kb * 64, n0, drow0, scr, lane);
        }
    }
}

struct RowArgs {
    const float* xs_x; const float* xs_c; int nrows;
    const bf16_t* y; float ysc; const float* m; int k; const float* g; const float* b;
    float* xd; bf16_t* hd; const float* m2; int k2;
};
__device__ __forceinline__ void row_phase(const RowArgs& a) {
    const int tid0 = opaque_tid(); const int wid = tid0 >> 6, lane = tid0 & 63;
    constexpr int NR = 4;
    for (int rowb = blockIdx.x * (8 * NR) + wid; rowb < a.nrows; rowb += gridDim.x * (8 * NR)) {
        const int mrow = rowb < MX ? (rowb >> 11) : 32;
        f32x4 v[NR][4];
#pragma unroll
        for (int q = 0; q < NR; ++q) {
            const int row = rowb + 8 * q;
            const float* xr = row < MX ? a.xs_x + (size_t)row * D : a.xs_c + (size_t)(row - MX) * D;
#pragma unroll
            for (int j = 0; j < 4; ++j) v[q][j] = *(const f32x4*)(xr + j * 256 + lane * 4);
        }
        if (a.y) {
            u32x2 yy[NR][4]; f32x4 gt[4];
            const float* gp = a.m + (size_t)mrow * 9216 + (3 * a.k + 2) * 1024;
#pragma unroll
            for (int q = 0; q < NR; ++q) {
                const int row = rowb + 8 * q;
#pragma unroll
                for (int j = 0; j < 4; ++j) yy[q][j] = *(const u32x2*)(a.y + (size_t)row * D + j * 256 + lane * 4);
            }
#pragma unroll
            for (int j = 0; j < 4; ++j) gt[j] = *(const f32x4*)(gp + j * 256 + lane * 4) * a.ysc;
            float s[NR];
#pragma unroll
            for (int q = 0; q < NR; ++q) {
                s[q] = 0.f;
#pragma unroll
                for (int j = 0; j < 4; ++j) {
                    v[q][j][0] = DN_ALPHA * v[q][j][0] + gt[j][0] * bf_lo(yy[q][j].x); v[q][j][1] = DN_ALPHA * v[q][j][1] + gt[j][1] * bf_hi(yy[q][j].x);
                    v[q][j][2] = DN_ALPHA * v[q][j][2] + gt[j][2] * bf_lo(yy[q][j].y); v[q][j][3] = DN_ALPHA * v[q][j][3] + gt[j][3] * bf_hi(yy[q][j].y);
                    s[q] += (v[q][j][0] + v[q][j][1]) + (v[q][j][2] + v[q][j][3]);
                }
            }
            float mean[NR], s2[NR];
#pragma unroll
            for (int q = 0; q < NR; ++q) mean[q] = wave_sum(s[q]) * (1.f / D);
#pragma unroll
            for (int q = 0; q < NR; ++q) {
                s2[q] = 0.f;
#pragma unroll
                for (int j = 0; j < 4; ++j) { v[q][j] = v[q][j] - mean[q]; s2[q] += (v[q][j][0] * v[q][j][0] + v[q][j][1] * v[q][j][1]) + (v[q][j][2] * v[q][j][2] + v[q][j][3] * v[q][j][3]); }
            }
            f32x4 gg[4], bb[4];
#pragma unroll
            for (int j = 0; j < 4; ++j) { gg[j] = *(const f32x4*)(a.g + j * 256 + lane * 4); bb[j] = *(const f32x4*)(a.b + j * 256 + lane * 4); }
#pragma unroll
            for (int q = 0; q < NR; ++q) {
                const int row = rowb + 8 * q;
                const float rstd = __builtin_amdgcn_rsqf(wave_sum(s2[q]) * (1.f / D) + LN_EPS);
#pragma unroll
                for (int j = 0; j < 4; ++j) v[q][j] = v[q][j] * rstd * gg[j] + bb[j];
                if (a.xd && row < MX) {
#pragma unroll
                    for (int j = 0; j < 4; ++j) *(f32x4*)(a.xd + (size_t)row * D + j * 256 + lane * 4) = v[q][j];
                }
            }
        }
        if (a.hd) {
            const float* shp = a.m2 + (size_t)mrow * 9216 + (3 * a.k2) * 1024; const float* scp = shp + 1024;
            f32x4 sh[4], sc[4];
#pragma unroll
            for (int j = 0; j < 4; ++j) { sh[j] = *(const f32x4*)(shp + j * 256 + lane * 4); sc[j] = *(const f32x4*)(scp + j * 256 + lane * 4) + 1.f; }
#pragma unroll
            for (int q = 0; q < NR; ++q) {
                const int row = rowb + 8 * q;
#pragma unroll
                for (int j = 0; j < 4; ++j) {
                    const f32x4 h = v[q][j] * sc[j] + sh[j];
                    u32x2 o; o.x = cvt_pk_bf16(h[0], h[1]); o.y = cvt_pk_bf16(h[2], h[3]);
                    *(u32x2*)(a.hd + (size_t)row * D + j * 256 + lane * 4) = o;
                }
            }
        }
    }
}

constexpr int GLA_DIRB = 74240;
__device__ __forceinline__ void gla_phase(const Params& p, LAS unsigned char* lds) {
    const int tid = opaque_tid(), dir = tid >> 8, tl = tid & 255, w = tl >> 6, lane = tl & 63, fr = lane & 15, fq = lane >> 4;
    const int cp = lane, qt = w;
    bf16_t* P = (bf16_t*)(p.ws + WS_BIG); bf16_t* R = (bf16_t*)(p.ws + WS_A0);
    const float* normw = p.in[12];
    LAS unsigned char* base = lds + dir * GLA_DIRB;
    LAS bf16_t* Qin = (LAS bf16_t*)base;
    LAS bf16_t* Kin = (LAS bf16_t*)(base + 17408);
    LAS bf16_t* Sc = Kin;
    LAS bf16_t* KinT = (LAS bf16_t*)(base + 34816);
    LAS bf16_t* VT = (LAS bf16_t*)(base + 53248);
    LAS float* tot = (LAS float*)(base + 71680);
    LAS float* dec = (LAS float*)(base + 73728);
    for (int item = blockIdx.x; item < NB * 8; item += gridDim.x) {
        const int b = item >> 3, h = item & 7;
        f32x4 Sacc[8][2];
#pragma unroll
        for (int m = 0; m < 8; ++m) { Sacc[m][0] = (f32x4){0.f, 0.f, 0.f, 0.f}; Sacc[m][1] = (f32x4){0.f, 0.f, 0.f, 0.f}; }
        unsigned rq[16], rv[16], rl[16];
        auto chunk_row = [&](int ci, int t) -> size_t {
            const bool isc = ci < 4; const int lc = isc ? ci : ci - 4, L = isc ? CTXL : SEQ; const int rbase = isc ? MX + b * CTXL : b * SEQ;
            const int tok = dir == 0 ? 64 * lc + t : L - 1 - (64 * lc + t);
            return (size_t)(rbase + tok);
        };
        auto load_chunk = [&](int ci) {
            long off = (long)(chunk_row(ci, 16 * qt) * HG5 + h * 128 + 2 * cp);
            const long step = dir == 0 ? (long)HG5 : -(long)HG5;
#pragma unroll
            for (int i = 0; i < 16; ++i) {
                const bf16_t* rp = P + off;
                rq[i] = *(const unsigned*)rp; rv[i] = *(const unsigned*)(rp + 1024); rl[i] = *(const unsigned*)(rp + (2 + dir) * 1024);
                off += step; asm volatile("" : "+v"(off));
            }
        };
        __syncthreads();
        load_chunk(0);
        for (int ci = 0; ci < 36; ++ci) {
            const bool isc = ci < 4;
            {
                float run0 = 0.f, run1 = 0.f;
#pragma unroll
                for (int i = 0; i < 16; ++i) { run0 += bf_lo(rl[i]); run1 += bf_hi(rl[i]); }
                *(LAS f32x2*)(tot + qt * 128 + 2 * cp) = (f32x2){run0, run1};
#pragma unroll
                for (int hh = 0; hh < 2; ++hh) {
                    u32x4 a, c;
#pragma unroll
                    for (int u = 0; u < 4; ++u) { const int ip = 4 * hh + u;
                        a[u] = (rv[2 * ip] & 0xffffu) | (rv[2 * ip + 1] << 16); c[u] = (rv[2 * ip] >> 16) | (rv[2 * ip + 1] & 0xffff0000u); }
                    *(LAS u32x4*)(VT + (2 * cp) * 72 + 16 * qt + 8 * hh) = a;
                    *(LAS u32x4*)(VT + (2 * cp + 1) * 72 + 16 * qt + 8 * hh) = c;
                }
                lds_barrier();
                float pre0 = 0.f, pre1 = 0.f, all0 = 0.f, all1 = 0.f;
#pragma unroll
                for (int q = 0; q < 4; ++q) { const f32x2 tq = *(const LAS f32x2*)(tot + q * 128 + 2 * cp); if (q < qt) { pre0 += tq[0]; pre1 += tq[1]; } all0 += tq[0]; all1 += tq[1]; }
                if (qt == 0) *(LAS f32x2*)(dec + 2 * cp) = (f32x2){__expf(all0), __expf(all1)};
                float iebp0 = __expf(-pre0), iebp1 = __expf(-pre1);
                float bb0 = pre0, bb1 = pre1;
#pragma unroll
                for (int hh = 0; hh < 2; ++hh) {
                    u32x4 a, c;
#pragma unroll
                    for (int u4 = 0; u4 < 4; ++u4) {
                        float kin0[2], kin1[2];
#pragma unroll
                        for (int u = 0; u < 2; ++u) {
                            const int i = 8 * hh + 2 * u4 + u, t = 16 * qt + i;
                            bb0 += bf_lo(rl[i]); bb1 += bf_hi(rl[i]);
                            const float eb0 = __expf(bb0), eb1 = __expf(bb1), ieb0 = __expf(-bb0), ieb1 = __expf(-bb1);
                            const float k0 = 1.f - eb0 * iebp0, k1 = 1.f - eb1 * iebp1;
                            iebp0 = ieb0; iebp1 = ieb1;
                            kin0[u] = k0 * ieb0; kin1[u] = k1 * ieb1;
                            *(LAS unsigned*)(Qin + t * 136 + 2 * cp) = cvt_pk_bf16(bf_lo(rq[i]) * eb0, bf_hi(rq[i]) * eb1);
                            *(LAS unsigned*)(Kin + t * 136 + 2 * cp) = cvt_pk_bf16(kin0[u], kin1[u]);
                        }
                        a[u4] = cvt_pk_bf16(kin0[0], kin0[1]); c[u4] = cvt_pk_bf16(kin1[0], kin1[1]);
                    }
                    *(LAS u32x4*)(KinT + (2 * cp) * 72 + 16 * qt + 8 * hh) = a;
                    *(LAS u32x4*)(KinT + (2 * cp + 1) * 72 + 16 * qt + 8 * hh) = c;
                    __builtin_amdgcn_sched_barrier(0);
                }
            }
            lds_barrier();
            if (ci + 1 < 36) load_chunk(ci + 1);
            f32x4 sacc[4];
            if (!isc) {
                bf16x8 qf[4];
#pragma unroll
                for (int ks = 0; ks < 4; ++ks) qf[ks] = *(const LAS bf16x8*)(Qin + (16 * w + fr) * 136 + 32 * ks + 8 * fq);
#pragma unroll
                for (int ms = 0; ms < 4; ++ms) {
                    sacc[ms] = (f32x4){0.f, 0.f, 0.f, 0.f};
                    if (ms <= w) {
#pragma unroll
                        for (int ks = 0; ks < 4; ++ks) { const bf16x8 kf = *(const LAS bf16x8*)(Kin + (16 * ms + fr) * 136 + 32 * ks + 8 * fq);
                            sacc[ms] = __builtin_amdgcn_mfma_f32_16x16x32_bf16(kf, qf[ks], sacc[ms], 0, 0, 0); }
                    }
                }
            }
            lds_barrier();
            if (!isc) {
#pragma unroll
                for (int ms = 0; ms < 4; ++ms) {
                    f32x4 v = sacc[ms];
                    if (ms == w) {
#pragma unroll
                        for (int j = 0; j < 4; ++j) v[j] = (4 * fq + j <= fr) ? v[j] : 0.f;
                    }
                    u32x2 o; o.x = cvt_pk_bf16(v[0], v[1]); o.y = cvt_pk_bf16(v[2], v[3]);
                    *(LAS u32x2*)(Sc + (16 * w + fr) * 72 + 16 * ms + 4 * fq) = o;
                }
            }
            lds_barrier();
            __builtin_amdgcn_sched_barrier(0);
            bf16x8 vfrag[2][2];
#pragma unroll
            for (int n = 0; n < 2; ++n)
#pragma unroll
                for (int ks = 0; ks < 2; ++ks) vfrag[n][ks] = *(const LAS bf16x8*)(VT + (32 * w + 16 * n + fr) * 72 + 32 * ks + 8 * fq);
            if (!isc) {
                f32x4 oacc[2][4];
#pragma unroll
                for (int n = 0; n < 2; ++n)
#pragma unroll
                    for (int tt = 0; tt < 4; ++tt) oacc[n][tt] = (f32x4){0.f, 0.f, 0.f, 0.f};
#pragma unroll
                for (int kk = 0; kk < 4; ++kk) {
                    bf16x8 sf[2];
#pragma unroll
                    for (int n = 0; n < 2; ++n) {
                        u32x4 pk; pk.x = cvt_pk_bf16(Sacc[2 * kk][n][0], Sacc[2 * kk][n][1]); pk.y = cvt_pk_bf16(Sacc[2 * kk][n][2], Sacc[2 * kk][n][3]);
                        pk.z = cvt_pk_bf16(Sacc[2 * kk + 1][n][0], Sacc[2 * kk + 1][n][1]); pk.w = cvt_pk_bf16(Sacc[2 * kk + 1][n][2], Sacc[2 * kk + 1][n][3]);
                        sf[n] = __builtin_bit_cast(bf16x8, pk);
                    }
#pragma unroll
                    for (int tt = 0; tt < 4; ++tt) {
                        const LAS bf16_t* qp = Qin + (16 * tt + fr) * 136 + 32 * kk + 4 * fq;
                        const u32x2 lo = *(const LAS u32x2*)qp, hi = *(const LAS u32x2*)(qp + 16);
                        const bf16x8 qfr = __builtin_bit_cast(bf16x8, ((u32x4){lo.x, lo.y, hi.x, hi.y}));
#pragma unroll
                        for (int n = 0; n < 2; ++n) oacc[n][tt] = __builtin_amdgcn_mfma_f32_16x16x32_bf16(sf[n], qfr, oacc[n][tt], 0, 0, 0);
                    }
                }
                __builtin_amdgcn_sched_barrier(0);
#pragma unroll
                for (int tt = 0; tt < 4; ++tt)
#pragma unroll
                    for (int ks = 0; ks < 2; ++ks) {
                        if (ks == 1 && tt < 2) continue;
                        const bf16x8 scf = *(const LAS bf16x8*)(Sc + (16 * tt + fr) * 72 + 32 * ks + 8 * fq);
#pragma unroll
                        for (int n = 0; n < 2; ++n) oacc[n][tt] = __builtin_amdgcn_mfma_f32_16x16x32_bf16(vfrag[n][ks], scf, oacc[n][tt], 0, 0, 0);
                    }
                __builtin_amdgcn_sched_barrier(0);
#pragma unroll
                for (int tt = 0; tt < 4; ++tt) {
                    bf16_t* op = P + chunk_row(ci, 16 * tt + fr) * HG5 + (2 + dir) * 1024 + h * 128 + 32 * w + 4 * fq;
#pragma unroll
                    for (int n = 0; n < 2; ++n) { u32x2 o; o.x = cvt_pk_bf16(oacc[n][tt][0], oacc[n][tt][1]); o.y = cvt_pk_bf16(oacc[n][tt][2], oacc[n][tt][3]); *(u32x2*)(op + 16 * n) = o; }
                }
            }
            __builtin_amdgcn_sched_barrier(0);
#pragma unroll
            for (int m = 0; m < 8; ++m) {
#pragma unroll
                for (int ks = 0; ks < 2; ++ks) { const bf16x8 kf = *(const LAS bf16x8*)(KinT + (16 * m + fr) * 72 + 32 * ks + 8 * fq);
#pragma unroll
                    for (int n = 0; n < 2; ++n) Sacc[m][n] = __builtin_amdgcn_mfma_f32_16x16x32_bf16(kf, vfrag[n][ks], Sacc[m][n], 0, 0, 0); }
                const f32x4 dv = *(const LAS f32x4*)(dec + 16 * m + 4 * fq);
                Sacc[m][0] *= dv; Sacc[m][1] *= dv;
            }
            lds_barrier();
        }
        __syncthreads();
        {
            const int wid = tid >> 6, lane = tid & 63, sub = lane >> 4, l16 = lane & 15;
            const f32x4 w0 = *(const f32x4*)(normw + 8 * l16), w1 = *(const f32x4*)(normw + 8 * l16 + 4);
            for (int it0 = 0; it0 < 64; it0 += 8) {
                u32x4 of[8], ob[8], gg[8];
#pragma unroll
                for (int u = 0; u < 8; ++u) {
                    const int t = (it0 + u) * 32 + wid * 4 + sub; const bf16_t* rp = P + ((size_t)b * SEQ + t) * HG5 + h * 128 + 8 * l16;
                    of[u] = *(const u32x4*)(rp + 2048); ob[u] = *(const u32x4*)(rp + 3072); gg[u] = *(const u32x4*)(rp + 4096);
                }
#pragma unroll
                for (int u = 0; u < 8; ++u) {
                    const int t = (it0 + u) * 32 + wid * 4 + sub; const size_t row = (size_t)b * SEQ + t;
                    float o[8];
                    o[0] = bf_lo(of[u].x) + bf_lo(ob[u].x); o[1] = bf_hi(of[u].x) + bf_hi(ob[u].x); o[2] = bf_lo(of[u].y) + bf_lo(ob[u].y); o[3] = bf_hi(of[u].y) + bf_hi(ob[u].y);
                    o[4] = bf_lo(of[u].z) + bf_lo(ob[u].z); o[5] = bf_hi(of[u].z) + bf_hi(ob[u].z); o[6] = bf_lo(of[u].w) + bf_lo(ob[u].w); o[7] = bf_hi(of[u].w) + bf_hi(ob[u].w);
                    float ss = 0.f;
#pragma unroll
                    for (int i = 0; i < 8; ++i) ss += o[i] * o[i];
                    ss += __shfl_xor(ss, 1); ss += __shfl_xor(ss, 2); ss += __shfl_xor(ss, 4); ss += __shfl_xor(ss, 8);
                    const float rs = __builtin_amdgcn_rsqf(ss * (1.f / 128.f) + RMS_EPS);
                    u32x4 r;
                    r.x = cvt_pk_bf16(o[0] * rs * w0[0] * bf_lo(gg[u].x), o[1] * rs * w0[1] * bf_hi(gg[u].x));
                    r.y = cvt_pk_bf16(o[2] * rs * w0[2] * bf_lo(gg[u].y), o[3] * rs * w0[3] * bf_hi(gg[u].y));
                    r.z = cvt_pk_bf16(o[4] * rs * w1[0] * bf_lo(gg[u].z), o[5] * rs * w1[1] * bf_hi(gg[u].z));
                    r.w = cvt_pk_bf16(o[6] * rs * w1[2] * bf_lo(gg[u].w), o[7] * rs * w1[3] * bf_hi(gg[u].w));
                    *(u32x4*)(R + row * D + h * 128 + 8 * l16) = r;
                }
            }
        }
        __syncthreads();
    }
}

__device__ __forceinline__ void cm_gate_phase(const Params& p, LAS unsigned char* lds) {
    const int tid = opaque_tid(), wid = tid >> 6, lane = tid & 63, fr = lane & 15, fq = lane >> 4;
    bf16_t* UV = (bf16_t*)(p.ws + WS_BIG);
    const float* vg = p.in[15]; const float* vb = p.in[16]; const float* bs = p.in[18];
    const bf16_t* WSB = (const bf16_t*)(p.ws + WS_WSB);
    LAS bf16_t* Wl = (LAS bf16_t*)lds; LAS bf16_t* Vl = (LAS bf16_t*)(lds + 34816); LAS float* st = (LAS float*)(lds + 34816 + 100352); LAS float* bl = st + 256;
    const int c8 = lane < 48 ? lane : 47;
    for (int ch = blockIdx.x; ch < MX / 128; ch += gridDim.x) {
        const size_t row0 = (size_t)ch * 128;
        __syncthreads();
        for (int rr = 0; rr < 8; ++rr) {
            const int r = wid * 16 + 2 * rr; const bf16_t* vp = UV + (row0 + r) * 6144 + 3072;
            u32x4 x[2][6]; float s[2] = {0.f, 0.f};
#pragma unroll
            for (int q = 0; q < 2; ++q)
#pragma unroll
                for (int i = 0; i < 6; ++i) x[q][i] = *(const u32x4*)(vp + (size_t)q * 6144 + (i * 64 + lane) * 8);
#pragma unroll
            for (int q = 0; q < 2; ++q)
#pragma unroll
                for (int i = 0; i < 6; ++i) s[q] += (bf_lo(x[q][i].x) + bf_hi(x[q][i].x)) + (bf_lo(x[q][i].y) + bf_hi(x[q][i].y)) + (bf_lo(x[q][i].z) + bf_hi(x[q][i].z)) + (bf_lo(x[q][i].w) + bf_hi(x[q][i].w));
            float mean[2], s2[2] = {0.f, 0.f};
#pragma unroll
            for (int q = 0; q < 2; ++q) mean[q] = wave_sum(s[q]) * (1.f / 3072.f);
#pragma unroll
            for (int q = 0; q < 2; ++q)
#pragma unroll
                for (int i = 0; i < 6; ++i) { float d;
                    d = bf_lo(x[q][i].x) - mean[q]; s2[q] += d * d; d = bf_hi(x[q][i].x) - mean[q]; s2[q] += d * d; d = bf_lo(x[q][i].y) - mean[q]; s2[q] += d * d; d = bf_hi(x[q][i].y) - mean[q]; s2[q] += d * d;
                    d = bf_lo(x[q][i].z) - mean[q]; s2[q] += d * d; d = bf_hi(x[q][i].z) - mean[q]; s2[q] += d * d; d = bf_lo(x[q][i].w) - mean[q]; s2[q] += d * d; d = bf_hi(x[q][i].w) - mean[q]; s2[q] += d * d; }
#pragma unroll
            for (int q = 0; q < 2; ++q) { const float rstd = __builtin_amdgcn_rsqf(wave_sum(s2[q]) * (1.f / 3072.f) + LN_EPS); if (lane == 0) { st[2 * (r + q)] = mean[q]; st[2 * (r + q) + 1] = rstd; } }
        }
        for (int g = 0; g < 8; ++g) {
            lds_barrier();
#pragma unroll
            for (int i = 0; i < 4; ++i) { const int idx = tid + NTHREADS * i, r = idx >> 4, cc = idx & 15;
                *(LAS u32x4*)(Wl + r * 136 + cc * 8) = *(const u32x4*)(WSB + (size_t)g * 16384 + r * 128 + cc * 8); }
            if (tid < 128) bl[tid] = bs[g * 128 + tid];
            {
                const float* gp = vg + g * 384 + c8 * 8; const float* bp = vb + g * 384 + c8 * 8;
                const f32x4 g0 = *(const f32x4*)gp, g1 = *(const f32x4*)(gp + 4), b0 = *(const f32x4*)bp, b1 = *(const f32x4*)(bp + 4);
                size_t xo = (row0 + wid) * 6144 + 3072 + g * 384 + c8 * 8;
#pragma unroll
                for (int hb = 0; hb < 2; ++hb) {
                    u32x4 xv[8];
#pragma unroll
                    for (int i = 0; i < 8; ++i) { xv[i] = *(const u32x4*)(UV + xo); xo += 8 * 6144; asm volatile("" : "+v"(xo)); }
#pragma unroll
                    for (int i = 0; i < 8; ++i) { const int sr = wid + 8 * (8 * hb + i);
                        const f32x2 ms = *(const LAS f32x2*)(st + 2 * sr); const float mean = ms[0], rstd = ms[1]; const u32x4 x = xv[i];
                        u32x4 o;
                        o.x = cvt_pk_bf16((bf_lo(x.x) - mean) * rstd * g0[0] + b0[0], (bf_hi(x.x) - mean) * rstd * g0[1] + b0[1]);
                        o.y = cvt_pk_bf16((bf_lo(x.y) - mean) * rstd * g0[2] + b0[2], (bf_hi(x.y) - mean) * rstd * g0[3] + b0[3]);
                        o.z = cvt_pk_bf16((bf_lo(x.z) - mean) * rstd * g1[0] + b1[0], (bf_hi(x.z) - mean) * rstd * g1[1] + b1[1]);
                        o.w = cvt_pk_bf16((bf_lo(x.w) - mean) * rstd * g1[2] + b1[2], (bf_hi(x.w) - mean) * rstd * g1[3] + b1[3]);
                        if (lane < 48) *(LAS u32x4*)(Vl + sr * 392 + c8 * 8) = o; }
                }
            }
            lds_barrier();
#pragma unroll 1
            for (int n = 0; n < 3; ++n) {
                size_t uo = (row0 + fr) * 6144 + g * 384 + wid * 48 + n * 16 + 4 * fq;
                u32x2 uu[8];
#pragma unroll
                for (int m = 0; m < 8; ++m) { uu[m] = *(const u32x2*)(UV + uo); uo += 16 * 6144; asm volatile("" : "+v"(uo)); }
                f32x4 acc[8];
#pragma unroll
                for (int m = 0; m < 8; ++m) acc[m] = (f32x4){0.f, 0.f, 0.f, 0.f};
#pragma unroll
                for (int ks = 0; ks < 4; ++ks) {
                    bf16x8 af;
                    const LAS bf16_t* vp = Vl + (32 * ks + 8 * fq) * 392 + wid * 48 + n * 16 + fr;
#pragma unroll
                    for (int i = 0; i < 8; ++i) af[i] = (short)vp[i * 392];
#pragma unroll
                    for (int m = 0; m < 8; ++m) {
                        const bf16x8 bfrag = *(const LAS bf16x8*)(Wl + (16 * m + fr) * 136 + 32 * ks + 8 * fq);
                        acc[m] = __builtin_amdgcn_mfma_f32_16x16x32_bf16(af, bfrag, acc[m], 0, 0, 0);
                    }
                }
                size_t zo = (row0 + fr) * 6144 + g * 384 + wid * 48 + n * 16 + 4 * fq;
#pragma unroll
                for (int m = 0; m < 8; ++m) {
                    const float bias = bl[16 * m + fr];
                    const u32x2 u2 = uu[m];
                    u32x2 o; o.x = cvt_pk_bf16(bf_lo(u2.x) * (acc[m][0] + bias), bf_hi(u2.x) * (acc[m][1] + bias));
                    o.y = cvt_pk_bf16(bf_lo(u2.y) * (acc[m][2] + bias), bf_hi(u2.y) * (acc[m][3] + bias));
                    *(u32x2*)(UV + zo) = o;
                    zo += 16 * 6144; asm volatile("" : "+v"(zo));
                }
            }
        }
    }
}

#ifndef EN_MASK
#define EN_MASK 255
#endif
constexpr int EN = EN_MASK;
#ifndef PROBE_KINDS
#define PROBE_KINDS 0
#endif
#ifndef PROBE_K
#define PROBE_K 4
#endif
__global__ void __launch_bounds__(NTHREADS, 2) fwd_megakernel(Params p) {
    extern __shared__ __attribute__((aligned(16))) unsigned char lds_raw[];
    LAS unsigned char* lds = (LAS unsigned char*)lds_raw;
    cg::grid_group grid = cg::this_grid();
    volatile LAS unsigned* xst = (volatile LAS unsigned*)(lds + LDS_BYTES - 16);
    if (threadIdx.x == 0) { xst[0] = 0u; xst[1] = 0u; }
    XcdBarrier xb; xb.bar = (unsigned*)(p.ws + WS_BAR); xb.x = 0; xb.st = xst;
    const float* x_in = p.in[0]; const float* ctx_in = p.in[2];
    const float* mod0 = (const float*)(p.ws + WS_MOD); const float* mod1 = mod0 + (size_t)33 * 9216;
    const float* lbv = (const float*)(p.ws + WS_LB);
    const float* ln_g = p.in[6]; const float* ln_b = p.in[7];
    bf16_t* A0 = (bf16_t*)(p.ws + WS_A0); bf16_t* BIG = (bf16_t*)(p.ws + WS_BIG);
    const bf16_t* FIN = (const bf16_t*)(p.ws + WS_FIN); const bf16_t* FOUT = (const bf16_t*)(p.ws + WS_FOUT);
    const bf16_t* HIN = (const bf16_t*)(p.ws + WS_HIN); const bf16_t* HOUT = (const bf16_t*)(p.ws + WS_HOUT);
    const bf16_t* CIN = (const bf16_t*)(p.ws + WS_CIN); const bf16_t* COUT = (const bf16_t*)(p.ws + WS_COUT);
    const size_t FIN_SZ = (size_t)5632 * 1024, FOUT_SZ = (size_t)1024 * 2816;
    long long probe_acc = 0;
    for (int ph = p.ph_lo; ph < p.ph_hi; ++ph) {
        const long long probe_t0 = PROBE_KINDS ? wall_clock64() : 0;
        int kind;
        switch (ph) {
        case 0: kind = 0; break;
        case 1: case 4: case 8: case 11: case 14: case 18: case 21: kind = 1; break;
        case 2: case 9: case 12: case 19: kind = 2; break;
        case 3: case 7: case 10: case 13: case 17: case 20: kind = 3; break;
        case 5: kind = 4; break;
        case 6: kind = 5; break;
        case 15: kind = 6; break;
        default: kind = 7; break;
        }
        if (kind == 0) { if (EN & 1) phase0(p, lds); }
        else if (kind == 1) {
            RowArgs a;
            a.xs_x = p.out; a.xs_c = nullptr; a.nrows = MX; a.y = A0; a.ysc = 0.5f; a.xd = p.out; a.hd = A0;
            if (ph == 1) { a.xs_x = x_in; a.xs_c = ctx_in; a.nrows = MT; a.y = nullptr; a.m = mod0; a.k = 0; a.g = ln_g; a.b = ln_b; a.m2 = mod0; a.k2 = 0; }
            else if (ph == 4) { a.xs_x = x_in; a.xs_c = ctx_in; a.nrows = MT; a.m = mod0; a.k = 0; a.g = ln_g + 0 * D; a.b = ln_b + 0 * D; a.m2 = mod0; a.k2 = 1; }
            else if (ph == 8) { a.y = BIG; a.ysc = 1.f; a.m = mod0; a.k = 1; a.g = ln_g + 1 * D; a.b = ln_b + 1 * D; a.m2 = mod0; a.k2 = 2; }
            else if (ph == 11) { a.m = mod0; a.k = 2; a.g = ln_g + 2 * D; a.b = ln_b + 2 * D; a.m2 = mod1; a.k2 = 0; }
            else if (ph == 14) { a.m = mod1; a.k = 0; a.g = ln_g + 3 * D; a.b = ln_b + 3 * D; a.m2 = mod1; a.k2 = 1; }
            else if (ph == 18) { a.ysc = 1.f; a.m = mod1; a.k = 1; a.g = ln_g + 4 * D; a.b = ln_b + 4 * D; a.m2 = mod1; a.k2 = 2; }
            else { a.m = mod1; a.k = 2; a.g = ln_g + 5 * D; a.b = ln_b + 5 * D; a.hd = nullptr; a.m2 = mod1; a.k2 = 0; }
            if (EN & 2) row_phase(a);
        } else if (kind == 2) {
            const int wi = ph == 2 ? 0 : (ph == 9 ? 1 : (ph == 12 ? 2 : 3));
            if (EN & 4) run_gemm<1>(lds, A0, D, FIN + wi * FIN_SZ, ph == 2 ? MT : MX, 2 * FH, D, BIG, FH, nullptr);
        } else if (kind == 3) {
            const bf16_t* A = BIG; int lda = FH, M = MX, K = FH; const bf16_t* Bt; bf16_t* O = A0;
            if (ph == 3) { Bt = FOUT; M = MT; }
            else if (ph == 7) { A = A0; lda = D; K = D; Bt = HOUT; O = BIG; }
            else if (ph == 10) Bt = FOUT + 1 * FOUT_SZ;
            else if (ph == 13) Bt = FOUT + 2 * FOUT_SZ;
            else if (ph == 17) { lda = 2 * CMI; K = CMI; Bt = COUT; }
            else Bt = FOUT + 3 * FOUT_SZ;
            if (EN & 8) run_gemm<0>(lds, A, lda, Bt, M, D, K, O, D, nullptr);
        } else if (kind == 4) { if (EN & 16) run_gemm<2>(lds, A0, D, HIN, MT, HG5, D, BIG, HG5, lbv); }
        else if (kind == 5) { if (EN & 32) gla_phase(p, lds); }
        else if (kind == 6) { if (EN & 64) run_gemm<3>(lds, A0, D, CIN, MX, 2 * CMI, D, BIG, 2 * CMI, nullptr); }
        else { if (EN & 128) cm_gate_phase(p, lds); }
        if (ph + 1 < p.ph_hi) {
            if (ph == 0) { grid.sync(); xb = xcd_barrier_post((unsigned*)(p.ws + WS_BAR), xst); }
            else xcd_barrier(xb);
        }
        if (PROBE_KINDS && ((PROBE_KINDS >> kind) & 1)) probe_acc += wall_clock64() - probe_t0;
    }
    if (PROBE_KINDS && blockIdx.x == 0 && threadIdx.x == 0) { const long long te = wall_clock64(); while (wall_clock64() - te < PROBE_K * probe_acc) __builtin_amdgcn_s_sleep(8); }
}

extern "C" void kernel_launch(void* const* d_in, const int* in_sizes, int n_in, void* d_out, int out_size, void* d_ws, size_t ws_size, hipStream_t stream) {
    static int grid_blocks = 0;
    if (grid_blocks == 0) {
        if (n_in != 20 || out_size != MX * D || ws_size < WS_END) { fprintf(stderr, "kernel_launch: unexpected shapes (n_in %d out %d ws %zu need %zu)\n", n_in, out_size, ws_size, (size_t)WS_END); grid_blocks = -1; return; }
        int dev = 0, cus = 0, per_cu = 0;
        hipGetDevice(&dev);
        hipDeviceGetAttribute(&cus, hipDeviceAttributeMultiprocessorCount, dev);
        if (hipFuncSetAttribute((const void*)fwd_megakernel, hipFuncAttributeMaxDynamicSharedMemorySize, LDS_BYTES) != hipSuccess) { fprintf(stderr, "kernel_launch: hipFuncSetAttribute failed\n"); grid_blocks = -1; return; }
        if (hipOccupancyMaxActiveBlocksPerMultiprocessor(&per_cu, (const void*)fwd_megakernel, NTHREADS, LDS_BYTES) != hipSuccess || per_cu < 1) { fprintf(stderr, "kernel_launch: occupancy query says %d\n", per_cu); per_cu = 1; }
        (void)hipGetLastError();
        grid_blocks = cus * 1;
    }
    if (grid_blocks < 0) return;
    Params p{};
    for (int i = 0; i < 20; ++i) p.in[i] = (const float*)d_in[i];
    p.out = (float*)d_out; p.ws = (unsigned char*)d_ws; p.ph_lo = 0; p.ph_hi = 22;
    void* args[] = {&p};
    hipError_t e = hipLaunchCooperativeKernel((const void*)fwd_megakernel, dim3(grid_blocks), dim3(NTHREADS), args, LDS_BYTES, stream);
    if (e != hipSuccess) fprintf(stderr, "cooperative launch failed: %s (grid %d)\n", hipGetErrorString(e), grid_blocks);
}
```

```cpp
#include <hip/hip_runtime.h>
#include <hip/hip_cooperative_groups.h>
#include <cstdio>
#include <cstdint>
namespace cg = cooperative_groups;

#define LAS __attribute__((address_space(3)))
typedef unsigned short bf16_t;
typedef short bf16x8 __attribute__((ext_vector_type(8)));
typedef float f32x4 __attribute__((ext_vector_type(4)));
typedef float f32x2 __attribute__((ext_vector_type(2)));
typedef unsigned u32x4 __attribute__((ext_vector_type(4)));
typedef unsigned u32x2 __attribute__((ext_vector_type(2)));

constexpr int D = 1024, NB = 32, SEQ = 2048, CTXL = 256;
constexpr int MX = NB * SEQ;
constexpr int MC = NB * CTXL;
constexpr int MT = MX + MC;
constexpr int FH = 2816, HG5 = 5 * D, CMI = 3072, NMOD = 9;
constexpr float DN_ALPHA = 1.41421356237309515f;
constexpr float LN_EPS = 1e-5f, RMS_EPS = 1e-6f;
constexpr int LDS_BYTES = 149504;
constexpr int NTHREADS = 512;

constexpr size_t WS_MOD = 0;
constexpr size_t WS_LB = WS_MOD + (size_t)2 * 33 * 9216 * 4;
constexpr size_t WS_BAR = WS_LB + 2 * 1024 * 4;
constexpr size_t WS_FIN = WS_BAR + 4096 * 4;
constexpr size_t WS_FOUT = WS_FIN + (size_t)4 * 5632 * 1024 * 2;
constexpr size_t WS_HIN = WS_FOUT + (size_t)4 * 1024 * 2816 * 2;
constexpr size_t WS_HOUT = WS_HIN + (size_t)5120 * 1024 * 2;
constexpr size_t WS_CIN = WS_HOUT + (size_t)1024 * 1024 * 2;
constexpr size_t WS_COUT = WS_CIN + (size_t)6144 * 1024 * 2;
constexpr size_t WS_WSB = WS_COUT + (size_t)1024 * 3072 * 2;
constexpr size_t WS_A0 = WS_WSB + (size_t)8 * 128 * 128 * 2;
constexpr size_t WS_BIG = WS_A0 + (size_t)MT * 1024 * 2;
constexpr size_t WS_END = WS_BIG + (size_t)MX * 6144 * 2;

struct Params {
    const float* in[20];
    float* out;
    unsigned char* ws;
    int ph_lo, ph_hi;
};

__device__ __forceinline__ unsigned cvt_pk_bf16(float lo, float hi) { unsigned r; asm volatile("v_cvt_pk_bf16_f32 %0, %1, %2" : "=v"(r) : "v"(lo), "v"(hi)); return r; }
__device__ __forceinline__ int opaque_tid() { int t = threadIdx.x; asm volatile("" : "+v"(t)); return t; }
__device__ __forceinline__ void lds_barrier() { asm volatile("s_waitcnt lgkmcnt(0)" ::: "memory"); __builtin_amdgcn_s_barrier(); asm volatile("" ::: "memory"); }
__device__ __forceinline__ float bf_lo(unsigned u) { return __uint_as_float(u << 16); }
__device__ __forceinline__ float bf_hi(unsigned u) { return __uint_as_float(u & 0xffff0000u); }
__device__ __forceinline__ float wave_sum(float v) {
#pragma unroll
    for (int o = 1; o < 64; o <<= 1) v += __shfl_xor(v, o);
    return v;
}
__device__ __forceinline__ float sigmoid_f(float x) { return __builtin_amdgcn_rcpf(1.f + __expf(-x)); }
__device__ __forceinline__ float silu_f(float x) { return x * sigmoid_f(x); }
__device__ __forceinline__ float gelu_tanh_f(float x) { const float u = 0.7978845608028654f * (x + 0.044715f * x * x * x); return x * sigmoid_f(2.f * u); }

namespace pg8 {
constexpr int BM = 256, BK = 64, HALF = 128, HTB = HALF * BK * 2, STAGE_BYTES = 8 * HTB, NXCD = 8, WGM = 8;
__host__ __device__ __forceinline__ int lds_byte(int r, int c) { const int st = (r >> 4) * 2 + (c >> 5), rr = r & 15, cc = c & 31, ob = rr * 64 + cc * 2; return st * 1024 + (ob ^ (((ob >> 9) & 1) << 5)); }
__host__ __device__ __forceinline__ void stage_rc(int b, int& R, int& C) { const int st = b / 1024, sb = b % 1024, swz = sb ^ (((sb >> 9) & 1) << 5); R = (st >> 1) * 16 + swz / 64; C = (st & 1) * 32 + (swz % 64) / 2; }
__host__ __device__ __forceinline__ int perm32(int rho) { const int n = rho >> 4, i = rho & 15; return 8 * (i >> 2) + 4 * n + (i & 3); }

struct Unit { int pm, pn; };
struct Gemm { const bf16_t* A; int lda; const bf16_t* Bt; int M, N, K; };

struct StaticOrder {
    int nM, nN, nwg, G, c;
    __device__ void init(int M, int N, int G_, int c_) { nM = M / BM; nN = N / BM; nwg = nM * nN; G = G_; c = c_; }
    __device__ bool next(int i, Unit& u) const {
        const long L = (long)i * G + c; if (L >= nwg) return false;
        int wgid = (int)L; { const int q = nwg / NXCD, r = nwg % NXCD, xcd = wgid % NXCD, off = wgid / NXCD; wgid = (xcd < r ? xcd * (q + 1) : r * (q + 1) + (xcd - r) * q) + off; }
        const int nig = WGM * nN, gid = wgid / nig, fm = gid * WGM, gsz = (nM - fm) < WGM ? (nM - fm) : WGM;
        u.pm = fm + ((wgid % nig) % gsz); u.pn = (wgid % nig) / gsz; return true;
    }
};

template <int MODE> struct Epi {
    bf16_t* O; int ldo; const float* lb;
    __device__ __forceinline__ void operator()(const f32x4 (&acc)[2][2][4][2], const Unit& u, int wr, int wc, int fr, int fq) const {
        const int row0 = u.pm * BM + wr * 64 + fr;
        if constexpr (MODE == 1) {
            const int col0 = u.pn * 128 + wc * 32 + 8 * fq;
#pragma unroll
            for (int ai = 0; ai < 2; ++ai)
#pragma unroll
                for (int m = 0; m < 4; ++m) {
                    const f32x4 g0 = acc[ai][0][m][0], g1 = acc[ai][0][m][1], u0 = acc[ai][1][m][0], u1 = acc[ai][1][m][1];
                    u32x4 o;
                    o.x = cvt_pk_bf16(silu_f(g0[0]) * u0[0], silu_f(g0[1]) * u0[1]);
                    o.y = cvt_pk_bf16(silu_f(g0[2]) * u0[2], silu_f(g0[3]) * u0[3]);
                    o.z = cvt_pk_bf16(silu_f(g1[0]) * u1[0], silu_f(g1[1]) * u1[1]);
                    o.w = cvt_pk_bf16(silu_f(g1[2]) * u1[2], silu_f(g1[3]) * u1[3]);
                    *(u32x4*)(O + (size_t)(row0 + ai * HALF + m * 16) * ldo + col0) = o;
                    __builtin_amdgcn_sched_barrier(0);
                }
        } else {
            const int seg = u.pn >> 2;
#pragma unroll
            for (int bj = 0; bj < 2; ++bj) {
                const int col0 = u.pn * BM + bj * HALF + wc * 32 + 8 * fq;
                f32x4 l0 = {0.f, 0.f, 0.f, 0.f}, l1 = {0.f, 0.f, 0.f, 0.f};
                if (MODE == 2 && (seg == 2 || seg == 3)) { const float* lp = lb + (seg - 2) * 1024 + (col0 & 1023); l0 = *(const f32x4*)lp; l1 = *(const f32x4*)(lp + 4); }
#pragma unroll
                for (int ai = 0; ai < 2; ++ai)
#pragma unroll
                    for (int m = 0; m < 4; ++m) {
                        f32x4 v0 = acc[ai][bj][m][0], v1 = acc[ai][bj][m][1];
                        if constexpr (MODE == 3) {
#pragma unroll
                            for (int i = 0; i < 4; ++i) { v0[i] = gelu_tanh_f(v0[i]); v1[i] = gelu_tanh_f(v1[i]); }
                        }
                        if constexpr (MODE == 2) {
                            if (seg == 0 || seg == 4) {
#pragma unroll
                                for (int i = 0; i < 4; ++i) { v0[i] = silu_f(v0[i]); v1[i] = silu_f(v1[i]); }
                            } else if (seg >= 2) {
#pragma unroll
                                for (int i = 0; i < 4; ++i) {
                                    v0[i] = __logf(l0[i] + (1.f - l0[i]) * sigmoid_f(v0[i]));
                                    v1[i] = __logf(l1[i] + (1.f - l1[i]) * sigmoid_f(v1[i]));
                                }
                            }
                        }
                        u32x4 o;
                        o.x = cvt_pk_bf16(v0[0], v0[1]); o.y = cvt_pk_bf16(v0[2], v0[3]); o.z = cvt_pk_bf16(v1[0], v1[1]); o.w = cvt_pk_bf16(v1[2], v1[3]);
                        *(u32x4*)(O + (size_t)(row0 + ai * HALF + m * 16) * ldo + col0) = o;
                        __builtin_amdgcn_sched_barrier(0);
                    }
            }
        }
    }
};

template <class EpiT>
__device__ __forceinline__ void gemm_phase(LAS unsigned char* lds, const Gemm g, const StaticOrder& S, const EpiT& E) {
    const int tid = opaque_tid(), wid = __builtin_amdgcn_readfirstlane(tid >> 6), lane = tid & 63, wr = wid >> 2, wc = wid & 3, fr = lane & 15, fq = lane >> 4;
    const int K = g.K, nt = K / BK, lda = g.lda;
    unsigned voffA[2], voffB[2];
#pragma unroll
    for (int i = 0; i < 2; ++i) { int R, C; stage_rc(tid * 16 + i * 8192, R, C); const int Rb = (R & ~31) + perm32(R & 31);
        voffA[i] = (unsigned)(R * lda + C) * 2u; voffB[i] = (unsigned)(Rb * K + C) * 2u; }
    const size_t kstep = (size_t)(BK * 2);
    const size_t hstepA = (size_t)HALF * lda * 2, hstepB = (size_t)HALF * K * 2;
    const size_t tstepA = 2 * hstepA, tstepB = 2 * hstepB;
    const unsigned ldsw = (unsigned)wid * 1024u;
    const int aoff = lds_byte(wr * 64 + fr, fq * 8), boff = lds_byte(wc * 32 + fr, fq * 8);
#define PG8_SA(b, h) (((b) * 2 + (h)) * HTB)
#define PG8_SB(b, h) ((4 + (b) * 2 + (h)) * HTB)
#define PG8_STAGE(bufoff, gbase, voff) do { _Pragma("unroll") for (int _i = 0; _i < 2; ++_i) \
        __builtin_amdgcn_global_load_lds((const unsigned*)((const char*)(gbase) + (voff)[_i]), (LAS unsigned*)(lds + (bufoff) + ldsw + _i * 8192), 16, 0, 0); } while (0)
#define PG8_LDA(dst, b, h) do { _Pragma("unroll") for (int m = 0; m < 4; ++m) _Pragma("unroll") for (int k = 0; k < 2; ++k) dst[m][k] = *(const LAS bf16x8*)(lds + PG8_SA(b, h) + aoff + m * 2048 + k * 1024); } while (0)
#define PG8_LDB(dst, b, h) do { _Pragma("unroll") for (int n = 0; n < 2; ++n) _Pragma("unroll") for (int k = 0; k < 2; ++k) dst[n][k] = *(const LAS bf16x8*)(lds + PG8_SB(b, h) + boff + n * 2048 + k * 1024); } while (0)
#define PG8_MMA(ai, bj, At, Bt) do { __builtin_amdgcn_s_setprio(1); _Pragma("unroll") for (int m = 0; m < 4; ++m) _Pragma("unroll") for (int n = 0; n < 2; ++n) _Pragma("unroll") for (int k = 0; k < 2; ++k) \
        acc[ai][bj][m][n] = __builtin_amdgcn_mfma_f32_16x16x32_bf16(Bt[n][k], At[m][k], acc[ai][bj][m][n], 0, 0, 0); __builtin_amdgcn_s_setprio(0); } while (0)
#define PG8_WAIT_V(n) asm volatile("s_waitcnt vmcnt(" #n ")" ::: "memory")
#define PG8_WAIT_L(n) asm volatile("s_waitcnt lgkmcnt(" #n ")" ::: "memory")
#define PG8_BAR __builtin_amdgcn_s_barrier()
#define PG8_SCHED __builtin_amdgcn_sched_barrier(0)
    Unit cur, nxt; int ui = 0;
    if (!S.next(0, cur)) return;
    f32x4 acc[2][2][4][2];
#pragma unroll
    for (int a = 0; a < 2; ++a)
#pragma unroll
        for (int b = 0; b < 2; ++b)
#pragma unroll
            for (int m = 0; m < 4; ++m)
#pragma unroll
                for (int n = 0; n < 2; ++n) acc[a][b][m][n] = (f32x4){0.f, 0.f, 0.f, 0.f};
    bf16x8 At[4][2], B0[2][2], B1[2][2];
    const char* cA = (const char*)g.A + (size_t)cur.pm * tstepA; const char* cB = (const char*)g.Bt + (size_t)cur.pn * tstepB;
    PG8_STAGE(PG8_SB(0, 0), cB, voffB); PG8_STAGE(PG8_SB(0, 1), cB + hstepB, voffB); PG8_STAGE(PG8_SA(0, 0), cA, voffA); PG8_STAGE(PG8_SA(0, 1), cA + hstepA, voffA);
    if (wr == 1) PG8_BAR;
    PG8_WAIT_V(2); PG8_BAR;
    PG8_STAGE(PG8_SB(1, 0), cB + kstep, voffB); PG8_STAGE(PG8_SA(1, 0), cA + kstep, voffA); PG8_STAGE(PG8_SB(1, 1), cB + hstepB + kstep, voffB);
    PG8_WAIT_V(6); PG8_BAR;
    for (;;) {
        const bool has_next = S.next(ui + 1, nxt);
        const char* nA = has_next ? (const char*)g.A + (size_t)nxt.pm * tstepA : cA; const char* nB = has_next ? (const char*)g.Bt + (size_t)nxt.pn * tstepB : cB;
        for (int t = 0; t < nt; t += 2) {
            const bool last = (t == nt - 2);
            const char* a1 = cA + (size_t)(t + 1) * kstep;
            const char* a2 = last ? nA : cA + (size_t)(t + 2) * kstep; const char* b2 = last ? nB : cB + (size_t)(t + 2) * kstep;
            const char* a3 = a2 + kstep; const char* b3 = b2 + kstep;
            PG8_LDB(B0, 0, 0); PG8_LDB(B1, 0, 1); PG8_SCHED; PG8_LDA(At, 0, 0); PG8_STAGE(PG8_SA(1, 1), a1 + hstepA, voffA);
            PG8_WAIT_V(8); PG8_WAIT_L(0); PG8_BAR; PG8_MMA(0, 0, At, B0); PG8_MMA(0, 1, At, B1); PG8_BAR; PG8_SCHED;
            PG8_LDA(At, 0, 1); PG8_STAGE(PG8_SB(0, 0), b2, voffB); PG8_STAGE(PG8_SB(0, 1), b2 + hstepB, voffB); PG8_STAGE(PG8_SA(0, 0), a2, voffA);
            PG8_WAIT_V(8); PG8_WAIT_L(0); PG8_BAR; PG8_MMA(1, 0, At, B0); PG8_MMA(1, 1, At, B1); PG8_BAR; PG8_SCHED;
            PG8_LDB(B0, 1, 0); PG8_LDB(B1, 1, 1); PG8_SCHED; PG8_LDA(At, 1, 0); PG8_STAGE(PG8_SA(0, 1), a2 + hstepA, voffA);
            PG8_WAIT_V(8); PG8_WAIT_L(0); PG8_BAR; PG8_MMA(0, 0, At, B0); PG8_MMA(0, 1, At, B1); PG8_BAR; PG8_SCHED;
            PG8_LDA(At, 1, 1); PG8_STAGE(PG8_SB(1, 0), b3, voffB); PG8_STAGE(PG8_SB(1, 1), b3 + hstepB, voffB); PG8_STAGE(PG8_SA(1, 0), a3, voffA);
            PG8_WAIT_V(8); PG8_WAIT_L(0); PG8_BAR; PG8_MMA(1, 0, At, B0); PG8_MMA(1, 1, At, B1); PG8_BAR; PG8_SCHED;
        }
        if (wr == 0) PG8_BAR;
        E(acc, cur, wr, wc, fr, fq);
        if (!has_next) break;
#pragma unroll
        for (int a = 0; a < 2; ++a)
#pragma unroll
            for (int b = 0; b < 2; ++b)
#pragma unroll
                for (int m = 0; m < 4; ++m)
#pragma unroll
                    for (int n = 0; n < 2; ++n) acc[a][b][m][n] = (f32x4){0.f, 0.f, 0.f, 0.f};
        cur = nxt; cA = nA; cB = nB; ++ui;
        if (wr == 1) PG8_BAR;
    }
    PG8_WAIT_V(0);
    PG8_BAR;
#undef PG8_SA
#undef PG8_SB
#undef PG8_STAGE
#undef PG8_LDA
#undef PG8_LDB
#undef PG8_MMA
#undef PG8_WAIT_V
#undef PG8_WAIT_L
#undef PG8_BAR
#undef PG8_SCHED
}
}

template <int MODE>
__device__ __forceinline__ void run_gemm(LAS unsigned char* lds, const bf16_t* A, int lda, const bf16_t* Bt, int M, int N, int K, bf16_t* O, int ldo, const float* lb) {
    pg8::Gemm g{A, lda, Bt, M, N, K};
    pg8::StaticOrder S; S.init(M, N, gridDim.x, blockIdx.x);
    pg8::Epi<MODE> E{O, ldo, lb};
    pg8::gemm_phase(lds, g, S, E);
}

#define XB_TMO      128
#define XB_XCNT(j)  (256  + 64 * (j))
#define XB_XSUB(j)  (1280 + 64 * (j))
#define XB_XGEN(j)  (2304 + 64 * (j))
#define XB_TOP      3328
#define XB_TOPGEN   3392
#define XCD_BAR_WORDS 3456
#define XB_SPIN_CAP (1u << 22)
__device__ __forceinline__ unsigned xb_ld(unsigned* p)              { return __hip_atomic_load(p, __ATOMIC_RELAXED, __HIP_MEMORY_SCOPE_AGENT); }
__device__ __forceinline__ unsigned xb_add(unsigned* p, unsigned v) { return __hip_atomic_fetch_add(p, v, __ATOMIC_RELAXED, __HIP_MEMORY_SCOPE_AGENT); }
__device__ __forceinline__ unsigned xb_xcc_id() { return (unsigned)__builtin_amdgcn_s_getreg((3 << 11) | 20) & 0xFu; }
#define XB_SPIN(cond, bar) do { unsigned _sp = 0; while (cond) { __builtin_amdgcn_s_sleep(1); \
    if ((++_sp & 255u) == 0u) { if (xb_ld(&(bar)[XB_TMO])) break; if (_sp > XB_SPIN_CAP) { atomicAdd(&(bar)[XB_TMO], 1u); break; } } } } while (0)
struct XcdBarrier { unsigned* bar; unsigned x; volatile LAS unsigned* st; };
__device__ __forceinline__ XcdBarrier xcd_barrier_post(unsigned* bar, volatile LAS unsigned* st) {
    XcdBarrier b; b.bar = bar; b.x = xb_xcc_id(); b.st = st;
    if (threadIdx.x == 0) (void)xb_add(&bar[XB_XCNT(b.x)], 1u);
    return b;
}
__device__ __forceinline__ void xcd_barrier_complete(unsigned* bar, unsigned x, unsigned& nloc, unsigned& nx) {
    const unsigned G = gridDim.x * gridDim.y * gridDim.z;
    unsigned sum, cnt, mine, sp = 0u;
    for (;;) {
        sum = 0u; cnt = 0u; mine = 0u;
#pragma unroll
        for (unsigned j = 0; j < 16; ++j) { const unsigned c = xb_ld(&bar[XB_XCNT(j)]); sum += c; cnt += (c > 0u) ? 1u : 0u; mine = (j == x) ? c : mine; }
        if (sum == G) break;
        __builtin_amdgcn_s_sleep(1);
        if ((++sp & 255u) == 0u) { if (xb_ld(&bar[XB_TMO])) break; if (sp > XB_SPIN_CAP) { atomicAdd(&bar[XB_TMO], 1u); break; } }
    }
    nloc = mine > 0u ? mine : 1u; nx = cnt > 0u ? cnt : 1u;
}
__device__ __forceinline__ void xcd_barrier(const XcdBarrier& b) {
    asm volatile("s_waitcnt vmcnt(0)" ::: "memory");
    __syncthreads();
    if (threadIdx.x == 0) {
        unsigned* bar = b.bar;
        __builtin_amdgcn_s_waitcnt(0);
        unsigned nloc = b.st[0], nx = b.st[1];
        if (nloc == 0u) { xcd_barrier_complete(bar, b.x, nloc, nx); b.st[0] = nloc; b.st[1] = nx; }
        const unsigned old = xb_add(&bar[XB_XSUB(b.x)], 1u);
        const unsigned gen = old / nloc;
        if (old + 1u == (gen + 1u) * nloc) {
            __builtin_amdgcn_fence(__ATOMIC_RELEASE, "agent");
            asm volatile("s_waitcnt vmcnt(0)" ::: "memory");
            const unsigned og = xb_add(&bar[XB_TOP], 1u);
            const unsigned tg = og / nx;
            if (og + 1u == (tg + 1u) * nx) xb_add(&bar[XB_TOPGEN], 1u);
            else XB_SPIN(xb_ld(&bar[XB_TOPGEN]) == tg, bar);
            __builtin_amdgcn_fence(__ATOMIC_ACQUIRE, "agent");
            xb_add(&bar[XB_XGEN(b.x)], 1u);
            asm volatile("s_waitcnt vmcnt(0)" ::: "memory");
        } else {
            XB_SPIN(xb_ld(&bar[XB_XGEN(b.x)]) == gen, bar);
            __builtin_amdgcn_fence(__ATOMIC_ACQUIRE, "agent");
            asm volatile("s_waitcnt vmcnt(0)" ::: "memory");
        }
    }
    __syncthreads();
}


__device__ __forceinline__ void p0_mod_item(const Params& p, LAS unsigned char* lds, int item) {
    const int tid = opaque_tid();
    const int layer = item / 144, cgp = item % 144, col0 = cgp * 64;
    const float* c = p.in[1]; const float* cctx = p.in[3];
    const float* W = p.in[4] + (size_t)layer * 1024 * 9216; const float* bias = p.in[5] + (size_t)layer * 9216;
    float* mout = (float*)(p.ws + WS_MOD) + (size_t)layer * 33 * 9216;
    LAS float* S = (LAS float*)lds;
    __syncthreads();
    for (int i = tid; i < 33 * 1024; i += NTHREADS) { const int r = i >> 10, k = i & 1023; const float v = r < 32 ? c[r * 1024 + k] : cctx[k]; S[i] = silu_f(v); }
    __syncthreads();
    const int col = tid & 63, ks = tid >> 6;
    float acc[33];
#pragma unroll
    for (int r = 0; r < 33; ++r) acc[r] = 0.f;
    for (int k4 = 0; k4 < 32; ++k4) {
        const int k = ks * 128 + k4 * 4;
        const float w0 = W[(size_t)(k + 0) * 9216 + col0 + col], w1 = W[(size_t)(k + 1) * 9216 + col0 + col], w2 = W[(size_t)(k + 2) * 9216 + col0 + col], w3 = W[(size_t)(k + 3) * 9216 + col0 + col];
#pragma unroll
        for (int r = 0; r < 33; ++r) { const f32x4 s4 = *(const LAS f32x4*)(S + r * 1024 + k); acc[r] += w0 * s4[0] + w1 * s4[1] + w2 * s4[2] + w3 * s4[3]; }
    }
    __syncthreads();
    LAS float* red = (LAS float*)lds;
#pragma unroll
    for (int r = 0; r < 33; ++r) red[(ks * 33 + r) * 64 + col] = acc[r];
    __syncthreads();
    for (int i = tid; i < 33 * 64; i += NTHREADS) {
        const int r = i >> 6, cc = i & 63; float s = 0.f;
#pragma unroll
        for (int q = 0; q < 8; ++q) s += red[(q * 33 + r) * 64 + cc];
        mout[(size_t)r * 9216 + col0 + cc] = s + bias[col0 + cc];
    }
    __syncthreads();
}

__device__ __forceinline__ void p0_transpose_item(const float* W, int K, int N, bf16_t* WT, int k0, int n0, int drow0, LAS float* scr, int lane) {
    const int n4 = lane & 15, kr = lane >> 4;
    f32x4 v[16];
#pragma unroll
    for (int i = 0; i < 16; ++i) v[i] = *(const f32x4*)(W + (size_t)(k0 + 4 * i + kr) * N + n0 + 4 * n4);
#pragma unroll
    for (int i = 0; i < 16; ++i) { LAS float* d = scr + (4 * i + kr) * 65 + 4 * n4; d[0] = v[i][0]; d[1] = v[i][1]; d[2] = v[i][2]; d[3] = v[i][3]; }
    asm volatile("s_waitcnt lgkmcnt(0)" ::: "memory");
    const int c = lane & 7;
#pragma unroll
    for (int j = 0; j < 8; ++j) { const int n = (lane >> 3) + 8 * j; const LAS float* s = scr + (8 * c) * 65 + n;
        u32x4 o; o.x = cvt_pk_bf16(s[0 * 65], s[1 * 65]); o.y = cvt_pk_bf16(s[2 * 65], s[3 * 65]); o.z = cvt_pk_bf16(s[4 * 65], s[5 * 65]); o.w = cvt_pk_bf16(s[6 * 65], s[7 * 65]);
        *(u32x4*)(WT + (size_t)(drow0 + n) * K + k0 + 8 * c) = o; }
    asm volatile("s_waitcnt lgkmcnt(0)" ::: "memory");
}

__device__ __forceinline__ void phase0(const Params& p, LAS unsigned char* lds) {
    const int tid = opaque_tid(), wid = tid >> 6, lane = tid & 63;
    if (blockIdx.x == 0) { unsigned* bar = (unsigned*)(p.ws + WS_BAR); for (int i = tid; i < 4096; i += NTHREADS) bar[i] = 0u; }
    if (blockIdx.x == gridDim.x - 1) {
        const float* lbp = p.in[11]; float* lbo = (float*)(p.ws + WS_LB);
        for (int i = tid; i < 2048; i += NTHREADS) { const int dir = i >> 10, col = i & 1023;
            const float l0 = lbp[(dir * 3 + 0) * 1024 + col], l1 = lbp[(dir * 3 + 1) * 1024 + col], l2 = lbp[(dir * 3 + 2) * 1024 + col];
            const float mx = fmaxf(l0, fmaxf(l1, l2)); const float e0 = __expf(l0 - mx), e1 = __expf(l1 - mx), e2 = __expf(l2 - mx);
            lbo[i] = e0 / (e0 + e1 + e2); }
    }
    if (blockIdx.x == gridDim.x - 2) {
        const float* wsp = p.in[17]; bf16_t* wsb = (bf16_t*)(p.ws + WS_WSB);
        for (int i = tid; i < 8 * 128 * 128 / 4; i += NTHREADS) { const f32x4 w = *(const f32x4*)(wsp + 4 * i); u32x2 o; o.x = cvt_pk_bf16(w[0], w[1]); o.y = cvt_pk_bf16(w[2], w[3]); *(u32x2*)(wsb + 4 * i) = o; }
    }
    for (int it = blockIdx.x; it < 288; it += gridDim.x) p0_mod_item(p, lds, it);
    __syncthreads();
    LAS float* scr = (LAS float*)lds + wid * (64 * 65);
    const int gw = blockIdx.x * 8 + wid, nw = gridDim.x * 8;
    for (int git = gw; git < 12288; git += nw) {
        int it = git, mi = 0;
        for (; mi < 12; ++mi) { const int cnt = mi < 4 ? 1408 : (mi < 8 ? 704 : (mi == 8 ? 1280 : (mi == 9 ? 256 : (mi == 10 ? 1536 : 768)))); if (it < cnt) break; it -= cnt; }
        const float* W; bf16_t* WT; int K, N, mode = 0;
        if (mi < 4) { W = p.in[8] + (size_t)mi * 1024 * 5632; WT = (bf16_t*)(p.ws + WS_FIN) + (size_t)mi * 5632 * 1024; K = 1024; N = 5632; mode = 1; }
        else if (mi < 8) { W = p.in[9] + (size_t)(mi - 4) * 2816 * 1024; WT = (bf16_t*)(p.ws + WS_FOUT) + (size_t)(mi - 4) * 1024 * 2816; K = 2816; N = 1024; }
        else if (mi == 8) { W = p.in[10]; WT = (bf16_t*)(p.ws + WS_HIN); K = 1024; N = 5120; }
        else if (mi == 9) { W = p.in[13]; WT = (bf16_t*)(p.ws + WS_HOUT); K = 1024; N = 1024; }
        else if (mi == 10) { W = p.in[14]; WT = (bf16_t*)(p.ws + WS_CIN); K = 1024; N = 6144; }
        else { W = p.in[19]; WT = (bf16_t*)(p.ws + WS_COUT); K = 3072; N = 1024; }
        const int nblk = N / 64;
        const int kb = it / nblk, nb = it % nblk, n0 = nb * 64;
        int drow0 = n0;
        if (mode == 1) { const int j = n0 < FH ? n0 : n0 - FH; drow0 = 256 * (j >> 7) + (n0 < FH ? 0 : 128) + (j & 127); }
        p0_transpose_item(W, K, N, WT, kb * 64, n0, drow0, scr, lane);
    }
}

struct RowArgs {
    const float* xs_x; const float* xs_c; int nrows;
    const bf16_t* y; float ysc; const float* m; int k; const float* g; const float* b;
    float* xd; bf16_t* hd; const float* m2; int k2;
};
__device__ __forceinline__ void row_phase(const RowArgs& a) {
    const int tid0 = opaque_tid(); const int wid = tid0 >> 6, lane = tid0 & 63;
    constexpr int NR = 4;
    for (int rowb = blockIdx.x * (8 * NR) + wid; rowb < a.nrows; rowb += gridDim.x * (8 * NR)) {
        const int mrow = rowb < MX ? (rowb >> 11) : 32;
        f32x4 v[NR][4];
#pragma unroll
        for (int q = 0; q < NR; ++q) {
            const int row = rowb + 8 * q;
            const float* xr = row < MX ? a.xs_x + (size_t)row * D : a.xs_c + (size_t)(row - MX) * D;
#pragma unroll
            for (int j = 0; j < 4; ++j) v[q][j] = *(const f32x4*)(xr + j * 256 + lane * 4);
        }
        if (a.y) {
            u32x2 yy[NR][4]; f32x4 gt[4];
            const float* gp = a.m + (size_t)mrow * 9216 + (3 * a.k + 2) * 1024;
#pragma unroll
            for (int q = 0; q < NR; ++q) {
                const int row = rowb + 8 * q;
#pragma unroll
                for (int j = 0; j < 4; ++j) yy[q][j] = *(const u32x2*)(a.y + (size_t)row * D + j * 256 + lane * 4);
            }
#pragma unroll
            for (int j = 0; j < 4; ++j) gt[j] = *(const f32x4*)(gp + j * 256 + lane * 4) * a.ysc;
            float s[NR];
#pragma unroll
            for (int q = 0; q < NR; ++q) {
                s[q] = 0.f;
#pragma unroll
                for (int j = 0; j < 4; ++j) {
                    v[q][j][0] = DN_ALPHA * v[q][j][0] + gt[j][0] * bf_lo(yy[q][j].x); v[q][j][1] = DN_ALPHA * v[q][j][1] + gt[j][1] * bf_hi(yy[q][j].x);
                    v[q][j][2] = DN_ALPHA * v[q][j][2] + gt[j][2] * bf_lo(yy[q][j].y); v[q][j][3] = DN_ALPHA * v[q][j][3] + gt[j][3] * bf_hi(yy[q][j].y);
                    s[q] += (v[q][j][0] + v[q][j][1]) + (v[q][j][2] + v[q][j][3]);
                }
            }
            float mean[NR], s2[NR];
#pragma unroll
            for (int q = 0; q < NR; ++q) mean[q] = wave_sum(s[q]) * (1.f / D);
#pragma unroll
            for (int q = 0; q < NR; ++q) {
                s2[q] = 0.f;
#pragma unroll
                for (int j = 0; j < 4; ++j) { v[q][j] = v[q][j] - mean[q]; s2[q] += (v[q][j][0] * v[q][j][0] + v[q][j][1] * v[q][j][1]) + (v[q][j][2] * v[q][j][2] + v[q][j][3] * v[q][j][3]); }
            }
            f32x4 gg[4], bb[4];
#pragma unroll
            for (int j = 0; j < 4; ++j) { gg[j] = *(const f32x4*)(a.g + j * 256 + lane * 4); bb[j] = *(const f32x4*)(a.b + j * 256 + lane * 4); }
#pragma unroll
            for (int q = 0; q < NR; ++q) {
                const int row = rowb + 8 * q;
                const float rstd = __builtin_amdgcn_rsqf(wave_sum(s2[q]) * (1.f / D) + LN_EPS);
#pragma unroll
                for (int j = 0; j < 4; ++j) v[q][j] = v[q][j] * rstd * gg[j] + bb[j];
                if (a.xd && row < MX) {
#pragma unroll
                    for (int j = 0; j < 4; ++j) *(f32x4*)(a.xd + (size_t)row * D + j * 256 + lane * 4) = v[q][j];
                }
            }
        }
        if (a.hd) {
            const float* shp = a.m2 + (size_t)mrow * 9216 + (3 * a.k2) * 1024; const float* scp = shp + 1024;
            f32x4 sh[4], sc[4];
#pragma unroll
            for (int j = 0; j < 4; ++j) { sh[j] = *(const f32x4*)(shp + j * 256 + lane * 4); sc[j] = *(const f32x4*)(scp + j * 256 + lane * 4) + 1.f; }
#pragma unroll
            for (int q = 0; q < NR; ++q) {
                const int row = rowb + 8 * q;
#pragma unroll
                for (int j = 0; j < 4; ++j) {
                    const f32x4 h = v[q][j] * sc[j] + sh[j];
                    u32x2 o; o.x = cvt_pk_bf16(h[0], h[1]); o.y = cvt_pk_bf16(h[2], h[3]);
                    *(u32x2*)(a.hd + (size_t)row * D + j * 256 + lane * 4) = o;
                }
            }
        }
    }
}

constexpr int GLA_DIRB = 74240;
__device__ __forceinline__ void gla_phase(const Params& p, LAS unsigned char* lds) {
    const int tid = opaque_tid(), dir = tid >> 8, tl = tid & 255, w = tl >> 6, lane = tl & 63, fr = lane & 15, fq = lane >> 4;
    const int cp = lane, qt = w;
    bf16_t* P = (bf16_t*)(p.ws + WS_BIG); bf16_t* R = (bf16_t*)(p.ws + WS_A0);
    const float* normw = p.in[12];
    LAS unsigned char* base = lds + dir * GLA_DIRB;
    LAS bf16_t* Qin = (LAS bf16_t*)base;
    LAS bf16_t* Kin = (LAS bf16_t*)(base + 17408);
    LAS bf16_t* Sc = Kin;
    LAS bf16_t* KinT = (LAS bf16_t*)(base + 34816);
    LAS bf16_t* VT = (LAS bf16_t*)(base + 53248);
    LAS float* tot = (LAS float*)(base + 71680);
    LAS float* dec = (LAS float*)(base + 73728);
    for (int item = blockIdx.x; item < NB * 8; item += gridDim.x) {
        const int b = item >> 3, h = item & 7;
        f32x4 Sacc[8][2];
#pragma unroll
        for (int m = 0; m < 8; ++m) { Sacc[m][0] = (f32x4){0.f, 0.f, 0.f, 0.f}; Sacc[m][1] = (f32x4){0.f, 0.f, 0.f, 0.f}; }
        unsigned rq[16], rv[16], rl[16];
        auto chunk_row = [&](int ci, int t) -> size_t {
            const bool isc = ci < 4; const int lc = isc ? ci : ci - 4, L = isc ? CTXL : SEQ; const int rbase = isc ? MX + b * CTXL : b * SEQ;
            const int tok = dir == 0 ? 64 * lc + t : L - 1 - (64 * lc + t);
            return (size_t)(rbase + tok);
        };
        auto load_chunk = [&](int ci) {
            long off = (long)(chunk_row(ci, 16 * qt) * HG5 + h * 128 + 2 * cp);
            const long step = dir == 0 ? (long)HG5 : -(long)HG5;
#pragma unroll
            for (int i = 0; i < 16; ++i) {
                const bf16_t* rp = P + off;
                rq[i] = *(const unsigned*)rp; rv[i] = *(const unsigned*)(rp + 1024); rl[i] = *(const unsigned*)(rp + (2 + dir) * 1024);
                off += step; asm volatile("" : "+v"(off));
            }
        };
        __syncthreads();
        load_chunk(0);
        for (int ci = 0; ci < 36; ++ci) {
            const bool isc = ci < 4;
            {
                float run0 = 0.f, run1 = 0.f;
#pragma unroll
                for (int i = 0; i < 16; ++i) { run0 += bf_lo(rl[i]); run1 += bf_hi(rl[i]); }
                *(LAS f32x2*)(tot + qt * 128 + 2 * cp) = (f32x2){run0, run1};
#pragma unroll
                for (int hh = 0; hh < 2; ++hh) {
                    u32x4 a, c;
#pragma unroll
                    for (int u = 0; u < 4; ++u) { const int ip = 4 * hh + u;
                        a[u] = (rv[2 * ip] & 0xffffu) | (rv[2 * ip + 1] << 16); c[u] = (rv[2 * ip] >> 16) | (rv[2 * ip + 1] & 0xffff0000u); }
                    *(LAS u32x4*)(VT + (2 * cp) * 72 + 16 * qt + 8 * hh) = a;
                    *(LAS u32x4*)(VT + (2 * cp + 1) * 72 + 16 * qt + 8 * hh) = c;
                }
                lds_barrier();
                float pre0 = 0.f, pre1 = 0.f, all0 = 0.f, all1 = 0.f;
#pragma unroll
                for (int q = 0; q < 4; ++q) { const f32x2 tq = *(const LAS f32x2*)(tot + q * 128 + 2 * cp); if (q < qt) { pre0 += tq[0]; pre1 += tq[1]; } all0 += tq[0]; all1 += tq[1]; }
                if (qt == 0) *(LAS f32x2*)(dec + 2 * cp) = (f32x2){__expf(all0), __expf(all1)};
                float iebp0 = __expf(-pre0), iebp1 = __expf(-pre1);
                float bb0 = pre0, bb1 = pre1;
#pragma unroll
                for (int hh = 0; hh < 2; ++hh) {
                    u32x4 a, c;
#pragma unroll
                    for (int u4 = 0; u4 < 4; ++u4) {
                        float kin0[2], kin1[2];
#pragma unroll
                        for (int u = 0; u < 2; ++u) {
                            const int i = 8 * hh + 2 * u4 + u, t = 16 * qt + i;
                            bb0 += bf_lo(rl[i]); bb1 += bf_hi(rl[i]);
                            const float eb0 = __expf(bb0), eb1 = __expf(bb1), ieb0 = __expf(-bb0), ieb1 = __expf(-bb1);
                            const float k0 = 1.f - eb0 * iebp0, k1 = 1.f - eb1 * iebp1;
                            iebp0 = ieb0; iebp1 = ieb1;
                            kin0[u] = k0 * ieb0; kin1[u] = k1 * ieb1;
                            *(LAS unsigned*)(Qin + t * 136 + 2 * cp) = cvt_pk_bf16(bf_lo(rq[i]) * eb0, bf_hi(rq[i]) * eb1);
                            *(LAS unsigned*)(Kin + t * 136 + 2 * cp) = cvt_pk_bf16(kin0[u], kin1[u]);
                        }
                        a[u4] = cvt_pk_bf16(kin0[0], kin0[1]); c[u4] = cvt_pk_bf16(kin1[0], kin1[1]);
                    }
                    *(LAS u32x4*)(KinT + (2 * cp) * 72 + 16 * qt + 8 * hh) = a;
                    *(LAS u32x4*)(KinT + (2 * cp + 1) * 72 + 16 * qt + 8 * hh) = c;
                    __builtin_amdgcn_sched_barrier(0);
                }
            }
            lds_barrier();
            if (ci + 1 < 36) load_chunk(ci + 1);
            f32x4 sacc[4];
            if (!isc) {
                bf16x8 qf[4];
#pragma unroll
                for (int ks = 0; ks < 4; ++ks) qf[ks] = *(const LAS bf16x8*)(Qin + (16 * w + fr) * 136 + 32 * ks + 8 * fq);
#pragma unroll
                for (int ms = 0; ms < 4; ++ms) {
                    sacc[ms] = (f32x4){0.f, 0.f, 0.f, 0.f};
                    if (ms <= w) {
#pragma unroll
                        for (int ks = 0; ks < 4; ++ks) { const bf16x8 kf = *(const LAS bf16x8*)(Kin + (16 * ms + fr) * 136 + 32 * ks + 8 * fq);
                            sacc[ms] = __builtin_amdgcn_mfma_f32_16x16x32_bf16(kf, qf[ks], sacc[ms], 0, 0, 0); }
                    }
                }
            }
            lds_barrier();
            if (!isc) {
#pragma unroll
                for (int ms = 0; ms < 4; ++ms) {
                    f32x4 v = sacc[ms];
                    if (ms == w) {
#pragma unroll
                        for (int j = 0; j < 4; ++j) v[j] = (4 * fq + j <= fr) ? v[j] : 0.f;
                    }
                    u32x2 o; o.x = cvt_pk_bf16(v[0], v[1]); o.y = cvt_pk_bf16(v[2], v[3]);
                    *(LAS u32x2*)(Sc + (16 * w + fr) * 72 + 16 * ms + 4 * fq) = o;
                }
            }
            lds_barrier();
            __builtin_amdgcn_sched_barrier(0);
            bf16x8 vfrag[2][2];
#pragma unroll
            for (int n = 0; n < 2; ++n)
#pragma unroll
                for (int ks = 0; ks < 2; ++ks) vfrag[n][ks] = *(const LAS bf16x8*)(VT + (32 * w + 16 * n + fr) * 72 + 32 * ks + 8 * fq);
            if (!isc) {
                f32x4 oacc[2][4];
#pragma unroll
                for (int n = 0; n < 2; ++n)
#pragma unroll
                    for (int tt = 0; tt < 4; ++tt) oacc[n][tt] = (f32x4){0.f, 0.f, 0.f, 0.f};
#pragma unroll
                for (int kk = 0; kk < 4; ++kk) {
                    bf16x8 sf[2];
#pragma unroll
                    for (int n = 0; n < 2; ++n) {
                        u32x4 pk; pk.x = cvt_pk_bf16(Sacc[2 * kk][n][0], Sacc[2 * kk][n][1]); pk.y = cvt_pk_bf16(Sacc[2 * kk][n][2], Sacc[2 * kk][n][3]);
                        pk.z = cvt_pk_bf16(Sacc[2 * kk + 1][n][0], Sacc[2 * kk + 1][n][1]); pk.w = cvt_pk_bf16(Sacc[2 * kk + 1][n][2], Sacc[2 * kk + 1][n][3]);
                        sf[n] = __builtin_bit_cast(bf16x8, pk);
                    }
#pragma unroll
                    for (int tt = 0; tt < 4; ++tt) {
                        const LAS bf16_t* qp = Qin + (16 * tt + fr) * 136 + 32 * kk + 4 * fq;
                        const u32x2 lo = *(const LAS u32x2*)qp, hi = *(const LAS u32x2*)(qp + 16);
                        const bf16x8 qfr = __builtin_bit_cast(bf16x8, ((u32x4){lo.x, lo.y, hi.x, hi.y}));
#pragma unroll
                        for (int n = 0; n < 2; ++n) oacc[n][tt] = __builtin_amdgcn_mfma_f32_16x16x32_bf16(sf[n], qfr, oacc[n][tt], 0, 0, 0);
                    }
                }
                __builtin_amdgcn_sched_barrier(0);
#pragma unroll
                for (int tt = 0; tt < 4; ++tt)
#pragma unroll
                    for (int ks = 0; ks < 2; ++ks) {
                        if (ks == 1 && tt < 2) continue;
                        const bf16x8 scf = *(const LAS bf16x8*)(Sc + (16 * tt + fr) * 72 + 32 * ks + 8 * fq);
#pragma unroll
                        for (int n = 0; n < 2; ++n) oacc[n][tt] = __builtin_amdgcn_mfma_f32_16x16x32_bf16(vfrag[n][ks], scf, oacc[n][tt], 0, 0, 0);
                    }
                __builtin_amdgcn_sched_barrier(0);
#pragma unroll
                for (int tt = 0; tt < 4; ++tt) {
                    bf16_t* op = P + chunk_row(ci, 16 * tt + fr) * HG5 + (2 + dir) * 1024 + h * 128 + 32 * w + 4 * fq;
#pragma unroll
                    for (int n = 0; n < 2; ++n) { u32x2 o; o.x = cvt_pk_bf16(oacc[n][tt][0], oacc[n][tt][1]); o.y = cvt_pk_bf16(oacc[n][tt][2], oacc[n][tt][3]); *(u32x2*)(op + 16 * n) = o; }
                }
            }
            __builtin_amdgcn_sched_barrier(0);
#pragma unroll
            for (int m = 0; m < 8; ++m) {
#pragma unroll
                for (int ks = 0; ks < 2; ++ks) { const bf16x8 kf = *(const LAS bf16x8*)(KinT + (16 * m + fr) * 72 + 32 * ks + 8 * fq);
#pragma unroll
                    for (int n = 0; n < 2; ++n) Sacc[m][n] = __builtin_amdgcn_mfma_f32_16x16x32_bf16(kf, vfrag[n][ks], Sacc[m][n], 0, 0, 0); }
                const f32x4 dv = *(const LAS f32x4*)(dec + 16 * m + 4 * fq);
                Sacc[m][0] *= dv; Sacc[m][1] *= dv;
            }
            lds_barrier();
        }
        __syncthreads();
        {
            const int wid = tid >> 6, lane = tid & 63, sub = lane >> 4, l16 = lane & 15;
            const f32x4 w0 = *(const f32x4*)(normw + 8 * l16), w1 = *(const f32x4*)(normw + 8 * l16 + 4);
            for (int it0 = 0; it0 < 64; it0 += 8) {
                u32x4 of[8], ob[8], gg[8];
#pragma unroll
                for (int u = 0; u < 8; ++u) {
                    const int t = (it0 + u) * 32 + wid * 4 + sub; const bf16_t* rp = P + ((size_t)b * SEQ + t) * HG5 + h * 128 + 8 * l16;
                    of[u] = *(const u32x4*)(rp + 2048); ob[u] = *(const u32x4*)(rp + 3072); gg[u] = *(const u32x4*)(rp + 4096);
                }
#pragma unroll
                for (int u = 0; u < 8; ++u) {
                    const int t = (it0 + u) * 32 + wid * 4 + sub; const size_t row = (size_t)b * SEQ + t;
                    float o[8];
                    o[0] = bf_lo(of[u].x) + bf_lo(ob[u].x); o[1] = bf_hi(of[u].x) + bf_hi(ob[u].x); o[2] = bf_lo(of[u].y) + bf_lo(ob[u].y); o[3] = bf_hi(of[u].y) + bf_hi(ob[u].y);
                    o[4] = bf_lo(of[u].z) + bf_lo(ob[u].z); o[5] = bf_hi(of[u].z) + bf_hi(ob[u].z); o[6] = bf_lo(of[u].w) + bf_lo(ob[u].w); o[7] = bf_hi(of[u].w) + bf_hi(ob[u].w);
                    float ss = 0.f;
#pragma unroll
                    for (int i = 0; i < 8; ++i) ss += o[i] * o[i];
                    ss += __shfl_xor(ss, 1); ss += __shfl_xor(ss, 2); ss += __shfl_xor(ss, 4); ss += __shfl_xor(ss, 8);
                    const float rs = __builtin_amdgcn_rsqf(ss * (1.f / 128.f) + RMS_EPS);
                    u32x4 r;
                    r.x = cvt_pk_bf16(o[0] * rs * w0[0] * bf_lo(gg[u].x), o[1] * rs * w0[1] * bf_hi(gg[u].x));
                    r.y = cvt_pk_bf16(o[2] * rs * w0[2] * bf_lo(gg[u].y), o[3] * rs * w0[3] * bf_hi(gg[u].y));
                    r.z = cvt_pk_bf16(o[4] * rs * w1[0] * bf_lo(gg[u].z), o[5] * rs * w1[1] * bf_hi(gg[u].z));
                    r.w = cvt_pk_bf16(o[6] * rs * w1[2] * bf_lo(gg[u].w), o[7] * rs * w1[3] * bf_hi(gg[u].w));
                    *(u32x4*)(R + row * D + h * 128 + 8 * l16) = r;
                }
            }
        }
        __syncthreads();
    }
}

__device__ __forceinline__ void cm_gate_phase(const Params& p, LAS unsigned char* lds) {
    const int tid = opaque_tid(), wid = tid >> 6, lane = tid & 63, fr = lane & 15, fq = lane >> 4;
    bf16_t* UV = (bf16_t*)(p.ws + WS_BIG);
    const float* vg = p.in[15]; const float* vb = p.in[16]; const float* bs = p.in[18];
    const bf16_t* WSB = (const bf16_t*)(p.ws + WS_WSB);
    LAS bf16_t* Wl = (LAS bf16_t*)lds; LAS bf16_t* Vl = (LAS bf16_t*)(lds + 34816); LAS float* st = (LAS float*)(lds + 34816 + 100352); LAS float* bl = st + 256;
    const int c8 = lane < 48 ? lane : 47;
    for (int ch = blockIdx.x; ch < MX / 128; ch += gridDim.x) {
        const size_t row0 = (size_t)ch * 128;
        __syncthreads();
        for (int rr = 0; rr < 8; ++rr) {
            const int r = wid * 16 + 2 * rr; const bf16_t* vp = UV + (row0 + r) * 6144 + 3072;
            u32x4 x[2][6]; float s[2] = {0.f, 0.f};
#pragma unroll
            for (int q = 0; q < 2; ++q)
#pragma unroll
                for (int i = 0; i < 6; ++i) x[q][i] = *(const u32x4*)(vp + (size_t)q * 6144 + (i * 64 + lane) * 8);
#pragma unroll
            for (int q = 0; q < 2; ++q)
#pragma unroll
                for (int i = 0; i < 6; ++i) s[q] += (bf_lo(x[q][i].x) + bf_hi(x[q][i].x)) + (bf_lo(x[q][i].y) + bf_hi(x[q][i].y)) + (bf_lo(x[q][i].z) + bf_hi(x[q][i].z)) + (bf_lo(x[q][i].w) + bf_hi(x[q][i].w));
            float mean[2], s2[2] = {0.f, 0.f};
#pragma unroll
            for (int q = 0; q < 2; ++q) mean[q] = wave_sum(s[q]) * (1.f / 3072.f);
#pragma unroll
            for (int q = 0; q < 2; ++q)
#pragma unroll
                for (int i = 0; i < 6; ++i) { float d;
                    d = bf_lo(x[q][i].x) - mean[q]; s2[q] += d * d; d = bf_hi(x[q][i].x) - mean[q]; s2[q] += d * d; d = bf_lo(x[q][i].y) - mean[q]; s2[q] += d * d; d = bf_hi(x[q][i].y) - mean[q]; s2[q] += d * d;
                    d = bf_lo(x[q][i].z) - mean[q]; s2[q] += d * d; d = bf_hi(x[q][i].z) - mean[q]; s2[q] += d * d; d = bf_lo(x[q][i].w) - mean[q]; s2[q] += d * d; d = bf_hi(x[q][i].w) - mean[q]; s2[q] += d * d; }
#pragma unroll
            for (int q = 0; q < 2; ++q) { const float rstd = __builtin_amdgcn_rsqf(wave_sum(s2[q]) * (1.f / 3072.f) + LN_EPS); if (lane == 0) { st[2 * (r + q)] = mean[q]; st[2 * (r + q) + 1] = rstd; } }
        }
        for (int g = 0; g < 8; ++g) {
            lds_barrier();
#pragma unroll
            for (int i = 0; i < 4; ++i) { const int idx = tid + NTHREADS * i, r = idx >> 4, cc = idx & 15;
                *(LAS u32x4*)(Wl + r * 136 + cc * 8) = *(const u32x4*)(WSB + (size_t)g * 16384 + r * 128 + cc * 8); }
            if (tid < 128) bl[tid] = bs[g * 128 + tid];
            {
                const float* gp = vg + g * 384 + c8 * 8; const float* bp = vb + g * 384 + c8 * 8;
                const f32x4 g0 = *(const f32x4*)gp, g1 = *(const f32x4*)(gp + 4), b0 = *(const f32x4*)bp, b1 = *(const f32x4*)(bp + 4);
                size_t xo = (row0 + wid) * 6144 + 3072 + g * 384 + c8 * 8;
#pragma unroll
                for (int hb = 0; hb < 2; ++hb) {
                    u32x4 xv[8];
#pragma unroll
                    for (int i = 0; i < 8; ++i) { xv[i] = *(const u32x4*)(UV + xo); xo += 8 * 6144; asm volatile("" : "+v"(xo)); }
#pragma unroll
                    for (int i = 0; i < 8; ++i) { const int sr = wid + 8 * (8 * hb + i);
                        const f32x2 ms = *(const LAS f32x2*)(st + 2 * sr); const float mean = ms[0], rstd = ms[1]; const u32x4 x = xv[i];
                        u32x4 o;
                        o.x = cvt_pk_bf16((bf_lo(x.x) - mean) * rstd * g0[0] + b0[0], (bf_hi(x.x) - mean) * rstd * g0[1] + b0[1]);
                        o.y = cvt_pk_bf16((bf_lo(x.y) - mean) * rstd * g0[2] + b0[2], (bf_hi(x.y) - mean) * rstd * g0[3] + b0[3]);
                        o.z = cvt_pk_bf16((bf_lo(x.z) - mean) * rstd * g1[0] + b1[0], (bf_hi(x.z) - mean) * rstd * g1[1] + b1[1]);
                        o.w = cvt_pk_bf16((bf_lo(x.w) - mean) * rstd * g1[2] + b1[2], (bf_hi(x.w) - mean) * rstd * g1[3] + b1[3]);
                        if (lane < 48) *(LAS u32x4*)(Vl + sr * 392 + c8 * 8) = o; }
                }
            }
            lds_barrier();
#pragma unroll 1
            for (int n = 0; n < 3; ++n) {
                size_t uo = (row0 + fr) * 6144 + g * 384 + wid * 48 + n * 16 + 4 * fq;
                u32x2 uu[8];
#pragma unroll
                for (int m = 0; m < 8; ++m) { uu[m] = *(const u32x2*)(UV + uo); uo += 16 * 6144; asm volatile("" : "+v"(uo)); }
                f32x4 acc[8];
#pragma unroll
                for (int m = 0; m < 8; ++m) acc[m] = (f32x4){0.f, 0.f, 0.f, 0.f};
#pragma unroll
                for (int ks = 0; ks < 4; ++ks) {
                    bf16x8 af;
                    const LAS bf16_t* vp = Vl + (32 * ks + 8 * fq) * 392 + wid * 48 + n * 16 + fr;
#pragma unroll
                    for (int i = 0; i < 8; ++i) af[i] = (short)vp[i * 392];
#pragma unroll
                    for (int m = 0; m < 8; ++m) {
                        const bf16x8 bfrag = *(const LAS bf16x8*)(Wl + (16 * m + fr) * 136 + 32 * ks + 8 * fq);
                        acc[m] = __builtin_amdgcn_mfma_f32_16x16x32_bf16(af, bfrag, acc[m], 0, 0, 0);
                    }
                }
                size_t zo = (row0 + fr) * 6144 + g * 384 + wid * 48 + n * 16 + 4 * fq;
#pragma unroll
                for (int m = 0; m < 8; ++m) {
                    const float bias = bl[16 * m + fr];
                    const u32x2 u2 = uu[m];
                    u32x2 o; o.x = cvt_pk_bf16(bf_lo(u2.x) * (acc[m][0] + bias), bf_hi(u2.x) * (acc[m][1] + bias));
                    o.y = cvt_pk_bf16(bf_lo(u2.y) * (acc[m][2] + bias), bf_hi(u2.y) * (acc[m][3] + bias));
                    *(u32x2*)(UV + zo) = o;
                    zo += 16 * 6144; asm volatile("" : "+v"(zo));
                }
            }
        }
    }
}

#ifndef EN_MASK
#define EN_MASK 255
#endif
constexpr int EN = EN_MASK;
#ifndef PROBE_KINDS
#define PROBE_KINDS 0
#endif
#ifndef PROBE_K
#define PROBE_K 4
#endif
__global__ void __launch_bounds__(NTHREADS, 2) fwd_megakernel(Params p) {
    extern __shared__ __attribute__((aligned(16))) unsigned char lds_raw[];
    LAS unsigned char* lds = (LAS unsigned char*)lds_raw;
    cg::grid_group grid = cg::this_grid();
    volatile LAS unsigned* xst = (volatile LAS unsigned*)(lds + LDS_BYTES - 16);
    if (threadIdx.x == 0) { xst[0] = 0u; xst[1] = 0u; }
    XcdBarrier xb; xb.bar = (unsigned*)(p.ws + WS_BAR); xb.x = 0; xb.st = xst;
    const float* x_in = p.in[0]; const float* ctx_in = p.in[2];
    const float* mod0 = (const float*)(p.ws + WS_MOD); const float* mod1 = mod0 + (size_t)33 * 9216;
    const float* lbv = (const float*)(p.ws + WS_LB);
    const float* ln_g = p.in[6]; const float* ln_b = p.in[7];
    bf16_t* A0 = (bf16_t*)(p.ws + WS_A0); bf16_t* BIG = (bf16_t*)(p.ws + WS_BIG);
    const bf16_t* FIN = (const bf16_t*)(p.ws + WS_FIN); const bf16_t* FOUT = (const bf16_t*)(p.ws + WS_FOUT);
    const bf16_t* HIN = (const bf16_t*)(p.ws + WS_HIN); const bf16_t* HOUT = (const bf16_t*)(p.ws + WS_HOUT);
    const bf16_t* CIN = (const bf16_t*)(p.ws + WS_CIN); const bf16_t* COUT = (const bf16_t*)(p.ws + WS_COUT);
    const size_t FIN_SZ = (size_t)5632 * 1024, FOUT_SZ = (size_t)1024 * 2816;
    long long probe_acc = 0;
    for (int ph = p.ph_lo; ph < p.ph_hi; ++ph) {
        const long long probe_t0 = PROBE_KINDS ? wall_clock64() : 0;
        int kind;
        switch (ph) {
        case 0: kind = 0; break;
        case 1: case 4: case 8: case 11: case 14: case 18: case 21: kind = 1; break;
        case 2: case 9: case 12: case 19: kind = 2; break;
        case 3: case 7: case 10: case 13: case 17: case 20: kind = 3; break;
        case 5: kind = 4; break;
        case 6: kind = 5; break;
        case 15: kind = 6; break;
        default: kind = 7; break;
        }
        if (kind == 0) { if (EN & 1) phase0(p, lds); }
        else if (kind == 1) {
            RowArgs a;
            a.xs_x = p.out; a.xs_c = nullptr; a.nrows = MX; a.y = A0; a.ysc = 0.5f; a.xd = p.out; a.hd = A0;
            if (ph == 1) { a.xs_x = x_in; a.xs_c = ctx_in; a.nrows = MT; a.y = nullptr; a.m = mod0; a.k = 0; a.g = ln_g; a.b = ln_b; a.m2 = mod0; a.k2 = 0; }
            else if (ph == 4) { a.xs_x = x_in; a.xs_c = ctx_in; a.nrows = MT; a.m = mod0; a.k = 0; a.g = ln_g + 0 * D; a.b = ln_b + 0 * D; a.m2 = mod0; a.k2 = 1; }
            else if (ph == 8) { a.y = BIG; a.ysc = 1.f; a.m = mod0; a.k = 1; a.g = ln_g + 1 * D; a.b = ln_b + 1 * D; a.m2 = mod0; a.k2 = 2; }
            else if (ph == 11) { a.m = mod0; a.k = 2; a.g = ln_g + 2 * D; a.b = ln_b + 2 * D; a.m2 = mod1; a.k2 = 0; }
            else if (ph == 14) { a.m = mod1; a.k = 0; a.g = ln_g + 3 * D; a.b = ln_b + 3 * D; a.m2 = mod1; a.k2 = 1; }
            else if (ph == 18) { a.ysc = 1.f; a.m = mod1; a.k = 1; a.g = ln_g + 4 * D; a.b = ln_b + 4 * D; a.m2 = mod1; a.k2 = 2; }
            else { a.m = mod1; a.k = 2; a.g = ln_g + 5 * D; a.b = ln_b + 5 * D; a.hd = nullptr; a.m2 = mod1; a.k2 = 0; }
            if (EN & 2) row_phase(a);
        } else if (kind == 2) {
            const int wi = ph == 2 ? 0 : (ph == 9 ? 1 : (ph == 12 ? 2 : 3));
            if (EN & 4) run_gemm<1>(lds, A0, D, FIN + wi * FIN_SZ, ph == 2 ? MT : MX, 2 * FH, D, BIG, FH, nullptr);
        } else if (kind == 3) {
            const bf16_t* A = BIG; int lda = FH, M = MX, K = FH; const bf16_t* Bt; bf16_t* O = A0;
            if (ph == 3) { Bt = FOUT; M = MT; }
            else if (ph == 7) { A = A0; lda = D; K = D; Bt = HOUT; O = BIG; }
            else if (ph == 10) Bt = FOUT + 1 * FOUT_SZ;
            else if (ph == 13) Bt = FOUT + 2 * FOUT_SZ;
            else if (ph == 17) { lda = 2 * CMI; K = CMI; Bt = COUT; }
            else Bt = FOUT + 3 * FOUT_SZ;
            if (EN & 8) run_gemm<0>(lds, A, lda, Bt, M, D, K, O, D, nullptr);
        } else if (kind == 4) { if (EN & 16) run_gemm<2>(lds, A0, D, HIN, MT, HG5, D, BIG, HG5, lbv); }
        else if (kind == 5) { if (EN & 32) gla_phase(p, lds); }
        else if (kind == 6) { if (EN & 64) run_gemm<3>(lds, A0, D, CIN, MX, 2 * CMI, D, BIG, 2 * CMI, nullptr); }
        else { if (EN & 128) cm_gate_phase(p, lds); }
        if (ph + 1 < p.ph_hi) {
            if (ph == 0) { grid.sync(); xb = xcd_barrier_post((unsigned*)(p.ws + WS_BAR), xst); }
            else xcd_barrier(xb);
        }
        if (PROBE_KINDS && ((PROBE_KINDS >> kind) & 1)) probe_acc += wall_clock64() - probe_t0;
    }
    if (PROBE_KINDS && blockIdx.x == 0 && threadIdx.x == 0) { const long long te = wall_clock64(); while (wall_clock64() - te < PROBE_K * probe_acc) __builtin_amdgcn_s_sleep(8); }
}

extern "C" void kernel_launch(void* const* d_in, const int* in_sizes, int n_in, void* d_out, int out_size, void* d_ws, size_t ws_size, hipStream_t stream) {
    static int grid_blocks = 0;
    if (grid_blocks == 0) {
        if (n_in != 20 || out_size != MX * D || ws_size < WS_END) { fprintf(stderr, "kernel_launch: unexpected shapes (n_in %d out %d ws %zu need %zu)\n", n_in, out_size, ws_size, (size_t)WS_END); grid_blocks = -1; return; }
        int dev = 0, cus = 0, per_cu = 0;
        hipGetDevice(&dev);
        hipDeviceGetAttribute(&cus, hipDeviceAttributeMultiprocessorCount, dev);
        if (hipFuncSetAttribute((const void*)fwd_megakernel, hipFuncAttributeMaxDynamicSharedMemorySize, LDS_BYTES) != hipSuccess) { fprintf(stderr, "kernel_launch: hipFuncSetAttribute failed\n"); grid_blocks = -1; return; }
        if (hipOccupancyMaxActiveBlocksPerMultiprocessor(&per_cu, (const void*)fwd_megakernel, NTHREADS, LDS_BYTES) != hipSuccess || per_cu < 1) { fprintf(stderr, "kernel_launch: occupancy query says %d\n", per_cu); per_cu = 1; }
        (void)hipGetLastError();
        grid_blocks = cus * 1;
    }
    if (grid_blocks < 0) return;
    Params p{};
    for (int i = 0; i < 20; ++i) p.in[i] = (const float*)d_in[i];
    p.out = (float*)d_out; p.ws = (unsigned char*)d_ws; p.ph_lo = 0; p.ph_hi = 22;
    void* args[] = {&p};
    hipError_t e = hipLaunchCooperativeKernel((const void*)fwd_megakernel, dim3(grid_blocks), dim3(NTHREADS), args, LDS_BYTES, stream);
    if (e != hipSuccess) fprintf(stderr, "cooperative launch failed: %s (grid %d)\n", hipGetErrorString(e), grid_blocks);
}
```

```cpp
#include <hip/hip_runtime.h>
#include <hip/hip_cooperative_groups.h>
#include <cstdio>
#include <cstdint>
namespace cg = cooperative_groups;

#define LAS __attribute__((address_space(3)))
typedef unsigned short bf16_t;
typedef short bf16x8 __attribute__((ext_vector_type(8)));
typedef float f32x4 __attribute__((ext_vector_type(4)));
typedef float f32x2 __attribute__((ext_vector_type(2)));
typedef unsigned u32x4 __attribute__((ext_vector_type(4)));
typedef unsigned u32x2 __attribute__((ext_vector_type(2)));

constexpr int D = 1024, NB = 32, SEQ = 2048, CTXL = 256;
constexpr int MX = NB * SEQ;
constexpr int MC = NB * CTXL;
constexpr int MT = MX + MC;
constexpr int FH = 2816, HG5 = 5 * D, CMI = 3072, NMOD = 9;
constexpr float DN_ALPHA = 1.41421356237309515f;
constexpr float LN_EPS = 1e-5f, RMS_EPS = 1e-6f;
constexpr int LDS_BYTES = 149504;
constexpr int NTHREADS = 512;

constexpr size_t WS_MOD = 0;
constexpr size_t WS_LB = WS_MOD + (size_t)2 * 33 * 9216 * 4;
constexpr size_t WS_BAR = WS_LB + 2 * 1024 * 4;
constexpr size_t WS_FIN = WS_BAR + 4096 * 4;
constexpr size_t WS_FOUT = WS_FIN + (size_t)4 * 5632 * 1024 * 2;
constexpr size_t WS_HIN = WS_FOUT + (size_t)4 * 1024 * 2816 * 2;
constexpr size_t WS_HOUT = WS_HIN + (size_t)5120 * 1024 * 2;
constexpr size_t WS_CIN = WS_HOUT + (size_t)1024 * 1024 * 2;
constexpr size_t WS_COUT = WS_CIN + (size_t)6144 * 1024 * 2;
constexpr size_t WS_WSB = WS_COUT + (size_t)1024 * 3072 * 2;
constexpr size_t WS_A0 = WS_WSB + (size_t)8 * 128 * 128 * 2;
constexpr size_t WS_BIG = WS_A0 + (size_t)MT * 1024 * 2;
constexpr size_t WS_END = WS_BIG + (size_t)MX * 6144 * 2;

struct Params {
    const float* in[20];
    float* out;
    unsigned char* ws;
    int ph_lo, ph_hi;
};

__device__ __forceinline__ unsigned cvt_pk_bf16(float lo, float hi) { unsigned r; asm volatile("v_cvt_pk_bf16_f32 %0, %1, %2" : "=v"(r) : "v"(lo), "v"(hi)); return r; }
__device__ __forceinline__ int opaque_tid() { int t = threadIdx.x; asm volatile("" : "+v"(t)); return t; }
__device__ __forceinline__ void lds_barrier() { asm volatile("s_waitcnt lgkmcnt(0)" ::: "memory"); __builtin_amdgcn_s_barrier(); asm volatile("" ::: "memory"); }
__device__ __forceinline__ float bf_lo(unsigned u) { return __uint_as_float(u << 16); }
__device__ __forceinline__ float bf_hi(unsigned u) { return __uint_as_float(u & 0xffff0000u); }
__device__ __forceinline__ float wave_sum(float v) {
#pragma unroll
    for (int o = 1; o < 64; o <<= 1) v += __shfl_xor(v, o);
    return v;
}
__device__ __forceinline__ float sigmoid_f(float x) { return __builtin_amdgcn_rcpf(1.f + __expf(-x)); }
__device__ __forceinline__ float silu_f(float x) { return x * sigmoid_f(x); }
__device__ __forceinline__ float gelu_tanh_f(float x) { const float u = 0.7978845608028654f * (x + 0.044715f * x * x * x); return x * sigmoid_f(2.f * u); }

namespace pg8 {
constexpr int BM = 256, BK = 64, HALF = 128, HTB = HALF * BK * 2, STAGE_BYTES = 8 * HTB, NXCD = 8, WGM = 8;
__host__ __device__ __forceinline__ int lds_byte(int r, int c) { const int st = (r >> 4) * 2 + (c >> 5), rr = r & 15, cc = c & 31, ob = rr * 64 + cc * 2; return st * 1024 + (ob ^ (((ob >> 9) & 1) << 5)); }
__host__ __device__ __forceinline__ void stage_rc(int b, int& R, int& C) { const int st = b / 1024, sb = b % 1024, swz = sb ^ (((sb >> 9) & 1) << 5); R = (st >> 1) * 16 + swz / 64; C = (st & 1) * 32 + (swz % 64) / 2; }
__host__ __device__ __forceinline__ int perm32(int rho) { const int n = rho >> 4, i = rho & 15; return 8 * (i >> 2) + 4 * n + (i & 3); }

struct Unit { int pm, pn; };
struct Gemm { const bf16_t* A; int lda; const bf16_t* Bt; int M, N, K; };

struct StaticOrder {
    int nM, nN, nwg, G, c;
    __device__ void init(int M, int N, int G_, int c_) { nM = M / BM; nN = N / BM; nwg = nM * nN; G = G_; c = c_; }
    __device__ bool next(int i, Unit& u) const {
        const long L = (long)i * G + c; if (L >= nwg) return false;
        int wgid = (int)L; { const int q = nwg / NXCD, r = nwg % NXCD, xcd = wgid % NXCD, off = wgid / NXCD; wgid = (xcd < r ? xcd * (q + 1) : r * (q + 1) + (xcd - r) * q) + off; }
        const int nig = WGM * nN, gid = wgid / nig, fm = gid * WGM, gsz = (nM - fm) < WGM ? (nM - fm) : WGM;
        u.pm = fm + ((wgid % nig) % gsz); u.pn = (wgid % nig) / gsz; return true;
    }
};

template <int MODE> struct Epi {
    bf16_t* O; int ldo; const float* lb;
    __device__ __forceinline__ void operator()(const f32x4 (&acc)[2][2][4][2], const Unit& u, int wr, int wc, int fr, int fq) const {
        const int row0 = u.pm * BM + wr * 64 + fr;
        if constexpr (MODE == 1) {
            const int col0 = u.pn * 128 + wc * 32 + 8 * fq;
#pragma unroll
            for (int ai = 0; ai < 2; ++ai)
#pragma unroll
                for (int m = 0; m < 4; ++m) {
                    const f32x4 g0 = acc[ai][0][m][0], g1 = acc[ai][0][m][1], u0 = acc[ai][1][m][0], u1 = acc[ai][1][m][1];
                    u32x4 o;
                    o.x = cvt_pk_bf16(silu_f(g0[0]) * u0[0], silu_f(g0[1]) * u0[1]);
                    o.y = cvt_pk_bf16(silu_f(g0[2]) * u0[2], silu_f(g0[3]) * u0[3]);
                    o.z = cvt_pk_bf16(silu_f(g1[0]) * u1[0], silu_f(g1[1]) * u1[1]);
                    o.w = cvt_pk_bf16(silu_f(g1[2]) * u1[2], silu_f(g1[3]) * u1[3]);
                    *(u32x4*)(O + (size_t)(row0 + ai * HALF + m * 16) * ldo + col0) = o;
                    __builtin_amdgcn_sched_barrier(0);
                }
        } else {
            const int seg = u.pn >> 2;
#pragma unroll
            for (int bj = 0; bj < 2; ++bj) {
                const int col0 = u.pn * BM + bj * HALF + wc * 32 + 8 * fq;
                f32x4 l0 = {0.f, 0.f, 0.f, 0.f}, l1 = {0.f, 0.f, 0.f, 0.f};
                if (MODE == 2 && (seg == 2 || seg == 3)) { const float* lp = lb + (seg - 2) * 1024 + (col0 & 1023); l0 = *(const f32x4*)lp; l1 = *(const f32x4*)(lp + 4); }
#pragma unroll
                for (int ai = 0; ai < 2; ++ai)
#pragma unroll
                    for (int m = 0; m < 4; ++m) {
                        f32x4 v0 = acc[ai][bj][m][0], v1 = acc[ai][bj][m][1];
                        if constexpr (MODE == 3) {
#pragma unroll
                            for (int i = 0; i < 4; ++i) { v0[i] = gelu_tanh_f(v0[i]); v1[i] = gelu_tanh_f(v1[i]); }
                        }
                        if constexpr (MODE == 2) {
                            if (seg == 0 || seg == 4) {
#pragma unroll
                                for (int i = 0; i < 4; ++i) { v0[i] = silu_f(v0[i]); v1[i] = silu_f(v1[i]); }
                            } else if (seg >= 2) {
#pragma unroll
                                for (int i = 0; i < 4; ++i) {
                                    v0[i] = __logf(l0[i] + (1.f - l0[i]) * sigmoid_f(v0[i]));
                                    v1[i] = __logf(l1[i] + (1.f - l1[i]) * sigmoid_f(v1[i]));
                                }
                            }
                        }
                        u32x4 o;
                        o.x = cvt_pk_bf16(v0[0], v0[1]); o.y = cvt_pk_bf16(v0[2], v0[3]); o.z = cvt_pk_bf16(v1[0], v1[1]); o.w = cvt_pk_bf16(v1[2], v1[3]);
                        *(u32x4*)(O + (size_t)(row0 + ai * HALF + m * 16) * ldo + col0) = o;
                        __builtin_amdgcn_sched_barrier(0);
                    }
            }
        }
    }
};

template <class EpiT>
__device__ __forceinline__ void gemm_phase(LAS unsigned char* lds, const Gemm g, const StaticOrder& S, const EpiT& E) {
    const int tid = opaque_tid(), wid = __builtin_amdgcn_readfirstlane(tid >> 6), lane = tid & 63, wr = wid >> 2, wc = wid & 3, fr = lane & 15, fq = lane >> 4;
    const int K = g.K, nt = K / BK, lda = g.lda;
    unsigned voffA[2], voffB[2];
#pragma unroll
    for (int i = 0; i < 2; ++i) { int R, C; stage_rc(tid * 16 + i * 8192, R, C); const int Rb = (R & ~31) + perm32(R & 31);
        voffA[i] = (unsigned)(R * lda + C) * 2u; voffB[i] = (unsigned)(Rb * K + C) * 2u; }
    const size_t kstep = (size_t)(BK * 2);
    const size_t hstepA = (size_t)HALF * lda * 2, hstepB = (size_t)HALF * K * 2;
    const size_t tstepA = 2 * hstepA, tstepB = 2 * hstepB;
    const unsigned ldsw = (unsigned)wid * 1024u;
    const int aoff = lds_byte(wr * 64 + fr, fq * 8), boff = lds_byte(wc * 32 + fr, fq * 8);
#define PG8_SA(b, h) (((b) * 2 + (h)) * HTB)
#define PG8_SB(b, h) ((4 + (b) * 2 + (h)) * HTB)
#define PG8_STAGE(bufoff, gbase, voff) do { _Pragma("unroll") for (int _i = 0; _i < 2; ++_i) \
        __builtin_amdgcn_global_load_lds((const unsigned*)((const char*)(gbase) + (voff)[_i]), (LAS unsigned*)(lds + (bufoff) + ldsw + _i * 8192), 16, 0, 0); } while (0)
#define PG8_LDA(dst, b, h) do { _Pragma("unroll") for (int m = 0; m < 4; ++m) _Pragma("unroll") for (int k = 0; k < 2; ++k) dst[m][k] = *(const LAS bf16x8*)(lds + PG8_SA(b, h) + aoff + m * 2048 + k * 1024); } while (0)
#define PG8_LDB(dst, b, h) do { _Pragma("unroll") for (int n = 0; n < 2; ++n) _Pragma("unroll") for (int k = 0; k < 2; ++k) dst[n][k] = *(const LAS bf16x8*)(lds + PG8_SB(b, h) + boff + n * 2048 + k * 1024); } while (0)
#define PG8_MMA(ai, bj, At, Bt) do { __builtin_amdgcn_s_setprio(1); _Pragma("unroll") for (int m = 0; m < 4; ++m) _Pragma("unroll") for (int n = 0; n < 2; ++n) _Pragma("unroll") for (int k = 0; k < 2; ++k) \
        acc[ai][bj][m][n] = __builtin_amdgcn_mfma_f32_16x16x32_bf16(Bt[n][k], At[m][k], acc[ai][bj][m][n], 0, 0, 0); __builtin_amdgcn_s_setprio(0); } while (0)
#define PG8_WAIT_V(n) asm volatile("s_waitcnt vmcnt(" #n ")" ::: "memory")
#define PG8_WAIT_L(n) asm volatile("s_waitcnt lgkmcnt(" #n ")" ::: "memory")
#define PG8_BAR __builtin_amdgcn_s_barrier()
#define PG8_SCHED __builtin_amdgcn_sched_barrier(0)
    Unit cur, nxt; int ui = 0;
    if (!S.next(0, cur)) return;
    f32x4 acc[2][2][4][2];
#pragma unroll
    for (int a = 0; a < 2; ++a)
#pragma unroll
        for (int b = 0; b < 2; ++b)
#pragma unroll
            for (int m = 0; m < 4; ++m)
#pragma unroll
                for (int n = 0; n < 2; ++n) acc[a][b][m][n] = (f32x4){0.f, 0.f, 0.f, 0.f};
    bf16x8 At[4][2], B0[2][2], B1[2][2];
    const char* cA = (const char*)g.A + (size_t)cur.pm * tstepA; const char* cB = (const char*)g.Bt + (size_t)cur.pn * tstepB;
    PG8_STAGE(PG8_SB(0, 0), cB, voffB); PG8_STAGE(PG8_SB(0, 1), cB + hstepB, voffB); PG8_STAGE(PG8_SA(0, 0), cA, voffA); PG8_STAGE(PG8_SA(0, 1), cA + hstepA, voffA);
    if (wr == 1) PG8_BAR;
    PG8_WAIT_V(2); PG8_BAR;
    PG8_STAGE(PG8_SB(1, 0), cB + kstep, voffB); PG8_STAGE(PG8_SA(1, 0), cA + kstep, voffA); PG8_STAGE(PG8_SB(1, 1), cB + hstepB + kstep, voffB);
    PG8_WAIT_V(6); PG8_BAR;
    for (;;) {
        const bool has_next = S.next(ui + 1, nxt);
        const char* nA = has_next ? (const char*)g.A + (size_t)nxt.pm * tstepA : cA; const char* nB = has_next ? (const char*)g.Bt + (size_t)nxt.pn * tstepB : cB;
        for (int t = 0; t < nt; t += 2) {
            const bool last = (t == nt - 2);
            const char* a1 = cA + (size_t)(t + 1) * kstep;
            const char* a2 = last ? nA : cA + (size_t)(t + 2) * kstep; const char* b2 = last ? nB : cB + (size_t)(t + 2) * kstep;
            const char* a3 = a2 + kstep; const char* b3 = b2 + kstep;
            PG8_LDB(B0, 0, 0); PG8_LDB(B1, 0, 1); PG8_SCHED; PG8_LDA(At, 0, 0); PG8_STAGE(PG8_SA(1, 1), a1 + hstepA, voffA);
            PG8_WAIT_V(8); PG8_WAIT_L(0); PG8_BAR; PG8_MMA(0, 0, At, B0); PG8_MMA(0, 1, At, B1); PG8_BAR; PG8_SCHED;
            PG8_LDA(At, 0, 1); PG8_STAGE(PG8_SB(0, 0), b2, voffB); PG8_STAGE(PG8_SB(0, 1), b2 + hstepB, voffB); PG8_STAGE(PG8_SA(0, 0), a2, voffA);
            PG8_WAIT_V(8); PG8_WAIT_L(0); PG8_BAR; PG8_MMA(1, 0, At, B0); PG8_MMA(1, 1, At, B1); PG8_BAR; PG8_SCHED;
            PG8_LDB(B0, 1, 0); PG8_LDB(B1, 1, 1); PG8_SCHED; PG8_LDA(At, 1, 0); PG8_STAGE(PG8_SA(0, 1), a2 + hstepA, voffA);
            PG8_WAIT_V(8); PG8_WAIT_L(0); PG8_BAR; PG8_MMA(0, 0, At, B0); PG8_MMA(0, 1, At, B1); PG8_BAR; PG8_SCHED;
            PG8_LDA(At, 1, 1); PG8_STAGE(PG8_SB(1, 0), b3, voffB); PG8_STAGE(PG8_SB(1, 1), b3 + hstepB, voffB); PG8_STAGE(PG8_SA(1, 0), a3, voffA);
            PG8_WAIT_V(8); PG8_WAIT_L(0); PG8_BAR; PG8_MMA(1, 0, At, B0); PG8_MMA(1, 1, At, B1); PG8_BAR; PG8_SCHED;
        }
        if (wr == 0) PG8_BAR;
        E(acc, cur, wr, wc, fr, fq);
        if (!has_next) break;
#pragma unroll
        for (int a = 0; a < 2; ++a)
#pragma unroll
            for (int b = 0; b < 2; ++b)
#pragma unroll
                for (int m = 0; m < 4; ++m)
#pragma unroll
                    for (int n = 0; n < 2; ++n) acc[a][b][m][n] = (f32x4){0.f, 0.f, 0.f, 0.f};
        cur = nxt; cA = nA; cB = nB; ++ui;
        if (wr == 1) PG8_BAR;
    }
    PG8_WAIT_V(0);
    PG8_BAR;
#undef PG8_SA
#undef PG8_SB
#undef PG8_STAGE
#undef PG8_LDA
#undef PG8_LDB
#undef PG8_MMA
#undef PG8_WAIT_V
#undef PG8_WAIT_L
#undef PG8_BAR
#undef PG8_SCHED
}
}

template <int MODE>
__device__ __forceinline__ void run_gemm(LAS unsigned char* lds, const bf16_t* A, int lda, const bf16_t* Bt, int M, int N, int K, bf16_t* O, int ldo, const float* lb) {
    pg8::Gemm g{A, lda, Bt, M, N, K};
    pg8::StaticOrder S; S.init(M, N, gridDim.x, blockIdx.x);
    pg8::Epi<MODE> E{O, ldo, lb};
    pg8::gemm_phase(lds, g, S, E);
}

#define XB_TMO      128
#define XB_XCNT(j)  (256  + 64 * (j))
#define XB_XSUB(j)  (1280 + 64 * (j))
#define XB_XGEN(j)  (2304 + 64 * (j))
#define XB_TOP      3328
#define XB_TOPGEN   3392
#define XCD_BAR_WORDS 3456
#define XB_SPIN_CAP (1u << 22)
__device__ __forceinline__ unsigned xb_ld(unsigned* p)              { return __hip_atomic_load(p, __ATOMIC_RELAXED, __HIP_MEMORY_SCOPE_AGENT); }
__device__ __forceinline__ unsigned xb_add(unsigned* p, unsigned v) { return __hip_atomic_fetch_add(p, v, __ATOMIC_RELAXED, __HIP_MEMORY_SCOPE_AGENT); }
__device__ __forceinline__ unsigned xb_xcc_id() { return (unsigned)__builtin_amdgcn_s_getreg((3 << 11) | 20) & 0xFu; }
#define XB_SPIN(cond, bar) do { unsigned _sp = 0; while (cond) { __builtin_amdgcn_s_sleep(1); \
    if ((++_sp & 255u) == 0u) { if (xb_ld(&(bar)[XB_TMO])) break; if (_sp > XB_SPIN_CAP) { atomicAdd(&(bar)[XB_TMO], 1u); break; } } } } while (0)
struct XcdBarrier { unsigned* bar; unsigned x; volatile LAS unsigned* st; };
__device__ __forceinline__ XcdBarrier xcd_barrier_post(unsigned* bar, volatile LAS unsigned* st) {
    XcdBarrier b; b.bar = bar; b.x = xb_xcc_id(); b.st = st;
    if (threadIdx.x == 0) (void)xb_add(&bar[XB_XCNT(b.x)], 1u);
    return b;
}
__device__ __forceinline__ void xcd_barrier_complete(unsigned* bar, unsigned x, unsigned& nloc, unsigned& nx) {
    const unsigned G = gridDim.x * gridDim.y * gridDim.z;
    unsigned sum, cnt, mine, sp = 0u;
    for (;;) {
        sum = 0u; cnt = 0u; mine = 0u;
#pragma unroll
        for (unsigned j = 0; j < 16; ++j) { const unsigned c = xb_ld(&bar[XB_XCNT(j)]); sum += c; cnt += (c > 0u) ? 1u : 0u; mine = (j == x) ? c : mine; }
        if (sum == G) break;
        __builtin_amdgcn_s_sleep(1);
        if ((++sp & 255u) == 0u) { if (xb_ld(&bar[XB_TMO])) break; if (sp > XB_SPIN_CAP) { atomicAdd(&bar[XB_TMO], 1u); break; } }
    }
    nloc = mine > 0u ? mine : 1u; nx = cnt > 0u ? cnt : 1u;
}
__device__ __forceinline__ void xcd_barrier(const XcdBarrier& b) {
    asm volatile("s_waitcnt vmcnt(0)" ::: "memory");
    __syncthreads();
    if (threadIdx.x == 0) {
        unsigned* bar = b.bar;
        __builtin_amdgcn_s_waitcnt(0);
        unsigned nloc = b.st[0], nx = b.st[1];
        if (nloc == 0u) { xcd_barrier_complete(bar, b.x, nloc, nx); b.st[0] = nloc; b.st[1] = nx; }
        const unsigned old = xb_add(&bar[XB_XSUB(b.x)], 1u);
        const unsigned gen = old / nloc;
        if (old + 1u == (gen + 1u) * nloc) {
            __builtin_amdgcn_fence(__ATOMIC_RELEASE, "agent");
            asm volatile("s_waitcnt vmcnt(0)" ::: "memory");
            const unsigned og = xb_add(&bar[XB_TOP], 1u);
            const unsigned tg = og / nx;
            if (og + 1u == (tg + 1u) * nx) xb_add(&bar[XB_TOPGEN], 1u);
            else XB_SPIN(xb_ld(&bar[XB_TOPGEN]) == tg, bar);
            __builtin_amdgcn_fence(__ATOMIC_ACQUIRE, "agent");
            xb_add(&bar[XB_XGEN(b.x)], 1u);
            asm volatile("s_waitcnt vmcnt(0)" ::: "memory");
        } else {
            XB_SPIN(xb_ld(&bar[XB_XGEN(b.x)]) == gen, bar);
            __builtin_amdgcn_fence(__ATOMIC_ACQUIRE, "agent");
            asm volatile("s_waitcnt vmcnt(0)" ::: "memory");
        }
    }
    __syncthreads();
}


__device__ __forceinline__ void p0_mod_item(const Params& p, LAS unsigned char* lds, int item) {
    const int tid = opaque_tid();
    const int layer = item / 72, cgp = item % 72, col0 = cgp * 128;
    const float* c = p.in[1]; const float* cctx = p.in[3];
    const float* W = p.in[4] + (size_t)layer * 1024 * 9216; const float* bias = p.in[5] + (size_t)layer * 9216;
    float* mout = (float*)(p.ws + WS_MOD) + (size_t)layer * 33 * 9216;
    LAS float* S = (LAS float*)lds;
    __syncthreads();
    for (int i = tid; i < 33 * 1024; i += NTHREADS) { const int r = i >> 10, k = i & 1023; const float v = r < 32 ? c[r * 1024 + k] : cctx[k]; S[i] = silu_f(v); }
    __syncthreads();
    const int col = tid & 63, ks = tid >> 6;
    float acc0[33], acc1[33];
#pragma unroll
    for (int r = 0; r < 33; ++r) { acc0[r] = 0.f; acc1[r] = 0.f; }
    const float* wp = W + (size_t)(ks * 128) * 9216 + col0 + col;
    float wa[4], wb[4], na[4], nb[4];
#pragma unroll
    for (int j = 0; j < 4; ++j) { wa[j] = wp[(size_t)j * 9216]; wb[j] = wp[(size_t)j * 9216 + 64]; }
    for (int k4 = 0; k4 < 32; ++k4) {
        const int k = ks * 128 + k4 * 4;
        if (k4 + 1 < 32) {
#pragma unroll
            for (int j = 0; j < 4; ++j) { na[j] = wp[(size_t)(4 * (k4 + 1) + j) * 9216]; nb[j] = wp[(size_t)(4 * (k4 + 1) + j) * 9216 + 64]; }
        }
#pragma unroll
        for (int r = 0; r < 33; ++r) { const f32x4 s4 = *(const LAS f32x4*)(S + r * 1024 + k);
            acc0[r] += wa[0] * s4[0] + wa[1] * s4[1] + wa[2] * s4[2] + wa[3] * s4[3];
            acc1[r] += wb[0] * s4[0] + wb[1] * s4[1] + wb[2] * s4[2] + wb[3] * s4[3]; }
#pragma unroll
        for (int j = 0; j < 4; ++j) { wa[j] = na[j]; wb[j] = nb[j]; }
    }
    __syncthreads();
    LAS float* red = (LAS float*)lds;
#pragma unroll
    for (int r = 0; r < 33; ++r) { red[(ks * 33 + r) * 128 + col] = acc0[r]; red[(ks * 33 + r) * 128 + 64 + col] = acc1[r]; }
    __syncthreads();
    for (int i = tid; i < 33 * 128; i += NTHREADS) {
        const int r = i >> 7, cc = i & 127; float s = 0.f;
#pragma unroll
        for (int q = 0; q < 8; ++q) s += red[(q * 33 + r) * 128 + cc];
        mout[(size_t)r * 9216 + col0 + cc] = s + bias[col0 + cc];
    }
    __syncthreads();
}

__device__ __forceinline__ void p0_transpose_item(const float* W, int K, int N, bf16_t* WT, int k0, int n0, int drow0, LAS float* scr, int lane) {
    const int n4 = lane & 15, kr = lane >> 4;
    f32x4 v[16];
#pragma unroll
    for (int i = 0; i < 16; ++i) v[i] = *(const f32x4*)(W + (size_t)(k0 + 4 * i + kr) * N + n0 + 4 * n4);
#pragma unroll
    for (int i = 0; i < 16; ++i) { LAS float* d = scr + (4 * i + kr) * 65 + 4 * n4; d[0] = v[i][0]; d[1] = v[i][1]; d[2] = v[i][2]; d[3] = v[i][3]; }
    asm volatile("s_waitcnt lgkmcnt(0)" ::: "memory");
    const int c = lane & 7;
#pragma unroll
    for (int j = 0; j < 8; ++j) { const int n = (lane >> 3) + 8 * j; const LAS float* s = scr + (8 * c) * 65 + n;
        u32x4 o; o.x = cvt_pk_bf16(s[0 * 65], s[1 * 65]); o.y = cvt_pk_bf16(s[2 * 65], s[3 * 65]); o.z = cvt_pk_bf16(s[4 * 65], s[5 * 65]); o.w = cvt_pk_bf16(s[6 * 65], s[7 * 65]);
        *(u32x4*)(WT + (size_t)(drow0 + n) * K + k0 + 8 * c) = o; }
    asm volatile("s_waitcnt lgkmcnt(0)" ::: "memory");
}

__device__ __forceinline__ void phase0(const Params& p, LAS unsigned char* lds) {
    const int tid = opaque_tid(), wid = tid >> 6, lane = tid & 63;
    if (blockIdx.x == 0) { unsigned* bar = (unsigned*)(p.ws + WS_BAR); for (int i = tid; i < 4096; i += NTHREADS) bar[i] = 0u; }
    if (blockIdx.x == gridDim.x - 1) {
        const float* lbp = p.in[11]; float* lbo = (float*)(p.ws + WS_LB);
        for (int i = tid; i < 2048; i += NTHREADS) { const int dir = i >> 10, col = i & 1023;
            const float l0 = lbp[(dir * 3 + 0) * 1024 + col], l1 = lbp[(dir * 3 + 1) * 1024 + col], l2 = lbp[(dir * 3 + 2) * 1024 + col];
            const float mx = fmaxf(l0, fmaxf(l1, l2)); const float e0 = __expf(l0 - mx), e1 = __expf(l1 - mx), e2 = __expf(l2 - mx);
            lbo[i] = e0 / (e0 + e1 + e2); }
    }
    if (blockIdx.x == gridDim.x - 2) {
        const float* wsp = p.in[17]; bf16_t* wsb = (bf16_t*)(p.ws + WS_WSB);
        for (int i = tid; i < 8 * 128 * 128 / 4; i += NTHREADS) { const f32x4 w = *(const f32x4*)(wsp + 4 * i); u32x2 o; o.x = cvt_pk_bf16(w[0], w[1]); o.y = cvt_pk_bf16(w[2], w[3]); *(u32x2*)(wsb + 4 * i) = o; }
    }
    for (int it = blockIdx.x; it < 144; it += gridDim.x) p0_mod_item(p, lds, it);
    __syncthreads();
    LAS float* scr = (LAS float*)lds + wid * (64 * 65);
    const int gw = blockIdx.x * 8 + wid, nw = gridDim.x * 8;
    for (int git = gw; git < 12288; git += nw) {
        int it = git, mi = 0;
        for (; mi < 12; ++mi) { const int cnt = mi < 4 ? 1408 : (mi < 8 ? 704 : (mi == 8 ? 1280 : (mi == 9 ? 256 : (mi == 10 ? 1536 : 768)))); if (it < cnt) break; it -= cnt; }
        const float* W; bf16_t* WT; int K, N, mode = 0;
        if (mi < 4) { W = p.in[8] + (size_t)mi * 1024 * 5632; WT = (bf16_t*)(p.ws + WS_FIN) + (size_t)mi * 5632 * 1024; K = 1024; N = 5632; mode = 1; }
        else if (mi < 8) { W = p.in[9] + (size_t)(mi - 4) * 2816 * 1024; WT = (bf16_t*)(p.ws + WS_FOUT) + (size_t)(mi - 4) * 1024 * 2816; K = 2816; N = 1024; }
        else if (mi == 8) { W = p.in[10]; WT = (bf16_t*)(p.ws + WS_HIN); K = 1024; N = 5120; }
        else if (mi == 9) { W = p.in[13]; WT = (bf16_t*)(p.ws + WS_HOUT); K = 1024; N = 1024; }
        else if (mi == 10) { W = p.in[14]; WT = (bf16_t*)(p.ws + WS_CIN); K = 1024; N = 6144; }
        else { W = p.in[19]; WT = (bf16_t*)(p.ws + WS_COUT); K = 3072; N = 1024; }
        const int nblk = N / 64;
        const int kb = it / nblk, nb = it % nblk, n0 = nb * 64;
        int drow0 = n0;
        if (mode == 1) { const int j = n0 < FH ? n0 : n0 - FH; drow0 = 256 * (j >> 7) + (n0 < FH ? 0 : 128) + (j & 127); }
        p0_transpose_item(W, K, N, WT, kb * 64, n0, drow0, scr, lane);
    }
}

struct RowArgs {
    const float* xs_x; const float* xs_c; int nrows;
    const bf16_t* y; float ysc; const float* m; int k; const float* g; const float* b;
    float* xd; bf16_t* hd; const float* m2; int k2;
};
__device__ __forceinline__ void row_phase(const RowArgs& a) {
    const int tid0 = opaque_tid(); const int wid = tid0 >> 6, lane = tid0 & 63;
    constexpr int NR = 4;
    for (int rowb = blockIdx.x * (8 * NR) + wid; rowb < a.nrows; rowb += gridDim.x * (8 * NR)) {
        const int mrow = rowb < MX ? (rowb >> 11) : 32;
        f32x4 v[NR][4];
#pragma unroll
        for (int q = 0; q < NR; ++q) {
            const int row = rowb + 8 * q;
            const float* xr = row < MX ? a.xs_x + (size_t)row * D : a.xs_c + (size_t)(row - MX) * D;
#pragma unroll
            for (int j = 0; j < 4; ++j) v[q][j] = *(const f32x4*)(xr + j * 256 + lane * 4);
        }
        if (a.y) {
            u32x2 yy[NR][4]; f32x4 gt[4];
            const float* gp = a.m + (size_t)mrow * 9216 + (3 * a.k + 2) * 1024;
#pragma unroll
            for (int q = 0; q < NR; ++q) {
                const int row = rowb + 8 * q;
#pragma unroll
                for (int j = 0; j < 4; ++j) yy[q][j] = *(const u32x2*)(a.y + (size_t)row * D + j * 256 + lane * 4);
            }
#pragma unroll
            for (int j = 0; j < 4; ++j) gt[j] = *(const f32x4*)(gp + j * 256 + lane * 4) * a.ysc;
            float s[NR];
#pragma unroll
            for (int q = 0; q < NR; ++q) {
                s[q] = 0.f;
#pragma unroll
                for (int j = 0; j < 4; ++j) {
                    v[q][j][0] = DN_ALPHA * v[q][j][0] + gt[j][0] * bf_lo(yy[q][j].x); v[q][j][1] = DN_ALPHA * v[q][j][1] + gt[j][1] * bf_hi(yy[q][j].x);
                    v[q][j][2] = DN_ALPHA * v[q][j][2] + gt[j][2] * bf_lo(yy[q][j].y); v[q][j][3] = DN_ALPHA * v[q][j][3] + gt[j][3] * bf_hi(yy[q][j].y);
                    s[q] += (v[q][j][0] + v[q][j][1]) + (v[q][j][2] + v[q][j][3]);
                }
            }
            float mean[NR], s2[NR];
#pragma unroll
            for (int q = 0; q < NR; ++q) mean[q] = wave_sum(s[q]) * (1.f / D);
#pragma unroll
            for (int q = 0; q < NR; ++q) {
                s2[q] = 0.f;
#pragma unroll
                for (int j = 0; j < 4; ++j) { v[q][j] = v[q][j] - mean[q]; s2[q] += (v[q][j][0] * v[q][j][0] + v[q][j][1] * v[q][j][1]) + (v[q][j][2] * v[q][j][2] + v[q][j][3] * v[q][j][3]); }
            }
            f32x4 gg[4], bb[4];
#pragma unroll
            for (int j = 0; j < 4; ++j) { gg[j] = *(const f32x4*)(a.g + j * 256 + lane * 4); bb[j] = *(const f32x4*)(a.b + j * 256 + lane * 4); }
#pragma unroll
            for (int q = 0; q < NR; ++q) {
                const int row = rowb + 8 * q;
                const float rstd = __builtin_amdgcn_rsqf(wave_sum(s2[q]) * (1.f / D) + LN_EPS);
#pragma unroll
                for (int j = 0; j < 4; ++j) v[q][j] = v[q][j] * rstd * gg[j] + bb[j];
                if (a.xd && row < MX) {
#pragma unroll
                    for (int j = 0; j < 4; ++j) *(f32x4*)(a.xd + (size_t)row * D + j * 256 + lane * 4) = v[q][j];
                }
            }
        }
        if (a.hd) {
            const float* shp = a.m2 + (size_t)mrow * 9216 + (3 * a.k2) * 1024; const float* scp = shp + 1024;
            f32x4 sh[4], sc[4];
#pragma unroll
            for (int j = 0; j < 4; ++j) { sh[j] = *(const f32x4*)(shp + j * 256 + lane * 4); sc[j] = *(const f32x4*)(scp + j * 256 + lane * 4) + 1.f; }
#pragma unroll
            for (int q = 0; q < NR; ++q) {
                const int row = rowb + 8 * q;
#pragma unroll
                for (int j = 0; j < 4; ++j) {
                    const f32x4 h = v[q][j] * sc[j] + sh[j];
                    u32x2 o; o.x = cvt_pk_bf16(h[0], h[1]); o.y = cvt_pk_bf16(h[2], h[3]);
                    *(u32x2*)(a.hd + (size_t)row * D + j * 256 + lane * 4) = o;
                }
            }
        }
    }
}

constexpr int GLA_DIRB = 74240;
__device__ __forceinline__ void gla_phase(const Params& p, LAS unsigned char* lds) {
    const int tid = opaque_tid(), dir = tid >> 8, tl = tid & 255, w = tl >> 6, lane = tl & 63, fr = lane & 15, fq = lane >> 4;
    const int cp = lane, qt = w;
    bf16_t* P = (bf16_t*)(p.ws + WS_BIG); bf16_t* R = (bf16_t*)(p.ws + WS_A0);
    const float* normw = p.in[12];
    LAS unsigned char* base = lds + dir * GLA_DIRB;
    LAS bf16_t* Qin = (LAS bf16_t*)base;
    LAS bf16_t* Kin = (LAS bf16_t*)(base + 17408);
    LAS bf16_t* Sc = Kin;
    LAS bf16_t* KinT = (LAS bf16_t*)(base + 34816);
    LAS bf16_t* VT = (LAS bf16_t*)(base + 53248);
    LAS float* tot = (LAS float*)(base + 71680);
    LAS float* dec = (LAS float*)(base + 73728);
    for (int item = blockIdx.x; item < NB * 8; item += gridDim.x) {
        const int b = item >> 3, h = item & 7;
        f32x4 Sacc[8][2];
#pragma unroll
        for (int m = 0; m < 8; ++m) { Sacc[m][0] = (f32x4){0.f, 0.f, 0.f, 0.f}; Sacc[m][1] = (f32x4){0.f, 0.f, 0.f, 0.f}; }
        unsigned rq[16], rv[16], rl[16];
        auto chunk_row = [&](int ci, int t) -> size_t {
            const bool isc = ci < 4; const int lc = isc ? ci : ci - 4, L = isc ? CTXL : SEQ; const int rbase = isc ? MX + b * CTXL : b * SEQ;
            const int tok = dir == 0 ? 64 * lc + t : L - 1 - (64 * lc + t);
            return (size_t)(rbase + tok);
        };
        auto load_chunk = [&](int ci) {
            long off = (long)(chunk_row(ci, 16 * qt) * HG5 + h * 128 + 2 * cp);
            const long step = dir == 0 ? (long)HG5 : -(long)HG5;
#pragma unroll
            for (int i = 0; i < 16; ++i) {
                const bf16_t* rp = P + off;
                rq[i] = *(const unsigned*)rp; rv[i] = *(const unsigned*)(rp + 1024); rl[i] = *(const unsigned*)(rp + (2 + dir) * 1024);
                off += step; asm volatile("" : "+v"(off));
            }
        };
        __syncthreads();
        load_chunk(0);
        for (int ci = 0; ci < 36; ++ci) {
            const bool isc = ci < 4;
            {
                float run0 = 0.f, run1 = 0.f;
#pragma unroll
                for (int i = 0; i < 16; ++i) { run0 += bf_lo(rl[i]); run1 += bf_hi(rl[i]); }
                *(LAS f32x2*)(tot + qt * 128 + 2 * cp) = (f32x2){run0, run1};
#pragma unroll
                for (int hh = 0; hh < 2; ++hh) {
                    u32x4 a, c;
#pragma unroll
                    for (int u = 0; u < 4; ++u) { const int ip = 4 * hh + u;
                        a[u] = (rv[2 * ip] & 0xffffu) | (rv[2 * ip + 1] << 16); c[u] = (rv[2 * ip] >> 16) | (rv[2 * ip + 1] & 0xffff0000u); }
                    *(LAS u32x4*)(VT + (2 * cp) * 72 + 16 * qt + 8 * hh) = a;
                    *(LAS u32x4*)(VT + (2 * cp + 1) * 72 + 16 * qt + 8 * hh) = c;
                }
                lds_barrier();
                float pre0 = 0.f, pre1 = 0.f, all0 = 0.f, all1 = 0.f;
#pragma unroll
                for (int q = 0; q < 4; ++q) { const f32x2 tq = *(const LAS f32x2*)(tot + q * 128 + 2 * cp); if (q < qt) { pre0 += tq[0]; pre1 += tq[1]; } all0 += tq[0]; all1 += tq[1]; }
                if (qt == 0) *(LAS f32x2*)(dec + 2 * cp) = (f32x2){__expf(all0), __expf(all1)};
                float iebp0 = __expf(-pre0), iebp1 = __expf(-pre1);
                float bb0 = pre0, bb1 = pre1;
#pragma unroll
                for (int hh = 0; hh < 2; ++hh) {
                    u32x4 a, c;
#pragma unroll
                    for (int u4 = 0; u4 < 4; ++u4) {
                        float kin0[2], kin1[2];
#pragma unroll
                        for (int u = 0; u < 2; ++u) {
                            const int i = 8 * hh + 2 * u4 + u, t = 16 * qt + i;
                            bb0 += bf_lo(rl[i]); bb1 += bf_hi(rl[i]);
                            const float eb0 = __expf(bb0), eb1 = __expf(bb1), ieb0 = __expf(-bb0), ieb1 = __expf(-bb1);
                            const float k0 = 1.f - eb0 * iebp0, k1 = 1.f - eb1 * iebp1;
                            iebp0 = ieb0; iebp1 = ieb1;
                            kin0[u] = k0 * ieb0; kin1[u] = k1 * ieb1;
                            *(LAS unsigned*)(Qin + t * 136 + 2 * cp) = cvt_pk_bf16(bf_lo(rq[i]) * eb0, bf_hi(rq[i]) * eb1);
                            *(LAS unsigned*)(Kin + t * 136 + 2 * cp) = cvt_pk_bf16(kin0[u], kin1[u]);
                        }
                        a[u4] = cvt_pk_bf16(kin0[0], kin0[1]); c[u4] = cvt_pk_bf16(kin1[0], kin1[1]);
                    }
                    *(LAS u32x4*)(KinT + (2 * cp) * 72 + 16 * qt + 8 * hh) = a;
                    *(LAS u32x4*)(KinT + (2 * cp + 1) * 72 + 16 * qt + 8 * hh) = c;
                    __builtin_amdgcn_sched_barrier(0);
                }
            }
            lds_barrier();
            if (ci + 1 < 36) load_chunk(ci + 1);
            f32x4 sacc[4];
            if (!isc) {
                bf16x8 qf[4];
#pragma unroll
                for (int ks = 0; ks < 4; ++ks) qf[ks] = *(const LAS bf16x8*)(Qin + (16 * w + fr) * 136 + 32 * ks + 8 * fq);
#pragma unroll
                for (int ms = 0; ms < 4; ++ms) {
                    sacc[ms] = (f32x4){0.f, 0.f, 0.f, 0.f};
                    if (ms <= w) {
#pragma unroll
                        for (int ks = 0; ks < 4; ++ks) { const bf16x8 kf = *(const LAS bf16x8*)(Kin + (16 * ms + fr) * 136 + 32 * ks + 8 * fq);
                            sacc[ms] = __builtin_amdgcn_mfma_f32_16x16x32_bf16(kf, qf[ks], sacc[ms], 0, 0, 0); }
                    }
                }
            }
            lds_barrier();
            if (!isc) {
#pragma unroll
                for (int ms = 0; ms < 4; ++ms) {
                    f32x4 v = sacc[ms];
                    if (ms == w) {
#pragma unroll
                        for (int j = 0; j < 4; ++j) v[j] = (4 * fq + j <= fr) ? v[j] : 0.f;
                    }
                    u32x2 o; o.x = cvt_pk_bf16(v[0], v[1]); o.y = cvt_pk_bf16(v[2], v[3]);
                    *(LAS u32x2*)(Sc + (16 * w + fr) * 72 + 16 * ms + 4 * fq) = o;
                }
            }
            lds_barrier();
            __builtin_amdgcn_sched_barrier(0);
            bf16x8 vfrag[2][2];
#pragma unroll
            for (int n = 0; n < 2; ++n)
#pragma unroll
                for (int ks = 0; ks < 2; ++ks) vfrag[n][ks] = *(const LAS bf16x8*)(VT + (32 * w + 16 * n + fr) * 72 + 32 * ks + 8 * fq);
            if (!isc) {
                f32x4 oacc[2][4];
#pragma unroll
                for (int n = 0; n < 2; ++n)
#pragma unroll
                    for (int tt = 0; tt < 4; ++tt) oacc[n][tt] = (f32x4){0.f, 0.f, 0.f, 0.f};
#pragma unroll
                for (int kk = 0; kk < 4; ++kk) {
                    bf16x8 sf[2];
#pragma unroll
                    for (int n = 0; n < 2; ++n) {
                        u32x4 pk; pk.x = cvt_pk_bf16(Sacc[2 * kk][n][0], Sacc[2 * kk][n][1]); pk.y = cvt_pk_bf16(Sacc[2 * kk][n][2], Sacc[2 * kk][n][3]);
                        pk.z = cvt_pk_bf16(Sacc[2 * kk + 1][n][0], Sacc[2 * kk + 1][n][1]); pk.w = cvt_pk_bf16(Sacc[2 * kk + 1][n][2], Sacc[2 * kk + 1][n][3]);
                        sf[n] = __builtin_bit_cast(bf16x8, pk);
                    }
#pragma unroll
                    for (int tt = 0; tt < 4; ++tt) {
                        const LAS bf16_t* qp = Qin + (16 * tt + fr) * 136 + 32 * kk + 4 * fq;
                        const u32x2 lo = *(const LAS u32x2*)qp, hi = *(const LAS u32x2*)(qp + 16);
                        const bf16x8 qfr = __builtin_bit_cast(bf16x8, ((u32x4){lo.x, lo.y, hi.x, hi.y}));
#pragma unroll
                        for (int n = 0; n < 2; ++n) oacc[n][tt] = __builtin_amdgcn_mfma_f32_16x16x32_bf16(sf[n], qfr, oacc[n][tt], 0, 0, 0);
                    }
                }
                __builtin_amdgcn_sched_barrier(0);
#pragma unroll
                for (int tt = 0; tt < 4; ++tt)
#pragma unroll
                    for (int ks = 0; ks < 2; ++ks) {
                        if (ks == 1 && tt < 2) continue;
                        const bf16x8 scf = *(const LAS bf16x8*)(Sc + (16 * tt + fr) * 72 + 32 * ks + 8 * fq);
#pragma unroll
                        for (int n = 0; n < 2; ++n) oacc[n][tt] = __builtin_amdgcn_mfma_f32_16x16x32_bf16(vfrag[n][ks], scf, oacc[n][tt], 0, 0, 0);
                    }
                __builtin_amdgcn_sched_barrier(0);
#pragma unroll
                for (int tt = 0; tt < 4; ++tt) {
                    bf16_t* op = P + chunk_row(ci, 16 * tt + fr) * HG5 + (2 + dir) * 1024 + h * 128 + 32 * w + 4 * fq;
#pragma unroll
                    for (int n = 0; n < 2; ++n) { u32x2 o; o.x = cvt_pk_bf16(oacc[n][tt][0], oacc[n][tt][1]); o.y = cvt_pk_bf16(oacc[n][tt][2], oacc[n][tt][3]); *(u32x2*)(op + 16 * n) = o; }
                }
            }
            __builtin_amdgcn_sched_barrier(0);
#pragma unroll
            for (int m = 0; m < 8; ++m) {
#pragma unroll
                for (int ks = 0; ks < 2; ++ks) { const bf16x8 kf = *(const LAS bf16x8*)(KinT + (16 * m + fr) * 72 + 32 * ks + 8 * fq);
#pragma unroll
                    for (int n = 0; n < 2; ++n) Sacc[m][n] = __builtin_amdgcn_mfma_f32_16x16x32_bf16(kf, vfrag[n][ks], Sacc[m][n], 0, 0, 0); }
                const f32x4 dv = *(const LAS f32x4*)(dec + 16 * m + 4 * fq);
                Sacc[m][0] *= dv; Sacc[m][1] *= dv;
            }
            lds_barrier();
        }
        __syncthreads();
        {
            const int wid = tid >> 6, lane = tid & 63, sub = lane >> 4, l16 = lane & 15;
            const f32x4 w0 = *(const f32x4*)(normw + 8 * l16), w1 = *(const f32x4*)(normw + 8 * l16 + 4);
            for (int it0 = 0; it0 < 64; it0 += 8) {
                u32x4 of[8], ob[8], gg[8];
#pragma unroll
                for (int u = 0; u < 8; ++u) {
                    const int t = (it0 + u) * 32 + wid * 4 + sub; const bf16_t* rp = P + ((size_t)b * SEQ + t) * HG5 + h * 128 + 8 * l16;
                    of[u] = *(const u32x4*)(rp + 2048); ob[u] = *(const u32x4*)(rp + 3072); gg[u] = *(const u32x4*)(rp + 4096);
                }
#pragma unroll
                for (int u = 0; u < 8; ++u) {
                    const int t = (it0 + u) * 32 + wid * 4 + sub; const size_t row = (size_t)b * SEQ + t;
                    float o[8];
                    o[0] = bf_lo(of[u].x) + bf_lo(ob[u].x); o[1] = bf_hi(of[u].x) + bf_hi(ob[u].x); o[2] = bf_lo(of[u].y) + bf_lo(ob[u].y); o[3] = bf_hi(of[u].y) + bf_hi(ob[u].y);
                    o[4] = bf_lo(of[u].z) + bf_lo(ob[u].z); o[5] = bf_hi(of[u].z) + bf_hi(ob[u].z); o[6] = bf_lo(of[u].w) + bf_lo(ob[u].w); o[7] = bf_hi(of[u].w) + bf_hi(ob[u].w);
                    float ss = 0.f;
#pragma unroll
                    for (int i = 0; i < 8; ++i) ss += o[i] * o[i];
                    ss += __shfl_xor(ss, 1); ss += __shfl_xor(ss, 2); ss += __shfl_xor(ss, 4); ss += __shfl_xor(ss, 8);
                    const float rs = __builtin_amdgcn_rsqf(ss * (1.f / 128.f) + RMS_EPS);
                    u32x4 r;
                    r.x = cvt_pk_bf16(o[0] * rs * w0[0] * bf_lo(gg[u].x), o[1] * rs * w0[1] * bf_hi(gg[u].x));
                    r.y = cvt_pk_bf16(o[2] * rs * w0[2] * bf_lo(gg[u].y), o[3] * rs * w0[3] * bf_hi(gg[u].y));
                    r.z = cvt_pk_bf16(o[4] * rs * w1[0] * bf_lo(gg[u].z), o[5] * rs * w1[1] * bf_hi(gg[u].z));
                    r.w = cvt_pk_bf16(o[6] * rs * w1[2] * bf_lo(gg[u].w), o[7] * rs * w1[3] * bf_hi(gg[u].w));
                    *(u32x4*)(R + row * D + h * 128 + 8 * l16) = r;
                }
            }
        }
        __syncthreads();
    }
}

__device__ __forceinline__ void cm_gate_phase(const Params& p, LAS unsigned char* lds) {
    const int tid = opaque_tid(), wid = tid >> 6, lane = tid & 63, fr = lane & 15, fq = lane >> 4;
    bf16_t* UV = (bf16_t*)(p.ws + WS_BIG);
    const float* vg = p.in[15]; const float* vb = p.in[16]; const float* bs = p.in[18];
    const bf16_t* WSB = (const bf16_t*)(p.ws + WS_WSB);
    LAS bf16_t* Wl = (LAS bf16_t*)lds; LAS bf16_t* Vl = (LAS bf16_t*)(lds + 34816); LAS float* st = (LAS float*)(lds + 34816 + 100352); LAS float* bl = st + 256;
    const int c8 = lane < 48 ? lane : 47;
    for (int ch = blockIdx.x; ch < MX / 128; ch += gridDim.x) {
        const size_t row0 = (size_t)ch * 128;
        __syncthreads();
        for (int rr = 0; rr < 8; ++rr) {
            const int r = wid * 16 + 2 * rr; const bf16_t* vp = UV + (row0 + r) * 6144 + 3072;
            u32x4 x[2][6]; float s[2] = {0.f, 0.f};
#pragma unroll
            for (int q = 0; q < 2; ++q)
#pragma unroll
                for (int i = 0; i < 6; ++i) x[q][i] = *(const u32x4*)(vp + (size_t)q * 6144 + (i * 64 + lane) * 8);
#pragma unroll
            for (int q = 0; q < 2; ++q)
#pragma unroll
                for (int i = 0; i < 6; ++i) s[q] += (bf_lo(x[q][i].x) + bf_hi(x[q][i].x)) + (bf_lo(x[q][i].y) + bf_hi(x[q][i].y)) + (bf_lo(x[q][i].z) + bf_hi(x[q][i].z)) + (bf_lo(x[q][i].w) + bf_hi(x[q][i].w));
            float mean[2], s2[2] = {0.f, 0.f};
#pragma unroll
            for (int q = 0; q < 2; ++q) mean[q] = wave_sum(s[q]) * (1.f / 3072.f);
#pragma unroll
            for (int q = 0; q < 2; ++q)
#pragma unroll
                for (int i = 0; i < 6; ++i) { float d;
                    d = bf_lo(x[q][i].x) - mean[q]; s2[q] += d * d; d = bf_hi(x[q][i].x) - mean[q]; s2[q] += d * d; d = bf_lo(x[q][i].y) - mean[q]; s2[q] += d * d; d = bf_hi(x[q][i].y) - mean[q]; s2[q] += d * d;
                    d = bf_lo(x[q][i].z) - mean[q]; s2[q] += d * d; d = bf_hi(x[q][i].z) - mean[q]; s2[q] += d * d; d = bf_lo(x[q][i].w) - mean[q]; s2[q] += d * d; d = bf_hi(x[q][i].w) - mean[q]; s2[q] += d * d; }
#pragma unroll
            for (int q = 0; q < 2; ++q) { const float rstd = __builtin_amdgcn_rsqf(wave_sum(s2[q]) * (1.f / 3072.f) + LN_EPS); if (lane == 0) { st[2 * (r + q)] = mean[q]; st[2 * (r + q) + 1] = rstd; } }
        }
        for (int g = 0; g < 8; ++g) {
            lds_barrier();
#pragma unroll
            for (int i = 0; i < 4; ++i) { const int idx = tid + NTHREADS * i, r = idx >> 4, cc = idx & 15;
                *(LAS u32x4*)(Wl + r * 136 + cc * 8) = *(const u32x4*)(WSB + (size_t)g * 16384 + r * 128 + cc * 8); }
            if (tid < 128) bl[tid] = bs[g * 128 + tid];
            {
                const float* gp = vg + g * 384 + c8 * 8; const float* bp = vb + g * 384 + c8 * 8;
                const f32x4 g0 = *(const f32x4*)gp, g1 = *(const f32x4*)(gp + 4), b0 = *(const f32x4*)bp, b1 = *(const f32x4*)(bp + 4);
                size_t xo = (row0 + wid) * 6144 + 3072 + g * 384 + c8 * 8;
#pragma unroll
                for (int hb = 0; hb < 2; ++hb) {
                    u32x4 xv[8];
#pragma unroll
                    for (int i = 0; i < 8; ++i) { xv[i] = *(const u32x4*)(UV + xo); xo += 8 * 6144; asm volatile("" : "+v"(xo)); }
#pragma unroll
                    for (int i = 0; i < 8; ++i) { const int sr = wid + 8 * (8 * hb + i);
                        const f32x2 ms = *(const LAS f32x2*)(st + 2 * sr); const float mean = ms[0], rstd = ms[1]; const u32x4 x = xv[i];
                        u32x4 o;
                        o.x = cvt_pk_bf16((bf_lo(x.x) - mean) * rstd * g0[0] + b0[0], (bf_hi(x.x) - mean) * rstd * g0[1] + b0[1]);
                        o.y = cvt_pk_bf16((bf_lo(x.y) - mean) * rstd * g0[2] + b0[2], (bf_hi(x.y) - mean) * rstd * g0[3] + b0[3]);
                        o.z = cvt_pk_bf16((bf_lo(x.z) - mean) * rstd * g1[0] + b1[0], (bf_hi(x.z) - mean) * rstd * g1[1] + b1[1]);
                        o.w = cvt_pk_bf16((bf_lo(x.w) - mean) * rstd * g1[2] + b1[2], (bf_hi(x.w) - mean) * rstd * g1[3] + b1[3]);
                        if (lane < 48) *(LAS u32x4*)(Vl + sr * 392 + c8 * 8) = o; }
                }
            }
            lds_barrier();
#pragma unroll 1
            for (int n = 0; n < 3; ++n) {
                size_t uo = (row0 + fr) * 6144 + g * 384 + wid * 48 + n * 16 + 4 * fq;
                u32x2 uu[8];
#pragma unroll
                for (int m = 0; m < 8; ++m) { uu[m] = *(const u32x2*)(UV + uo); uo += 16 * 6144; asm volatile("" : "+v"(uo)); }
                f32x4 acc[8];
#pragma unroll
                for (int m = 0; m < 8; ++m) acc[m] = (f32x4){0.f, 0.f, 0.f, 0.f};
#pragma unroll
                for (int ks = 0; ks < 4; ++ks) {
                    bf16x8 af;
                    const LAS bf16_t* vp = Vl + (32 * ks + 8 * fq) * 392 + wid * 48 + n * 16 + fr;
#pragma unroll
                    for (int i = 0; i < 8; ++i) af[i] = (short)vp[i * 392];
#pragma unroll
                    for (int m = 0; m < 8; ++m) {
                        const bf16x8 bfrag = *(const LAS bf16x8*)(Wl + (16 * m + fr) * 136 + 32 * ks + 8 * fq);
                        acc[m] = __builtin_amdgcn_mfma_f32_16x16x32_bf16(af, bfrag, acc[m], 0, 0, 0);
                    }
                }
                size_t zo = (row0 + fr) * 6144 + g * 384 + wid * 48 + n * 16 + 4 * fq;
#pragma unroll
                for (int m = 0; m < 8; ++m) {
                    const float bias = bl[16 * m + fr];
                    const u32x2 u2 = uu[m];
                    u32x2 o; o.x = cvt_pk_bf16(bf_lo(u2.x) * (acc[m][0] + bias), bf_hi(u2.x) * (acc[m][1] + bias));
                    o.y = cvt_pk_bf16(bf_lo(u2.y) * (acc[m][2] + bias), bf_hi(u2.y) * (acc[m][3] + bias));
                    *(u32x2*)(UV + zo) = o;
                    zo += 16 * 6144; asm volatile("" : "+v"(zo));
                }
            }
        }
    }
}

#ifndef EN_MASK
#define EN_MASK 255
#endif
constexpr int EN = EN_MASK;
#ifndef PROBE_KINDS
#define PROBE_KINDS 0
#endif
#ifndef PROBE_K
#define PROBE_K 4
#endif
__global__ void __launch_bounds__(NTHREADS, 2) fwd_megakernel(Params p) {
    extern __shared__ __attribute__((aligned(16))) unsigned char lds_raw[];
    LAS unsigned char* lds = (LAS unsigned char*)lds_raw;
    cg::grid_group grid = cg::this_grid();
    volatile LAS unsigned* xst = (volatile LAS unsigned*)(lds + LDS_BYTES - 16);
    if (threadIdx.x == 0) { xst[0] = 0u; xst[1] = 0u; }
    XcdBarrier xb; xb.bar = (unsigned*)(p.ws + WS_BAR); xb.x = 0; xb.st = xst;
    const float* x_in = p.in[0]; const float* ctx_in = p.in[2];
    const float* mod0 = (const float*)(p.ws + WS_MOD); const float* mod1 = mod0 + (size_t)33 * 9216;
    const float* lbv = (const float*)(p.ws + WS_LB);
    const float* ln_g = p.in[6]; const float* ln_b = p.in[7];
    bf16_t* A0 = (bf16_t*)(p.ws + WS_A0); bf16_t* BIG = (bf16_t*)(p.ws + WS_BIG);
    const bf16_t* FIN = (const bf16_t*)(p.ws + WS_FIN); const bf16_t* FOUT = (const bf16_t*)(p.ws + WS_FOUT);
    const bf16_t* HIN = (const bf16_t*)(p.ws + WS_HIN); const bf16_t* HOUT = (const bf16_t*)(p.ws + WS_HOUT);
    const bf16_t* CIN = (const bf16_t*)(p.ws + WS_CIN); const bf16_t* COUT = (const bf16_t*)(p.ws + WS_COUT);
    const size_t FIN_SZ = (size_t)5632 * 1024, FOUT_SZ = (size_t)1024 * 2816;
    long long probe_acc = 0;
    for (int ph = p.ph_lo; ph < p.ph_hi; ++ph) {
        const long long probe_t0 = PROBE_KINDS ? wall_clock64() : 0;
        int kind;
        switch (ph) {
        case 0: kind = 0; break;
        case 1: case 4: case 8: case 11: case 14: case 18: case 21: kind = 1; break;
        case 2: case 9: case 12: case 19: kind = 2; break;
        case 3: case 7: case 10: case 13: case 17: case 20: kind = 3; break;
        case 5: kind = 4; break;
        case 6: kind = 5; break;
        case 15: kind = 6; break;
        default: kind = 7; break;
        }
        if (kind == 0) { if (EN & 1) phase0(p, lds); }
        else if (kind == 1) {
            RowArgs a;
            a.xs_x = p.out; a.xs_c = nullptr; a.nrows = MX; a.y = A0; a.ysc = 0.5f; a.xd = p.out; a.hd = A0;
            if (ph == 1) { a.xs_x = x_in; a.xs_c = ctx_in; a.nrows = MT; a.y = nullptr; a.m = mod0; a.k = 0; a.g = ln_g; a.b = ln_b; a.m2 = mod0; a.k2 = 0; }
            else if (ph == 4) { a.xs_x = x_in; a.xs_c = ctx_in; a.nrows = MT; a.m = mod0; a.k = 0; a.g = ln_g + 0 * D; a.b = ln_b + 0 * D; a.m2 = mod0; a.k2 = 1; }
            else if (ph == 8) { a.y = BIG; a.ysc = 1.f; a.m = mod0; a.k = 1; a.g = ln_g + 1 * D; a.b = ln_b + 1 * D; a.m2 = mod0; a.k2 = 2; }
            else if (ph == 11) { a.m = mod0; a.k = 2; a.g = ln_g + 2 * D; a.b = ln_b + 2 * D; a.m2 = mod1; a.k2 = 0; }
            else if (ph == 14) { a.m = mod1; a.k = 0; a.g = ln_g + 3 * D; a.b = ln_b + 3 * D; a.m2 = mod1; a.k2 = 1; }
            else if (ph == 18) { a.ysc = 1.f; a.m = mod1; a.k = 1; a.g = ln_g + 4 * D; a.b = ln_b + 4 * D; a.m2 = mod1; a.k2 = 2; }
            else { a.m = mod1; a.k = 2; a.g = ln_g + 5 * D; a.b = ln_b + 5 * D; a.hd = nullptr; a.m2 = mod1; a.k2 = 0; }
            if (EN & 2) row_phase(a);
        } else if (kind == 2) {
            const int wi = ph == 2 ? 0 : (ph == 9 ? 1 : (ph == 12 ? 2 : 3));
            if (EN & 4) run_gemm<1>(lds, A0, D, FIN + wi * FIN_SZ, ph == 2 ? MT : MX, 2 * FH, D, BIG, FH, nullptr);
        } else if (kind == 3) {
            const bf16_t* A = BIG; int lda = FH, M = MX, K = FH; const bf16_t* Bt; bf16_t* O = A0;
            if (ph == 3) { Bt = FOUT; M = MT; }
            else if (ph == 7) { A = A0; lda = D; K = D; Bt = HOUT; O = BIG; }
            else if (ph == 10) Bt = FOUT + 1 * FOUT_SZ;
            else if (ph == 13) Bt = FOUT + 2 * FOUT_SZ;
            else if (ph == 17) { lda = 2 * CMI; K = CMI; Bt = COUT; }
            else Bt = FOUT + 3 * FOUT_SZ;
            if (EN & 8) run_gemm<0>(lds, A, lda, Bt, M, D, K, O, D, nullptr);
        } else if (kind == 4) { if (EN & 16) run_gemm<2>(lds, A0, D, HIN, MT, HG5, D, BIG, HG5, lbv); }
        else if (kind == 5) { if (EN & 32) gla_phase(p, lds); }
        else if (kind == 6) { if (EN & 64) run_gemm<3>(lds, A0, D, CIN, MX, 2 * CMI, D, BIG, 2 * CMI, nullptr); }
        else { if (EN & 128) cm_gate_phase(p, lds); }
        if (ph + 1 < p.ph_hi) {
            if (ph == 0) { grid.sync(); xb = xcd_barrier_post((unsigned*)(p.ws + WS_BAR), xst); }
            else xcd_barrier(xb);
        }
        if (PROBE_KINDS && ((PROBE_KINDS >> kind) & 1)) probe_acc += wall_clock64() - probe_t0;
    }
    if (PROBE_KINDS && blockIdx.x == 0 && threadIdx.x == 0) { const long long te = wall_clock64(); while (wall_clock64() - te < PROBE_K * probe_acc) __builtin_amdgcn_s_sleep(8); }
}

extern "C" void kernel_launch(void* const* d_in, const int* in_sizes, int n_in, void* d_out, int out_size, void* d_ws, size_t ws_size, hipStream_t stream) {
    static int grid_blocks = 0;
    if (grid_blocks == 0) {
        if (n_in != 20 || out_size != MX * D || ws_size < WS_END) { fprintf(stderr, "kernel_launch: unexpected shapes (n_in %d out %d ws %zu need %zu)\n", n_in, out_size, ws_size, (size_t)WS_END); grid_blocks = -1; return; }
        int dev = 0, cus = 0, per_cu = 0;
        hipGetDevice(&dev);
        hipDeviceGetAttribute(&cus, hipDeviceAttributeMultiprocessorCount, dev);
        if (hipFuncSetAttribute((const void*)fwd_megakernel, hipFuncAttributeMaxDynamicSharedMemorySize, LDS_BYTES) != hipSuccess) { fprintf(stderr, "kernel_launch: hipFuncSetAttribute failed\n"); grid_blocks = -1; return; }
        if (hipOccupancyMaxActiveBlocksPerMultiprocessor(&per_cu, (const void*)fwd_megakernel, NTHREADS, LDS_BYTES) != hipSuccess || per_cu < 1) { fprintf(stderr, "kernel_launch: occupancy query says %d\n", per_cu); per_cu = 1; }
        (void)hipGetLastError();
        grid_blocks = cus * 1;
    }
    if (grid_blocks < 0) return;
    Params p{};
    for (int i = 0; i < 20; ++i) p.in[i] = (const float*)d_in[i];
    p.out = (float*)d_out; p.ws = (unsigned char*)d_ws; p.ph_lo = 0; p.ph_hi = 22;
    void* args[] = {&p};
    hipError_t e = hipLaunchCooperativeKernel((const void*)fwd_megakernel, dim3(grid_blocks), dim3(NTHREADS), args, LDS_BYTES, stream);
    if (e != hipSuccess) fprintf(stderr, "cooperative launch failed: %s (grid %d)\n", hipGetErrorString(e), grid_blocks);
}
```

```cpp
#include <hip/hip_runtime.h>
#include <hip/hip_cooperative_groups.h>
#include <cstdio>
#include <cstdint>
namespace cg = cooperative_groups;

#define LAS __attribute__((address_space(3)))
typedef unsigned short bf16_t;
typedef short bf16x8 __attribute__((ext_vector_type(8)));
typedef float f32x4 __attribute__((ext_vector_type(4)));
typedef float f32x2 __attribute__((ext_vector_type(2)));
typedef unsigned u32x4 __attribute__((ext_vector_type(4)));
typedef unsigned u32x2 __attribute__((ext_vector_type(2)));

constexpr int D = 1024, NB = 32, SEQ = 2048, CTXL = 256;
constexpr int MX = NB * SEQ;
constexpr int MC = NB * CTXL;
constexpr int MT = MX + MC;
constexpr int FH = 2816, HG5 = 5 * D, CMI = 3072, NMOD = 9;
constexpr float DN_ALPHA = 1.41421356237309515f;
constexpr float LN_EPS = 1e-5f, RMS_EPS = 1e-6f;
constexpr int LDS_BYTES = 149504;
constexpr int NTHREADS = 512;

constexpr size_t WS_MOD = 0;
constexpr size_t WS_LB = WS_MOD + (size_t)2 * 33 * 9216 * 4;
constexpr size_t WS_BAR = WS_LB + 2 * 1024 * 4;
constexpr size_t WS_FIN = WS_BAR + 4096 * 4;
constexpr size_t WS_FOUT = WS_FIN + (size_t)4 * 5632 * 1024 * 2;
constexpr size_t WS_HIN = WS_FOUT + (size_t)4 * 1024 * 2816 * 2;
constexpr size_t WS_HOUT = WS_HIN + (size_t)5120 * 1024 * 2;
constexpr size_t WS_CIN = WS_HOUT + (size_t)1024 * 1024 * 2;
constexpr size_t WS_COUT = WS_CIN + (size_t)6144 * 1024 * 2;
constexpr size_t WS_WSB = WS_COUT + (size_t)1024 * 3072 * 2;
constexpr size_t WS_A0 = WS_WSB + (size_t)8 * 128 * 128 * 2;
constexpr size_t WS_BIG = WS_A0 + (size_t)MT * 1024 * 2;
constexpr size_t WS_END = WS_BIG + (size_t)MX * 6144 * 2;

struct Params {
    const float* in[20];
    float* out;
    unsigned char* ws;
    int ph_lo, ph_hi;
};

__device__ __forceinline__ unsigned cvt_pk_bf16(float lo, float hi) { unsigned r; asm volatile("v_cvt_pk_bf16_f32 %0, %1, %2" : "=v"(r) : "v"(lo), "v"(hi)); return r; }
__device__ __forceinline__ int opaque_tid() { int t = threadIdx.x; asm volatile("" : "+v"(t)); return t; }
__device__ __forceinline__ void lds_barrier() { asm volatile("s_waitcnt lgkmcnt(0)" ::: "memory"); __builtin_amdgcn_s_barrier(); asm volatile("" ::: "memory"); }
__device__ __forceinline__ float bf_lo(unsigned u) { return __uint_as_float(u << 16); }
__device__ __forceinline__ float bf_hi(unsigned u) { return __uint_as_float(u & 0xffff0000u); }
__device__ __forceinline__ float wave_sum(float v) {
#pragma unroll
    for (int o = 1; o < 64; o <<= 1) v += __shfl_xor(v, o);
    return v;
}
__device__ __forceinline__ float sigmoid_f(float x) { return __builtin_amdgcn_rcpf(1.f + __expf(-x)); }
__device__ __forceinline__ float silu_f(float x) { return x * sigmoid_f(x); }
__device__ __forceinline__ float gelu_tanh_f(float x) { const float u = 0.7978845608028654f * (x + 0.044715f * x * x * x); return x * sigmoid_f(2.f * u); }

namespace pg8 {
constexpr int BM = 256, BK = 64, HALF = 128, HTB = HALF * BK * 2, STAGE_BYTES = 8 * HTB, NXCD = 8, WGM = 8;
__host__ __device__ __forceinline__ int lds_byte(int r, int c) { const int st = (r >> 4) * 2 + (c >> 5), rr = r & 15, cc = c & 31, ob = rr * 64 + cc * 2; return st * 1024 + (ob ^ (((ob >> 9) & 1) << 5)); }
__host__ __device__ __forceinline__ void stage_rc(int b, int& R, int& C) { const int st = b / 1024, sb = b % 1024, swz = sb ^ (((sb >> 9) & 1) << 5); R = (st >> 1) * 16 + swz / 64; C = (st & 1) * 32 + (swz % 64) / 2; }
__host__ __device__ __forceinline__ int perm32(int rho) { const int n = rho >> 4, i = rho & 15; return 8 * (i >> 2) + 4 * n + (i & 3); }

struct Unit { int pm, pn; };
struct Gemm { const bf16_t* A; int lda; const bf16_t* Bt; int M, N, K; };

struct StaticOrder {
    int nM, nN, nwg, G, c;
    __device__ void init(int M, int N, int G_, int c_) { nM = M / BM; nN = N / BM; nwg = nM * nN; G = G_; c = c_; }
    __device__ bool next(int i, Unit& u) const {
        const long L = (long)i * G + c; if (L >= nwg) return false;
        int wgid = (int)L; { const int q = nwg / NXCD, r = nwg % NXCD, xcd = wgid % NXCD, off = wgid / NXCD; wgid = (xcd < r ? xcd * (q + 1) : r * (q + 1) + (xcd - r) * q) + off; }
        const int nig = WGM * nN, gid = wgid / nig, fm = gid * WGM, gsz = (nM - fm) < WGM ? (nM - fm) : WGM;
        u.pm = fm + ((wgid % nig) % gsz); u.pn = (wgid % nig) / gsz; return true;
    }
};

template <int MODE> struct Epi {
    bf16_t* O; int ldo; const float* lb;
    __device__ __forceinline__ void operator()(const f32x4 (&acc)[2][2][4][2], const Unit& u, int wr, int wc, int fr, int fq) const {
        const int row0 = u.pm * BM + wr * 64 + fr;
        if constexpr (MODE == 1) {
            const int col0 = u.pn * 128 + wc * 32 + 8 * fq;
#pragma unroll
            for (int ai = 0; ai < 2; ++ai)
#pragma unroll
                for (int m = 0; m < 4; ++m) {
                    const f32x4 g0 = acc[ai][0][m][0], g1 = acc[ai][0][m][1], u0 = acc[ai][1][m][0], u1 = acc[ai][1][m][1];
                    u32x4 o;
                    o.x = cvt_pk_bf16(silu_f(g0[0]) * u0[0], silu_f(g0[1]) * u0[1]);
                    o.y = cvt_pk_bf16(silu_f(g0[2]) * u0[2], silu_f(g0[3]) * u0[3]);
                    o.z = cvt_pk_bf16(silu_f(g1[0]) * u1[0], silu_f(g1[1]) * u1[1]);
                    o.w = cvt_pk_bf16(silu_f(g1[2]) * u1[2], silu_f(g1[3]) * u1[3]);
                    *(u32x4*)(O + (size_t)(row0 + ai * HALF + m * 16) * ldo + col0) = o;
                    __builtin_amdgcn_sched_barrier(0);
                }
        } else {
            const int seg = u.pn >> 2;
#pragma unroll
            for (int bj = 0; bj < 2; ++bj) {
                const int col0 = u.pn * BM + bj * HALF + wc * 32 + 8 * fq;
                f32x4 l0 = {0.f, 0.f, 0.f, 0.f}, l1 = {0.f, 0.f, 0.f, 0.f};
                if (MODE == 2 && (seg == 2 || seg == 3)) { const float* lp = lb + (seg - 2) * 1024 + (col0 & 1023); l0 = *(const f32x4*)lp; l1 = *(const f32x4*)(lp + 4); }
#pragma unroll
                for (int ai = 0; ai < 2; ++ai)
#pragma unroll
                    for (int m = 0; m < 4; ++m) {
                        f32x4 v0 = acc[ai][bj][m][0], v1 = acc[ai][bj][m][1];
                        if constexpr (MODE == 3) {
#pragma unroll
                            for (int i = 0; i < 4; ++i) { v0[i] = gelu_tanh_f(v0[i]); v1[i] = gelu_tanh_f(v1[i]); }
                        }
                        if constexpr (MODE == 2) {
                            if (seg == 0 || seg == 4) {
#pragma unroll
                                for (int i = 0; i < 4; ++i) { v0[i] = silu_f(v0[i]); v1[i] = silu_f(v1[i]); }
                            } else if (seg >= 2) {
#pragma unroll
                                for (int i = 0; i < 4; ++i) {
                                    v0[i] = __logf(l0[i] + (1.f - l0[i]) * sigmoid_f(v0[i]));
                                    v1[i] = __logf(l1[i] + (1.f - l1[i]) * sigmoid_f(v1[i]));
                                }
                            }
                        }
                        u32x4 o;
                        o.x = cvt_pk_bf16(v0[0], v0[1]); o.y = cvt_pk_bf16(v0[2], v0[3]); o.z = cvt_pk_bf16(v1[0], v1[1]); o.w = cvt_pk_bf16(v1[2], v1[3]);
                        *(u32x4*)(O + (size_t)(row0 + ai * HALF + m * 16) * ldo + col0) = o;
                        __builtin_amdgcn_sched_barrier(0);
                    }
            }
        }
    }
};

template <class EpiT>
__device__ __forceinline__ void gemm_phase(LAS unsigned char* lds, const Gemm g, const StaticOrder& S, const EpiT& E) {
    const int tid = opaque_tid(), wid = __builtin_amdgcn_readfirstlane(tid >> 6), lane = tid & 63, wr = wid >> 2, wc = wid & 3, fr = lane & 15, fq = lane >> 4;
    const int K = g.K, nt = K / BK, lda = g.lda;
    unsigned voffA[2], voffB[2];
#pragma unroll
    for (int i = 0; i < 2; ++i) { int R, C; stage_rc(tid * 16 + i * 8192, R, C); const int Rb = (R & ~31) + perm32(R & 31);
        voffA[i] = (unsigned)(R * lda + C) * 2u; voffB[i] = (unsigned)(Rb * K + C) * 2u; }
    const size_t kstep = (size_t)(BK * 2);
    const size_t hstepA = (size_t)HALF * lda * 2, hstepB = (size_t)HALF * K * 2;
    const size_t tstepA = 2 * hstepA, tstepB = 2 * hstepB;
    const unsigned ldsw = (unsigned)wid * 1024u;
    const int aoff = lds_byte(wr * 64 + fr, fq * 8), boff = lds_byte(wc * 32 + fr, fq * 8);
#define PG8_SA(b, h) (((b) * 2 + (h)) * HTB)
#define PG8_SB(b, h) ((4 + (b) * 2 + (h)) * HTB)
#define PG8_STAGE(bufoff, gbase, voff) do { _Pragma("unroll") for (int _i = 0; _i < 2; ++_i) \
        __builtin_amdgcn_global_load_lds((const unsigned*)((const char*)(gbase) + (voff)[_i]), (LAS unsigned*)(lds + (bufoff) + ldsw + _i * 8192), 16, 0, 0); } while (0)
#define PG8_LDA(dst, b, h) do { _Pragma("unroll") for (int m = 0; m < 4; ++m) _Pragma("unroll") for (int k = 0; k < 2; ++k) dst[m][k] = *(const LAS bf16x8*)(lds + PG8_SA(b, h) + aoff + m * 2048 + k * 1024); } while (0)
#define PG8_LDB(dst, b, h) do { _Pragma("unroll") for (int n = 0; n < 2; ++n) _Pragma("unroll") for (int k = 0; k < 2; ++k) dst[n][k] = *(const LAS bf16x8*)(lds + PG8_SB(b, h) + boff + n * 2048 + k * 1024); } while (0)
#define PG8_MMA(ai, bj, At, Bt) do { __builtin_amdgcn_s_setprio(1); _Pragma("unroll") for (int m = 0; m < 4; ++m) _Pragma("unroll") for (int n = 0; n < 2; ++n) _Pragma("unroll") for (int k = 0; k < 2; ++k) \
        acc[ai][bj][m][n] = __builtin_amdgcn_mfma_f32_16x16x32_bf16(Bt[n][k], At[m][k], acc[ai][bj][m][n], 0, 0, 0); __builtin_amdgcn_s_setprio(0); } while (0)
#define PG8_WAIT_V(n) asm volatile("s_waitcnt vmcnt(" #n ")" ::: "memory")
#define PG8_WAIT_L(n) asm volatile("s_waitcnt lgkmcnt(" #n ")" ::: "memory")
#define PG8_BAR __builtin_amdgcn_s_barrier()
#define PG8_SCHED __builtin_amdgcn_sched_barrier(0)
    Unit cur, nxt; int ui = 0;
    if (!S.next(0, cur)) return;
    f32x4 acc[2][2][4][2];
#pragma unroll
    for (int a = 0; a < 2; ++a)
#pragma unroll
        for (int b = 0; b < 2; ++b)
#pragma unroll
            for (int m = 0; m < 4; ++m)
#pragma unroll
                for (int n = 0; n < 2; ++n) acc[a][b][m][n] = (f32x4){0.f, 0.f, 0.f, 0.f};
    bf16x8 At[4][2], B0[2][2], B1[2][2];
    const char* cA = (const char*)g.A + (size_t)cur.pm * tstepA; const char* cB = (const char*)g.Bt + (size_t)cur.pn * tstepB;
    PG8_STAGE(PG8_SB(0, 0), cB, voffB); PG8_STAGE(PG8_SB(0, 1), cB + hstepB, voffB); PG8_STAGE(PG8_SA(0, 0), cA, voffA); PG8_STAGE(PG8_SA(0, 1), cA + hstepA, voffA);
    if (wr == 1) PG8_BAR;
    PG8_WAIT_V(2); PG8_BAR;
    PG8_STAGE(PG8_SB(1, 0), cB + kstep, voffB); PG8_STAGE(PG8_SA(1, 0), cA + kstep, voffA); PG8_STAGE(PG8_SB(1, 1), cB + hstepB + kstep, voffB);
    PG8_WAIT_V(6); PG8_BAR;
    for (;;) {
        const bool has_next = S.next(ui + 1, nxt);
        const char* nA = has_next ? (const char*)g.A + (size_t)nxt.pm * tstepA : cA; const char* nB = has_next ? (const char*)g.Bt + (size_t)nxt.pn * tstepB : cB;
        for (int t = 0; t < nt; t += 2) {
            const bool last = (t == nt - 2);
            const char* a1 = cA + (size_t)(t + 1) * kstep;
            const char* a2 = last ? nA : cA + (size_t)(t + 2) * kstep; const char* b2 = last ? nB : cB + (size_t)(t + 2) * kstep;
            const char* a3 = a2 + kstep; const char* b3 = b2 + kstep;
            PG8_LDB(B0, 0, 0); PG8_LDB(B1, 0, 1); PG8_SCHED; PG8_LDA(At, 0, 0); PG8_STAGE(PG8_SA(1, 1), a1 + hstepA, voffA);
            PG8_WAIT_V(8); PG8_WAIT_L(0); PG8_BAR; PG8_MMA(0, 0, At, B0); PG8_MMA(0, 1, At, B1); PG8_BAR; PG8_SCHED;
            PG8_LDA(At, 0, 1); PG8_STAGE(PG8_SB(0, 0), b2, voffB); PG8_STAGE(PG8_SB(0, 1), b2 + hstepB, voffB); PG8_STAGE(PG8_SA(0, 0), a2, voffA);
            PG8_WAIT_V(8); PG8_WAIT_L(0); PG8_BAR; PG8_MMA(1, 0, At, B0); PG8_MMA(1, 1, At, B1); PG8_BAR; PG8_SCHED;
            PG8_LDB(B0, 1, 0); PG8_LDB(B1, 1, 1); PG8_SCHED; PG8_LDA(At, 1, 0); PG8_STAGE(PG8_SA(0, 1), a2 + hstepA, voffA);
            PG8_WAIT_V(8); PG8_WAIT_L(0); PG8_BAR; PG8_MMA(0, 0, At, B0); PG8_MMA(0, 1, At, B1); PG8_BAR; PG8_SCHED;
            PG8_LDA(At, 1, 1); PG8_STAGE(PG8_SB(1, 0), b3, voffB); PG8_STAGE(PG8_SB(1, 1), b3 + hstepB, voffB); PG8_STAGE(PG8_SA(1, 0), a3, voffA);
            PG8_WAIT_V(8); PG8_WAIT_L(0); PG8_BAR; PG8_MMA(1, 0, At, B0); PG8_MMA(1, 1, At, B1); PG8_BAR; PG8_SCHED;
        }
        if (wr == 0) PG8_BAR;
        E(acc, cur, wr, wc, fr, fq);
        if (!has_next) break;
#pragma unroll
        for (int a = 0; a < 2; ++a)
#pragma unroll
            for (int b = 0; b < 2; ++b)
#pragma unroll
                for (int m = 0; m < 4; ++m)
#pragma unroll
                    for (int n = 0; n < 2; ++n) acc[a][b][m][n] = (f32x4){0.f, 0.f, 0.f, 0.f};
        cur = nxt; cA = nA; cB = nB; ++ui;
        if (wr == 1) PG8_BAR;
    }
    PG8_WAIT_V(0);
    PG8_BAR;
#undef PG8_SA
#undef PG8_SB
#undef PG8_STAGE
#undef PG8_LDA
#undef PG8_LDB
#undef PG8_MMA
#undef PG8_WAIT_V
#undef PG8_WAIT_L
#undef PG8_BAR
#undef PG8_SCHED
}
}

template <int MODE>
__device__ __forceinline__ void run_gemm(LAS unsigned char* lds, const bf16_t* A, int lda, const bf16_t* Bt, int M, int N, int K, bf16_t* O, int ldo, const float* lb) {
    pg8::Gemm g{A, lda, Bt, M, N, K};
    pg8::StaticOrder S; S.init(M, N, gridDim.x, blockIdx.x);
    pg8::Epi<MODE> E{O, ldo, lb};
    pg8::gemm_phase(lds, g, S, E);
}

#define XB_TMO      128
#define XB_XCNT(j)  (256  + 64 * (j))
#define XB_XSUB(j)  (1280 + 64 * (j))
#define XB_XGEN(j)  (2304 + 64 * (j))
#define XB_TOP      3328
#define XB_TOPGEN   3392
#define XCD_BAR_WORDS 3456
#define XB_SPIN_CAP (1u << 22)
__device__ __forceinline__ unsigned xb_ld(unsigned* p)              { return __hip_atomic_load(p, __ATOMIC_RELAXED, __HIP_MEMORY_SCOPE_AGENT); }
__device__ __forceinline__ unsigned xb_add(unsigned* p, unsigned v) { return __hip_atomic_fetch_add(p, v, __ATOMIC_RELAXED, __HIP_MEMORY_SCOPE_AGENT); }
__device__ __forceinline__ unsigned xb_xcc_id() { return (unsigned)__builtin_amdgcn_s_getreg((3 << 11) | 20) & 0xFu; }
#define XB_SPIN(cond, bar) do { unsigned _sp = 0; while (cond) { __builtin_amdgcn_s_sleep(1); \
    if ((++_sp & 255u) == 0u) { if (xb_ld(&(bar)[XB_TMO])) break; if (_sp > XB_SPIN_CAP) { atomicAdd(&(bar)[XB_TMO], 1u); break; } } } } while (0)
struct XcdBarrier { unsigned* bar; unsigned x; volatile LAS unsigned* st; };
__device__ __forceinline__ XcdBarrier xcd_barrier_post(unsigned* bar, volatile LAS unsigned* st) {
    XcdBarrier b; b.bar = bar; b.x = xb_xcc_id(); b.st = st;
    if (threadIdx.x == 0) (void)xb_add(&bar[XB_XCNT(b.x)], 1u);
    return b;
}
__device__ __forceinline__ void xcd_barrier_complete(unsigned* bar, unsigned x, unsigned& nloc, unsigned& nx) {
    const unsigned G = gridDim.x * gridDim.y * gridDim.z;
    unsigned sum, cnt, mine, sp = 0u;
    for (;;) {
        sum = 0u; cnt = 0u; mine = 0u;
#pragma unroll
        for (unsigned j = 0; j < 16; ++j) { const unsigned c = xb_ld(&bar[XB_XCNT(j)]); sum += c; cnt += (c > 0u) ? 1u : 0u; mine = (j == x) ? c : mine; }
        if (sum == G) break;
        __builtin_amdgcn_s_sleep(1);
        if ((++sp & 255u) == 0u) { if (xb_ld(&bar[XB_TMO])) break; if (sp > XB_SPIN_CAP) { atomicAdd(&bar[XB_TMO], 1u); break; } }
    }
    nloc = mine > 0u ? mine : 1u; nx = cnt > 0u ? cnt : 1u;
}
__device__ __forceinline__ void xcd_barrier(const XcdBarrier& b) {
    asm volatile("s_waitcnt vmcnt(0)" ::: "memory");
    __syncthreads();
    if (threadIdx.x == 0) {
        unsigned* bar = b.bar;
        __builtin_amdgcn_s_waitcnt(0);
        unsigned nloc = b.st[0], nx = b.st[1];
        if (nloc == 0u) { xcd_barrier_complete(bar, b.x, nloc, nx); b.st[0] = nloc; b.st[1] = nx; }
        const unsigned old = xb_add(&bar[XB_XSUB(b.x)], 1u);
        const unsigned gen = old / nloc;
        if (old + 1u == (gen + 1u) * nloc) {
            __builtin_amdgcn_fence(__ATOMIC_RELEASE, "agent");
            asm volatile("s_waitcnt vmcnt(0)" ::: "memory");
            const unsigned og = xb_add(&bar[XB_TOP], 1u);
            const unsigned tg = og / nx;
            if (og + 1u == (tg + 1u) * nx) xb_add(&bar[XB_TOPGEN], 1u);
            else XB_SPIN(xb_ld(&bar[XB_TOPGEN]) == tg, bar);
            __builtin_amdgcn_fence(__ATOMIC_ACQUIRE, "agent");
            xb_add(&bar[XB_XGEN(b.x)], 1u);
            asm volatile("s_waitcnt vmcnt(0)" ::: "memory");
        } else {
            XB_SPIN(xb_ld(&bar[XB_XGEN(b.x)]) == gen, bar);
            __builtin_amdgcn_fence(__ATOMIC_ACQUIRE, "agent");
            asm volatile("s_waitcnt vmcnt(0)" ::: "memory");
        }
    }
    __syncthreads();
}


__device__ __forceinline__ void p0_mod_item(const Params& p, LAS unsigned char* lds, int item) {
    const int tid = opaque_tid();
    const int layer = item / 72, cgp = item % 72, col0 = cgp * 128;
    const float* c = p.in[1]; const float* cctx = p.in[3];
    const float* W = p.in[4] + (size_t)layer * 1024 * 9216; const float* bias = p.in[5] + (size_t)layer * 9216;
    float* mout = (float*)(p.ws + WS_MOD) + (size_t)layer * 33 * 9216;
    LAS float* S = (LAS float*)lds;
    __syncthreads();
    for (int i = tid; i < 33 * 1024; i += NTHREADS) { const int r = i >> 10, k = i & 1023; const float v = r < 32 ? c[r * 1024 + k] : cctx[k]; S[i] = silu_f(v); }
    __syncthreads();
    const int col = tid & 63, ks = tid >> 6;
    float acc0[33], acc1[33];
#pragma unroll
    for (int r = 0; r < 33; ++r) { acc0[r] = 0.f; acc1[r] = 0.f; }
    const float* wp = W + (size_t)(ks * 128) * 9216 + col0 + col;
    float wa[4], wb[4], na[4], nb[4];
#pragma unroll
    for (int j = 0; j < 4; ++j) { wa[j] = wp[(size_t)j * 9216]; wb[j] = wp[(size_t)j * 9216 + 64]; }
    for (int k4 = 0; k4 < 32; ++k4) {
        const int k = ks * 128 + k4 * 4;
        if (k4 + 1 < 32) {
#pragma unroll
            for (int j = 0; j < 4; ++j) { na[j] = wp[(size_t)(4 * (k4 + 1) + j) * 9216]; nb[j] = wp[(size_t)(4 * (k4 + 1) + j) * 9216 + 64]; }
        }
#pragma unroll
        for (int r = 0; r < 33; ++r) { const f32x4 s4 = *(const LAS f32x4*)(S + r * 1024 + k);
            acc0[r] += wa[0] * s4[0] + wa[1] * s4[1] + wa[2] * s4[2] + wa[3] * s4[3];
            acc1[r] += wb[0] * s4[0] + wb[1] * s4[1] + wb[2] * s4[2] + wb[3] * s4[3]; }
#pragma unroll
        for (int j = 0; j < 4; ++j) { wa[j] = na[j]; wb[j] = nb[j]; }
    }
    __syncthreads();
    LAS float* red = (LAS float*)lds;
#pragma unroll
    for (int r = 0; r < 33; ++r) { red[(ks * 33 + r) * 128 + col] = acc0[r]; red[(ks * 33 + r) * 128 + 64 + col] = acc1[r]; }
    __syncthreads();
    for (int i = tid; i < 33 * 128; i += NTHREADS) {
        const int r = i >> 7, cc = i & 127; float s = 0.f;
#pragma unroll
        for (int q = 0; q < 8; ++q) s += red[(q * 33 + r) * 128 + cc];
        mout[(size_t)r * 9216 + col0 + cc] = s + bias[col0 + cc];
    }
    __syncthreads();
}

__device__ __forceinline__ void p0_transpose_item(const float* W, int K, int N, bf16_t* WT, int k0, int n0, int drow0, LAS float* scr, int lane) {
    const int n4 = lane & 15, kr = lane >> 4;
    f32x4 v[16];
#pragma unroll
    for (int i = 0; i < 16; ++i) v[i] = *(const f32x4*)(W + (size_t)(k0 + 4 * i + kr) * N + n0 + 4 * n4);
#pragma unroll
    for (int i = 0; i < 16; ++i) { LAS float* d = scr + (4 * i + kr) * 65 + 4 * n4; d[0] = v[i][0]; d[1] = v[i][1]; d[2] = v[i][2]; d[3] = v[i][3]; }
    asm volatile("s_waitcnt lgkmcnt(0)" ::: "memory");
    const int c = lane & 7;
#pragma unroll
    for (int j = 0; j < 8; ++j) { const int n = (lane >> 3) + 8 * j; const LAS float* s = scr + (8 * c) * 65 + n;
        u32x4 o; o.x = cvt_pk_bf16(s[0 * 65], s[1 * 65]); o.y = cvt_pk_bf16(s[2 * 65], s[3 * 65]); o.z = cvt_pk_bf16(s[4 * 65], s[5 * 65]); o.w = cvt_pk_bf16(s[6 * 65], s[7 * 65]);
        *(u32x4*)(WT + (size_t)(drow0 + n) * K + k0 + 8 * c) = o; }
    asm volatile("s_waitcnt lgkmcnt(0)" ::: "memory");
}

__device__ __forceinline__ void phase0(const Params& p, LAS unsigned char* lds) {
    const int tid = opaque_tid(), wid = tid >> 6, lane = tid & 63;
    if (blockIdx.x == 0) { unsigned* bar = (unsigned*)(p.ws + WS_BAR); for (int i = tid; i < 4096; i += NTHREADS) bar[i] = 0u; }
    if (blockIdx.x == gridDim.x - 1) {
        const float* lbp = p.in[11]; float* lbo = (float*)(p.ws + WS_LB);
        for (int i = tid; i < 2048; i += NTHREADS) { const int dir = i >> 10, col = i & 1023;
            const float l0 = lbp[(dir * 3 + 0) * 1024 + col], l1 = lbp[(dir * 3 + 1) * 1024 + col], l2 = lbp[(dir * 3 + 2) * 1024 + col];
            const float mx = fmaxf(l0, fmaxf(l1, l2)); const float e0 = __expf(l0 - mx), e1 = __expf(l1 - mx), e2 = __expf(l2 - mx);
            lbo[i] = e0 / (e0 + e1 + e2); }
    }
    if (blockIdx.x == gridDim.x - 2) {
        const float* wsp = p.in[17]; bf16_t* wsb = (bf16_t*)(p.ws + WS_WSB);
        for (int i = tid; i < 8 * 128 * 128 / 4; i += NTHREADS) { const f32x4 w = *(const f32x4*)(wsp + 4 * i); u32x2 o; o.x = cvt_pk_bf16(w[0], w[1]); o.y = cvt_pk_bf16(w[2], w[3]); *(u32x2*)(wsb + 4 * i) = o; }
    }
    for (int it = blockIdx.x; it < 144; it += gridDim.x) p0_mod_item(p, lds, it);
    __syncthreads();
    LAS float* scr = (LAS float*)lds + wid * (64 * 65);
    const int gw = blockIdx.x * 8 + wid, nw = gridDim.x * 8;
    for (int git = gw; git < 12288; git += nw) {
        int it = git, mi = 0;
        for (; mi < 12; ++mi) { const int cnt = mi < 4 ? 1408 : (mi < 8 ? 704 : (mi == 8 ? 1280 : (mi == 9 ? 256 : (mi == 10 ? 1536 : 768)))); if (it < cnt) break; it -= cnt; }
        const float* W; bf16_t* WT; int K, N, mode = 0;
        if (mi < 4) { W = p.in[8] + (size_t)mi * 1024 * 5632; WT = (bf16_t*)(p.ws + WS_FIN) + (size_t)mi * 5632 * 1024; K = 1024; N = 5632; mode = 1; }
        else if (mi < 8) { W = p.in[9] + (size_t)(mi - 4) * 2816 * 1024; WT = (bf16_t*)(p.ws + WS_FOUT) + (size_t)(mi - 4) * 1024 * 2816; K = 2816; N = 1024; }
        else if (mi == 8) { W = p.in[10]; WT = (bf16_t*)(p.ws + WS_HIN); K = 1024; N = 5120; }
        else if (mi == 9) { W = p.in[13]; WT = (bf16_t*)(p.ws + WS_HOUT); K = 1024; N = 1024; }
        else if (mi == 10) { W = p.in[14]; WT = (bf16_t*)(p.ws + WS_CIN); K = 1024; N = 6144; }
        else { W = p.in[19]; WT = (bf16_t*)(p.ws + WS_COUT); K = 3072; N = 1024; }
        const int nblk = N / 64;
        const int kb = it / nblk, nb = it % nblk, n0 = nb * 64;
        int drow0 = n0;
        if (mode == 1) { const int j = n0 < FH ? n0 : n0 - FH; drow0 = 256 * (j >> 7) + (n0 < FH ? 0 : 128) + (j & 127); }
        p0_transpose_item(W, K, N, WT, kb * 64, n0, drow0, scr, lane);
    }
}

struct RowArgs {
    const float* xs_x; const float* xs_c; int nrows;
    const bf16_t* y; float ysc; const float* m; int k; const float* g; const float* b;
    float* xd; bf16_t* hd; const float* m2; int k2;
};
__device__ __forceinline__ void row_phase(const RowArgs& a) {
    const int tid0 = opaque_tid(); const int wid = tid0 >> 6, lane = tid0 & 63;
    constexpr int NR = 4;
    for (int rowb = blockIdx.x * (8 * NR) + wid; rowb < a.nrows; rowb += gridDim.x * (8 * NR)) {
        const int mrow = rowb < MX ? (rowb >> 11) : 32;
        f32x4 v[NR][4];
#pragma unroll
        for (int q = 0; q < NR; ++q) {
            const int row = rowb + 8 * q;
            const float* xr = row < MX ? a.xs_x + (size_t)row * D : a.xs_c + (size_t)(row - MX) * D;
#pragma unroll
            for (int j = 0; j < 4; ++j) v[q][j] = *(const f32x4*)(xr + j * 256 + lane * 4);
        }
        if (a.y) {
            u32x2 yy[NR][4]; f32x4 gt[4];
            const float* gp = a.m + (size_t)mrow * 9216 + (3 * a.k + 2) * 1024;
#pragma unroll
            for (int q = 0; q < NR; ++q) {
                const int row = rowb + 8 * q;
#pragma unroll
                for (int j = 0; j < 4; ++j) yy[q][j] = *(const u32x2*)(a.y + (size_t)row * D + j * 256 + lane * 4);
            }
#pragma unroll
            for (int j = 0; j < 4; ++j) gt[j] = *(const f32x4*)(gp + j * 256 + lane * 4) * a.ysc;
            float s[NR];
#pragma unroll
            for (int q = 0; q < NR; ++q) {
                s[q] = 0.f;
#pragma unroll
                for (int j = 0; j < 4; ++j) {
                    v[q][j][0] = DN_ALPHA * v[q][j][0] + gt[j][0] * bf_lo(yy[q][j].x); v[q][j][1] = DN_ALPHA * v[q][j][1] + gt[j][1] * bf_hi(yy[q][j].x);
                    v[q][j][2] = DN_ALPHA * v[q][j][2] + gt[j][2] * bf_lo(yy[q][j].y); v[q][j][3] = DN_ALPHA * v[q][j][3] + gt[j][3] * bf_hi(yy[q][j].y);
                    s[q] += (v[q][j][0] + v[q][j][1]) + (v[q][j][2] + v[q][j][3]);
                }
            }
            float mean[NR], s2[NR];
#pragma unroll
            for (int q = 0; q < NR; ++q) mean[q] = wave_sum(s[q]) * (1.f / D);
#pragma unroll
            for (int q = 0; q < NR; ++q) {
                s2[q] = 0.f;
#pragma unroll
                for (int j = 0; j < 4; ++j) { v[q][j] = v[q][j] - mean[q]; s2[q] += (v[q][j][0] * v[q][j][0] + v[q][j][1] * v[q][j][1]) + (v[q][j][2] * v[q][j][2] + v[q][j][3] * v[q][j][3]); }
            }
            f32x4 gg[4], bb[4];
#pragma unroll
            for (int j = 0; j < 4; ++j) { gg[j] = *(const f32x4*)(a.g + j * 256 + lane * 4); bb[j] = *(const f32x4*)(a.b + j * 256 + lane * 4); }
#pragma unroll
            for (int q = 0; q < NR; ++q) {
                const int row = rowb + 8 * q;
                const float rstd = __builtin_amdgcn_rsqf(wave_sum(s2[q]) * (1.f / D) + LN_EPS);
#pragma unroll
                for (int j = 0; j < 4; ++j) v[q][j] = v[q][j] * rstd * gg[j] + bb[j];
                if (a.xd && row < MX) {
#pragma unroll
                    for (int j = 0; j < 4; ++j) *(f32x4*)(a.xd + (size_t)row * D + j * 256 + lane * 4) = v[q][j];
                }
            }
        }
        if (a.hd) {
            const float* shp = a.m2 + (size_t)mrow * 9216 + (3 * a.k2) * 1024; const float* scp = shp + 1024;
            f32x4 sh[4], sc[4];
#pragma unroll
            for (int j = 0; j < 4; ++j) { sh[j] = *(const f32x4*)(shp + j * 256 + lane * 4); sc[j] = *(const f32x4*)(scp + j * 256 + lane * 4) + 1.f; }
#pragma unroll
            for (int q = 0; q < NR; ++q) {
                const int row = rowb + 8 * q;
#pragma unroll
                for (int j = 0; j < 4; ++j) {
                    const f32x4 h = v[q][j] * sc[j] + sh[j];
                    u32x2 o; o.x = cvt_pk_bf16(h[0], h[1]); o.y = cvt_pk_bf16(h[2], h[3]);
                    *(u32x2*)(a.hd + (size_t)row * D + j * 256 + lane * 4) = o;
                }
            }
        }
    }
}

constexpr int GLA_DIRB = 74240;
__device__ __forceinline__ void gla_phase(const Params& p, LAS unsigned char* lds) {
    const int tid = opaque_tid(), dir = tid >> 8, tl = tid & 255, w = tl >> 6, lane = tl & 63, fr = lane & 15, fq = lane >> 4;
    const int cp = lane, qt = w;
    bf16_t* P = (bf16_t*)(p.ws + WS_BIG); bf16_t* R = (bf16_t*)(p.ws + WS_A0);
    const float* normw = p.in[12];
    LAS unsigned char* base = lds + dir * GLA_DIRB;
    LAS bf16_t* Qin = (LAS bf16_t*)base;
    LAS bf16_t* Kin = (LAS bf16_t*)(base + 17408);
    LAS bf16_t* Sc = Kin;
    LAS bf16_t* KinT = (LAS bf16_t*)(base + 34816);
    LAS bf16_t* VT = (LAS bf16_t*)(base + 53248);
    LAS float* tot = (LAS float*)(base + 71680);
    LAS float* dec = (LAS float*)(base + 73728);
    for (int item = blockIdx.x; item < NB * 8; item += gridDim.x) {
        const int b = item >> 3, h = item & 7;
        f32x4 Sacc[8][2];
#pragma unroll
        for (int m = 0; m < 8; ++m) { Sacc[m][0] = (f32x4){0.f, 0.f, 0.f, 0.f}; Sacc[m][1] = (f32x4){0.f, 0.f, 0.f, 0.f}; }
        unsigned rq[16], rv[16], rl[16];
        auto chunk_row = [&](int ci, int t) -> size_t {
            const bool isc = ci < 4; const int lc = isc ? ci : ci - 4, L = isc ? CTXL : SEQ; const int rbase = isc ? MX + b * CTXL : b * SEQ;
            const int tok = dir == 0 ? 64 * lc + t : L - 1 - (64 * lc + t);
            return (size_t)(rbase + tok);
        };
        auto load_chunk = [&](int ci) {
            long off = (long)(chunk_row(ci, 16 * qt) * HG5 + h * 128 + 2 * cp);
            const long step = dir == 0 ? (long)HG5 : -(long)HG5;
#pragma unroll
            for (int i = 0; i < 16; ++i) {
                const bf16_t* rp = P + off;
                rq[i] = *(const unsigned*)rp; rv[i] = *(const unsigned*)(rp + 1024); rl[i] = *(const unsigned*)(rp + (2 + dir) * 1024);
                off += step; asm volatile("" : "+v"(off));
            }
        };
        __syncthreads();
        load_chunk(0);
        for (int ci = 0; ci < 36; ++ci) {
            const bool isc = ci < 4;
            {
                float run0 = 0.f, run1 = 0.f;
#pragma unroll
                for (int i = 0; i < 16; ++i) { run0 += bf_lo(rl[i]); run1 += bf_hi(rl[i]); }
                *(LAS f32x2*)(tot + qt * 128 + 2 * cp) = (f32x2){run0, run1};
#pragma unroll
                for (int hh = 0; hh < 2; ++hh) {
                    u32x4 a, c;
#pragma unroll
                    for (int u = 0; u < 4; ++u) { const int ip = 4 * hh + u;
                        a[u] = (rv[2 * ip] & 0xffffu) | (rv[2 * ip + 1] << 16); c[u] = (rv[2 * ip] >> 16) | (rv[2 * ip + 1] & 0xffff0000u); }
                    *(LAS u32x4*)(VT + (2 * cp) * 72 + 16 * qt + 8 * hh) = a;
                    *(LAS u32x4*)(VT + (2 * cp + 1) * 72 + 16 * qt + 8 * hh) = c;
                }
                lds_barrier();
                float pre0 = 0.f, pre1 = 0.f, all0 = 0.f, all1 = 0.f;
#pragma unroll
                for (int q = 0; q < 4; ++q) { const f32x2 tq = *(const LAS f32x2*)(tot + q * 128 + 2 * cp); if (q < qt) { pre0 += tq[0]; pre1 += tq[1]; } all0 += tq[0]; all1 += tq[1]; }
                if (qt == 0) *(LAS f32x2*)(dec + 2 * cp) = (f32x2){__expf(all0), __expf(all1)};
                float iebp0 = __expf(-pre0), iebp1 = __expf(-pre1);
                float bb0 = pre0, bb1 = pre1;
#pragma unroll
                for (int hh = 0; hh < 2; ++hh) {
                    u32x4 a, c;
#pragma unroll
                    for (int u4 = 0; u4 < 4; ++u4) {
                        float kin0[2], kin1[2];
#pragma unroll
                        for (int u = 0; u < 2; ++u) {
                            const int i = 8 * hh + 2 * u4 + u, t = 16 * qt + i;
                            bb0 += bf_lo(rl[i]); bb1 += bf_hi(rl[i]);
                            const float eb0 = __expf(bb0), eb1 = __expf(bb1), ieb0 = __expf(-bb0), ieb1 = __expf(-bb1);
                            const float k0 = 1.f - eb0 * iebp0, k1 = 1.f - eb1 * iebp1;
                            iebp0 = ieb0; iebp1 = ieb1;
                            kin0[u] = k0 * ieb0; kin1[u] = k1 * ieb1;
                            *(LAS unsigned*)(Qin + t * 136 + 2 * cp) = cvt_pk_bf16(bf_lo(rq[i]) * eb0, bf_hi(rq[i]) * eb1);
                            *(LAS unsigned*)(Kin + t * 136 + 2 * cp) = cvt_pk_bf16(kin0[u], kin1[u]);
                        }
                        a[u4] = cvt_pk_bf16(kin0[0], kin0[1]); c[u4] = cvt_pk_bf16(kin1[0], kin1[1]);
                    }
                    *(LAS u32x4*)(KinT + (2 * cp) * 72 + 16 * qt + 8 * hh) = a;
                    *(LAS u32x4*)(KinT + (2 * cp + 1) * 72 + 16 * qt + 8 * hh) = c;
                    __builtin_amdgcn_sched_barrier(0);
                }
            }
            lds_barrier();
            if (ci + 1 < 36) load_chunk(ci + 1);
            f32x4 sacc[4];
            if (!isc) {
                bf16x8 qf[4];
#pragma unroll
                for (int ks = 0; ks < 4; ++ks) qf[ks] = *(const LAS bf16x8*)(Qin + (16 * w + fr) * 136 + 32 * ks + 8 * fq);
#pragma unroll
                for (int ms = 0; ms < 4; ++ms) {
                    sacc[ms] = (f32x4){0.f, 0.f, 0.f, 0.f};
                    if (ms <= w) {
#pragma unroll
                        for (int ks = 0; ks < 4; ++ks) { const bf16x8 kf = *(const LAS bf16x8*)(Kin + (16 * ms + fr) * 136 + 32 * ks + 8 * fq);
                            sacc[ms] = __builtin_amdgcn_mfma_f32_16x16x32_bf16(kf, qf[ks], sacc[ms], 0, 0, 0); }
                    }
                }
            }
            lds_barrier();
            if (!isc) {
#pragma unroll
                for (int ms = 0; ms < 4; ++ms) {
                    f32x4 v = sacc[ms];
                    if (ms == w) {
#pragma unroll
                        for (int j = 0; j < 4; ++j) v[j] = (4 * fq + j <= fr) ? v[j] : 0.f;
                    }
                    u32x2 o; o.x = cvt_pk_bf16(v[0], v[1]); o.y = cvt_pk_bf16(v[2], v[3]);
                    *(LAS u32x2*)(Sc + (16 * w + fr) * 72 + 16 * ms + 4 * fq) = o;
                }
            }
            lds_barrier();
            __builtin_amdgcn_sched_barrier(0);
            bf16x8 vfrag[2][2];
#pragma unroll
            for (int n = 0; n < 2; ++n)
#pragma unroll
                for (int ks = 0; ks < 2; ++ks) vfrag[n][ks] = *(const LAS bf16x8*)(VT + (32 * w + 16 * n + fr) * 72 + 32 * ks + 8 * fq);
            if (!isc) {
                f32x4 oacc[2][4];
#pragma unroll
                for (int n = 0; n < 2; ++n)
#pragma unroll
                    for (int tt = 0; tt < 4; ++tt) oacc[n][tt] = (f32x4){0.f, 0.f, 0.f, 0.f};
#pragma unroll
                for (int kk = 0; kk < 4; ++kk) {
                    bf16x8 sf[2];
#pragma unroll
                    for (int n = 0; n < 2; ++n) {
                        u32x4 pk; pk.x = cvt_pk_bf16(Sacc[2 * kk][n][0], Sacc[2 * kk][n][1]); pk.y = cvt_pk_bf16(Sacc[2 * kk][n][2], Sacc[2 * kk][n][3]);
                        pk.z = cvt_pk_bf16(Sacc[2 * kk + 1][n][0], Sacc[2 * kk + 1][n][1]); pk.w = cvt_pk_bf16(Sacc[2 * kk + 1][n][2], Sacc[2 * kk + 1][n][3]);
                        sf[n] = __builtin_bit_cast(bf16x8, pk);
                    }
#pragma unroll
                    for (int tt = 0; tt < 4; ++tt) {
                        const LAS bf16_t* qp = Qin + (16 * tt + fr) * 136 + 32 * kk + 4 * fq;
                        const u32x2 lo = *(const LAS u32x2*)qp, hi = *(const LAS u32x2*)(qp + 16);
                        const bf16x8 qfr = __builtin_bit_cast(bf16x8, ((u32x4){lo.x, lo.y, hi.x, hi.y}));
#pragma unroll
                        for (int n = 0; n < 2; ++n) oacc[n][tt] = __builtin_amdgcn_mfma_f32_16x16x32_bf16(sf[n], qfr, oacc[n][tt], 0, 0, 0);
                    }
                }
                __builtin_amdgcn_sched_barrier(0);
#pragma unroll
                for (int tt = 0; tt < 4; ++tt)
#pragma unroll
                    for (int ks = 0; ks < 2; ++ks) {
                        if (ks == 1 && tt < 2) continue;
                        const bf16x8 scf = *(const LAS bf16x8*)(Sc + (16 * tt + fr) * 72 + 32 * ks + 8 * fq);
#pragma unroll
                        for (int n = 0; n < 2; ++n) oacc[n][tt] = __builtin_amdgcn_mfma_f32_16x16x32_bf16(vfrag[n][ks], scf, oacc[n][tt], 0, 0, 0);
                    }
                __builtin_amdgcn_sched_barrier(0);
#pragma unroll
                for (int tt = 0; tt < 4; ++tt) {
                    bf16_t* op = P + chunk_row(ci, 16 * tt + fr) * HG5 + (2 + dir) * 1024 + h * 128 + 32 * w + 4 * fq;
#pragma unroll
                    for (int n = 0; n < 2; ++n) { u32x2 o; o.x = cvt_pk_bf16(oacc[n][tt][0], oacc[n][tt][1]); o.y = cvt_pk_bf16(oacc[n][tt][2], oacc[n][tt][3]); *(u32x2*)(op + 16 * n) = o; }
                }
            }
            __builtin_amdgcn_sched_barrier(0);
#pragma unroll
            for (int m = 0; m < 8; ++m) {
#pragma unroll
                for (int ks = 0; ks < 2; ++ks) { const bf16x8 kf = *(const LAS bf16x8*)(KinT + (16 * m + fr) * 72 + 32 * ks + 8 * fq);
#pragma unroll
                    for (int n = 0; n < 2; ++n) Sacc[m][n] = __builtin_amdgcn_mfma_f32_16x16x32_bf16(kf, vfrag[n][ks], Sacc[m][n], 0, 0, 0); }
                const f32x4 dv = *(const LAS f32x4*)(dec + 16 * m + 4 * fq);
                Sacc[m][0] *= dv; Sacc[m][1] *= dv;
            }
            lds_barrier();
        }
        __syncthreads();
        {
            const int wid = tid >> 6, lane = tid & 63, sub = lane >> 4, l16 = lane & 15;
            const f32x4 w0 = *(const f32x4*)(normw + 8 * l16), w1 = *(const f32x4*)(normw + 8 * l16 + 4);
            for (int it0 = 0; it0 < 64; it0 += 8) {
                u32x4 of[8], ob[8], gg[8];
#pragma unroll
                for (int u = 0; u < 8; ++u) {
                    const int t = (it0 + u) * 32 + wid * 4 + sub; const bf16_t* rp = P + ((size_t)b * SEQ + t) * HG5 + h * 128 + 8 * l16;
                    of[u] = __builtin_nontemporal_load((const u32x4*)(rp + 2048)); ob[u] = __builtin_nontemporal_load((const u32x4*)(rp + 3072)); gg[u] = __builtin_nontemporal_load((const u32x4*)(rp + 4096));
                }
#pragma unroll
                for (int u = 0; u < 8; ++u) {
                    const int t = (it0 + u) * 32 + wid * 4 + sub; const size_t row = (size_t)b * SEQ + t;
                    float o[8];
                    o[0] = bf_lo(of[u].x) + bf_lo(ob[u].x); o[1] = bf_hi(of[u].x) + bf_hi(ob[u].x); o[2] = bf_lo(of[u].y) + bf_lo(ob[u].y); o[3] = bf_hi(of[u].y) + bf_hi(ob[u].y);
                    o[4] = bf_lo(of[u].z) + bf_lo(ob[u].z); o[5] = bf_hi(of[u].z) + bf_hi(ob[u].z); o[6] = bf_lo(of[u].w) + bf_lo(ob[u].w); o[7] = bf_hi(of[u].w) + bf_hi(ob[u].w);
                    float ss = 0.f;
#pragma unroll
                    for (int i = 0; i < 8; ++i) ss += o[i] * o[i];
                    ss += __shfl_xor(ss, 1); ss += __shfl_xor(ss, 2); ss += __shfl_xor(ss, 4); ss += __shfl_xor(ss, 8);
                    const float rs = __builtin_amdgcn_rsqf(ss * (1.f / 128.f) + RMS_EPS);
                    u32x4 r;
                    r.x = cvt_pk_bf16(o[0] * rs * w0[0] * bf_lo(gg[u].x), o[1] * rs * w0[1] * bf_hi(gg[u].x));
                    r.y = cvt_pk_bf16(o[2] * rs * w0[2] * bf_lo(gg[u].y), o[3] * rs * w0[3] * bf_hi(gg[u].y));
                    r.z = cvt_pk_bf16(o[4] * rs * w1[0] * bf_lo(gg[u].z), o[5] * rs * w1[1] * bf_hi(gg[u].z));
                    r.w = cvt_pk_bf16(o[6] * rs * w1[2] * bf_lo(gg[u].w), o[7] * rs * w1[3] * bf_hi(gg[u].w));
                    *(u32x4*)(R + row * D + h * 128 + 8 * l16) = r;
                }
            }
        }
        __syncthreads();
    }
}

__device__ __forceinline__ void cm_gate_phase(const Params& p, LAS unsigned char* lds) {
    const int tid = opaque_tid(), wid = tid >> 6, lane = tid & 63, fr = lane & 15, fq = lane >> 4;
    bf16_t* UV = (bf16_t*)(p.ws + WS_BIG);
    const float* vg = p.in[15]; const float* vb = p.in[16]; const float* bs = p.in[18];
    const bf16_t* WSB = (const bf16_t*)(p.ws + WS_WSB);
    LAS bf16_t* Wl = (LAS bf16_t*)lds; LAS bf16_t* Vl = (LAS bf16_t*)(lds + 34816); LAS float* st = (LAS float*)(lds + 34816 + 100352); LAS float* bl = st + 256;
    const int c8 = lane < 48 ? lane : 47;
    for (int ch = blockIdx.x; ch < MX / 128; ch += gridDim.x) {
        const size_t row0 = (size_t)ch * 128;
        __syncthreads();
        for (int rr = 0; rr < 8; ++rr) {
            const int r = wid * 16 + 2 * rr; const bf16_t* vp = UV + (row0 + r) * 6144 + 3072;
            u32x4 x[2][6]; float s[2] = {0.f, 0.f};
#pragma unroll
            for (int q = 0; q < 2; ++q)
#pragma unroll
                for (int i = 0; i < 6; ++i) x[q][i] = *(const u32x4*)(vp + (size_t)q * 6144 + (i * 64 + lane) * 8);
#pragma unroll
            for (int q = 0; q < 2; ++q)
#pragma unroll
                for (int i = 0; i < 6; ++i) s[q] += (bf_lo(x[q][i].x) + bf_hi(x[q][i].x)) + (bf_lo(x[q][i].y) + bf_hi(x[q][i].y)) + (bf_lo(x[q][i].z) + bf_hi(x[q][i].z)) + (bf_lo(x[q][i].w) + bf_hi(x[q][i].w));
            float mean[2], s2[2] = {0.f, 0.f};
#pragma unroll
            for (int q = 0; q < 2; ++q) mean[q] = wave_sum(s[q]) * (1.f / 3072.f);
#pragma unroll
            for (int q = 0; q < 2; ++q)
#pragma unroll
                for (int i = 0; i < 6; ++i) { float d;
                    d = bf_lo(x[q][i].x) - mean[q]; s2[q] += d * d; d = bf_hi(x[q][i].x) - mean[q]; s2[q] += d * d; d = bf_lo(x[q][i].y) - mean[q]; s2[q] += d * d; d = bf_hi(x[q][i].y) - mean[q]; s2[q] += d * d;
                    d = bf_lo(x[q][i].z) - mean[q]; s2[q] += d * d; d = bf_hi(x[q][i].z) - mean[q]; s2[q] += d * d; d = bf_lo(x[q][i].w) - mean[q]; s2[q] += d * d; d = bf_hi(x[q][i].w) - mean[q]; s2[q] += d * d; }
#pragma unroll
            for (int q = 0; q < 2; ++q) { const float rstd = __builtin_amdgcn_rsqf(wave_sum(s2[q]) * (1.f / 3072.f) + LN_EPS); if (lane == 0) { st[2 * (r + q)] = mean[q]; st[2 * (r + q) + 1] = rstd; } }
        }
        for (int g = 0; g < 8; ++g) {
            lds_barrier();
#pragma unroll
            for (int i = 0; i < 4; ++i) { const int idx = tid + NTHREADS * i, r = idx >> 4, cc = idx & 15;
                *(LAS u32x4*)(Wl + r * 136 + cc * 8) = *(const u32x4*)(WSB + (size_t)g * 16384 + r * 128 + cc * 8); }
            if (tid < 128) bl[tid] = bs[g * 128 + tid];
            {
                const float* gp = vg + g * 384 + c8 * 8; const float* bp = vb + g * 384 + c8 * 8;
                const f32x4 g0 = *(const f32x4*)gp, g1 = *(const f32x4*)(gp + 4), b0 = *(const f32x4*)bp, b1 = *(const f32x4*)(bp + 4);
                size_t xo = (row0 + wid) * 6144 + 3072 + g * 384 + c8 * 8;
#pragma unroll
                for (int hb = 0; hb < 2; ++hb) {
                    u32x4 xv[8];
#pragma unroll
                    for (int i = 0; i < 8; ++i) { xv[i] = *(const u32x4*)(UV + xo); xo += 8 * 6144; asm volatile("" : "+v"(xo)); }
#pragma unroll
                    for (int i = 0; i < 8; ++i) { const int sr = wid + 8 * (8 * hb + i);
                        const f32x2 ms = *(const LAS f32x2*)(st + 2 * sr); const float mean = ms[0], rstd = ms[1]; const u32x4 x = xv[i];
                        u32x4 o;
                        o.x = cvt_pk_bf16((bf_lo(x.x) - mean) * rstd * g0[0] + b0[0], (bf_hi(x.x) - mean) * rstd * g0[1] + b0[1]);
                        o.y = cvt_pk_bf16((bf_lo(x.y) - mean) * rstd * g0[2] + b0[2], (bf_hi(x.y) - mean) * rstd * g0[3] + b0[3]);
                        o.z = cvt_pk_bf16((bf_lo(x.z) - mean) * rstd * g1[0] + b1[0], (bf_hi(x.z) - mean) * rstd * g1[1] + b1[1]);
                        o.w = cvt_pk_bf16((bf_lo(x.w) - mean) * rstd * g1[2] + b1[2], (bf_hi(x.w) - mean) * rstd * g1[3] + b1[3]);
                        if (lane < 48) *(LAS u32x4*)(Vl + sr * 392 + c8 * 8) = o; }
                }
            }
            lds_barrier();
#pragma unroll 1
            for (int n = 0; n < 3; ++n) {
                size_t uo = (row0 + fr) * 6144 + g * 384 + wid * 48 + n * 16 + 4 * fq;
                u32x2 uu[8];
#pragma unroll
                for (int m = 0; m < 8; ++m) { uu[m] = *(const u32x2*)(UV + uo); uo += 16 * 6144; asm volatile("" : "+v"(uo)); }
                f32x4 acc[8];
#pragma unroll
                for (int m = 0; m < 8; ++m) acc[m] = (f32x4){0.f, 0.f, 0.f, 0.f};
#pragma unroll
                for (int ks = 0; ks < 4; ++ks) {
                    bf16x8 af;
                    const LAS bf16_t* vp = Vl + (32 * ks + 8 * fq) * 392 + wid * 48 + n * 16 + fr;
#pragma unroll
                    for (int i = 0; i < 8; ++i) af[i] = (short)vp[i * 392];
#pragma unroll
                    for (int m = 0; m < 8; ++m) {
                        const bf16x8 bfrag = *(const LAS bf16x8*)(Wl + (16 * m + fr) * 136 + 32 * ks + 8 * fq);
                        acc[m] = __builtin_amdgcn_mfma_f32_16x16x32_bf16(af, bfrag, acc[m], 0, 0, 0);
                    }
                }
                size_t zo = (row0 + fr) * 6144 + g * 384 + wid * 48 + n * 16 + 4 * fq;
#pragma unroll
                for (int m = 0; m < 8; ++m) {
                    const float bias = bl[16 * m + fr];
                    const u32x2 u2 = uu[m];
                    u32x2 o; o.x = cvt_pk_bf16(bf_lo(u2.x) * (acc[m][0] + bias), bf_hi(u2.x) * (acc[m][1] + bias));
                    o.y = cvt_pk_bf16(bf_lo(u2.y) * (acc[m][2] + bias), bf_hi(u2.y) * (acc[m][3] + bias));
                    *(u32x2*)(UV + zo) = o;
                    zo += 16 * 6144; asm volatile("" : "+v"(zo));
                }
            }
        }
    }
}

#ifndef EN_MASK
#define EN_MASK 255
#endif
constexpr int EN = EN_MASK;
#ifndef PROBE_KINDS
#define PROBE_KINDS 0
#endif
#ifndef PROBE_K
#define PROBE_K 4
#endif
__global__ void __launch_bounds__(NTHREADS, 2) fwd_megakernel(Params p) {
    extern __shared__ __attribute__((aligned(16))) unsigned char lds_raw[];
    LAS unsigned char* lds = (LAS unsigned char*)lds_raw;
    cg::grid_group grid = cg::this_grid();
    volatile LAS unsigned* xst = (volatile LAS unsigned*)(lds + LDS_BYTES - 16);
    if (threadIdx.x == 0) { xst[0] = 0u; xst[1] = 0u; }
    XcdBarrier xb; xb.bar = (unsigned*)(p.ws + WS_BAR); xb.x = 0; xb.st = xst;
    const float* x_in = p.in[0]; const float* ctx_in = p.in[2];
    const float* mod0 = (const float*)(p.ws + WS_MOD); const float* mod1 = mod0 + (size_t)33 * 9216;
    const float* lbv = (const float*)(p.ws + WS_LB);
    const float* ln_g = p.in[6]; const float* ln_b = p.in[7];
    bf16_t* A0 = (bf16_t*)(p.ws + WS_A0); bf16_t* BIG = (bf16_t*)(p.ws + WS_BIG);
    const bf16_t* FIN = (const bf16_t*)(p.ws + WS_FIN); const bf16_t* FOUT = (const bf16_t*)(p.ws + WS_FOUT);
    const bf16_t* HIN = (const bf16_t*)(p.ws + WS_HIN); const bf16_t* HOUT = (const bf16_t*)(p.ws + WS_HOUT);
    const bf16_t* CIN = (const bf16_t*)(p.ws + WS_CIN); const bf16_t* COUT = (const bf16_t*)(p.ws + WS_COUT);
    const size_t FIN_SZ = (size_t)5632 * 1024, FOUT_SZ = (size_t)1024 * 2816;
    long long probe_acc = 0;
    for (int ph = p.ph_lo; ph < p.ph_hi; ++ph) {
        const long long probe_t0 = PROBE_KINDS ? wall_clock64() : 0;
        int kind;
        switch (ph) {
        case 0: kind = 0; break;
        case 1: case 4: case 8: case 11: case 14: case 18: case 21: kind = 1; break;
        case 2: case 9: case 12: case 19: kind = 2; break;
        case 3: case 7: case 10: case 13: case 17: case 20: kind = 3; break;
        case 5: kind = 4; break;
        case 6: kind = 5; break;
        case 15: kind = 6; break;
        default: kind = 7; break;
        }
        if (kind == 0) { if (EN & 1) phase0(p, lds); }
        else if (kind == 1) {
            RowArgs a;
            a.xs_x = p.out; a.xs_c = nullptr; a.nrows = MX; a.y = A0; a.ysc = 0.5f; a.xd = p.out; a.hd = A0;
            if (ph == 1) { a.xs_x = x_in; a.xs_c = ctx_in; a.nrows = MT; a.y = nullptr; a.m = mod0; a.k = 0; a.g = ln_g; a.b = ln_b; a.m2 = mod0; a.k2 = 0; }
            else if (ph == 4) { a.xs_x = x_in; a.xs_c = ctx_in; a.nrows = MT; a.m = mod0; a.k = 0; a.g = ln_g + 0 * D; a.b = ln_b + 0 * D; a.m2 = mod0; a.k2 = 1; }
            else if (ph == 8) { a.y = BIG; a.ysc = 1.f; a.m = mod0; a.k = 1; a.g = ln_g + 1 * D; a.b = ln_b + 1 * D; a.m2 = mod0; a.k2 = 2; }
            else if (ph == 11) { a.m = mod0; a.k = 2; a.g = ln_g + 2 * D; a.b = ln_b + 2 * D; a.m2 = mod1; a.k2 = 0; }
            else if (ph == 14) { a.m = mod1; a.k = 0; a.g = ln_g + 3 * D; a.b = ln_b + 3 * D; a.m2 = mod1; a.k2 = 1; }
            else if (ph == 18) { a.ysc = 1.f; a.m = mod1; a.k = 1; a.g = ln_g + 4 * D; a.b = ln_b + 4 * D; a.m2 = mod1; a.k2 = 2; }
            else { a.m = mod1; a.k = 2; a.g = ln_g + 5 * D; a.b = ln_b + 5 * D; a.hd = nullptr; a.m2 = mod1; a.k2 = 0; }
            if (EN & 2) row_phase(a);
        } else if (kind == 2) {
            const int wi = ph == 2 ? 0 : (ph == 9 ? 1 : (ph == 12 ? 2 : 3));
            if (EN & 4) run_gemm<1>(lds, A0, D, FIN + wi * FIN_SZ, ph == 2 ? MT : MX, 2 * FH, D, BIG, FH, nullptr);
        } else if (kind == 3) {
            const bf16_t* A = BIG; int lda = FH, M = MX, K = FH; const bf16_t* Bt; bf16_t* O = A0;
            if (ph == 3) { Bt = FOUT; M = MT; }
            else if (ph == 7) { A = A0; lda = D; K = D; Bt = HOUT; O = BIG; }
            else if (ph == 10) Bt = FOUT + 1 * FOUT_SZ;
            else if (ph == 13) Bt = FOUT + 2 * FOUT_SZ;
            else if (ph == 17) { lda = 2 * CMI; K = CMI; Bt = COUT; }
            else Bt = FOUT + 3 * FOUT_SZ;
            if (EN & 8) run_gemm<0>(lds, A, lda, Bt, M, D, K, O, D, nullptr);
        } else if (kind == 4) { if (EN & 16) run_gemm<2>(lds, A0, D, HIN, MT, HG5, D, BIG, HG5, lbv); }
        else if (kind == 5) { if (EN & 32) gla_phase(p, lds); }
        else if (kind == 6) { if (EN & 64) run_gemm<3>(lds, A0, D, CIN, MX, 2 * CMI, D, BIG, 2 * CMI, nullptr); }
        else { if (EN & 128) cm_gate_phase(p, lds); }
        if (ph + 1 < p.ph_hi) {
            if (ph == 0) { grid.sync(); xb = xcd_barrier_post((unsigned*)(p.ws + WS_BAR), xst); }
            else xcd_barrier(xb);
        }
        if (PROBE_KINDS && ((PROBE_KINDS >> kind) & 1)) probe_acc += wall_clock64() - probe_t0;
    }
    if (PROBE_KINDS && blockIdx.x == 0 && threadIdx.x == 0) { const long long te = wall_clock64(); while (wall_clock64() - te < PROBE_K * probe_acc) __builtin_amdgcn_s_sleep(8); }
}

extern "C" void kernel_launch(void* const* d_in, const int* in_sizes, int n_in, void* d_out, int out_size, void* d_ws, size_t ws_size, hipStream_t stream) {
    static int grid_blocks = 0;
    if (grid_blocks == 0) {
        if (n_in != 20 || out_size != MX * D || ws_size < WS_END) { fprintf(stderr, "kernel_launch: unexpected shapes (n_in %d out %d ws %zu need %zu)\n", n_in, out_size, ws_size, (size_t)WS_END); grid_blocks = -1; return; }
        int dev = 0, cus = 0, per_cu = 0;
        hipGetDevice(&dev);
        hipDeviceGetAttribute(&cus, hipDeviceAttributeMultiprocessorCount, dev);
        if (hipFuncSetAttribute((const void*)fwd_megakernel, hipFuncAttributeMaxDynamicSharedMemorySize, LDS_BYTES) != hipSuccess) { fprintf(stderr, "kernel_launch: hipFuncSetAttribute failed\n"); grid_blocks = -1; return; }
        if (hipOccupancyMaxActiveBlocksPerMultiprocessor(&per_cu, (const void*)fwd_megakernel, NTHREADS, LDS_BYTES) != hipSuccess || per_cu < 1) { fprintf(stderr, "kernel_launch: occupancy query says %d\n", per_cu); per_cu = 1; }
        (void)hipGetLastError();
        grid_blocks = cus * 1;
    }
    if (grid_blocks < 0) return;
    Params p{};
    for (int i = 0; i < 20; ++i) p.in[i] = (const float*)d_in[i];
    p.out = (float*)d_out; p.ws = (unsigned char*)d_ws; p.ph_lo = 0; p.ph_hi = 22;
    void* args[] = {&p};
    hipError_t e = hipLaunchCooperativeKernel((const void*)fwd_megakernel, dim3(grid_blocks), dim3(NTHREADS), args, LDS_BYTES, stream);
    if (e != hipSuccess) fprintf(stderr, "cooperative launch failed: %s (grid %d)\n", hipGetErrorString(e), grid_blocks);
}
```
